# Optimizing an MI355X kernel written in HIP

```python
import jax, jax.numpy as jnp
from jax import lax
import numpy as np

D_MODEL = 1024
BATCH = 2
SEQ = 8192
DEPTH = 2
DEC_BATCH = 32
DEC_SEQ = 64
PAST_LEN = 2048

CHUNK = 64
Q_BLOCK = 128
ROPE_THETA = 10000.0
RMS_EPS = 1e-6
NEG_INF = -1e30
N_HEADS_A = 8
HEAD_DIM_A = 64
N_KV_A = 2
N_IDX = 4
D_IDX = 64
TOPK_MAX = 256
N_HEADS_R = 8
HEAD_DIM_R = 64
D_DECAY_LORA = 64
D_A_LORA = 64
GN_EPS = 64e-5
N_HEADS_M = 4
HEAD_DIM_M = 128
N_MEM = 256
N_BRANCH = 3
D_A = N_HEADS_A * HEAD_DIM_A
D_KV_A = N_KV_A * HEAD_DIM_A
D_R = N_HEADS_R * HEAD_DIM_R
D_M = N_HEADS_M * HEAD_DIM_M
D_SHIFT = 3 * D_R + D_DECAY_LORA + D_A_LORA
IN_SIZES = (D_A, D_KV_A, D_KV_A, N_IDX * D_IDX, D_IDX, N_IDX, D_A, D_SHIFT, D_R, D_M, D_M, N_BRANCH * D_MODEL)
D_IN = 2 * D_A + 2 * D_KV_A + N_IDX * D_IDX + D_IDX + N_IDX + D_SHIFT + D_R + 2 * D_M + N_BRANCH * D_MODEL

kernel_name = "dsa_rwkv7_memory_hybrid_stream_step"


def _rmsnorm(x, g):
    xf = x.astype(jnp.float32)
    y = xf * lax.rsqrt(jnp.mean(xf * xf, axis=-1, keepdims=True) + RMS_EPS)
    return (y * g.astype(jnp.float32)).astype(x.dtype)


def _rotary(x, pos):
    d = x.shape[-1]
    inv = ROPE_THETA ** (-jnp.arange(0, d, 2, dtype=jnp.float32) / d)
    ang = pos.astype(jnp.float32)[:, None] * inv[None, :]
    cos = jnp.cos(ang)[None, :, None, :]
    sin = jnp.sin(ang)[None, :, None, :]
    xf = x.astype(jnp.float32)
    x1, x2 = xf[..., : d // 2], xf[..., d // 2:]
    return jnp.concatenate([x1 * cos - x2 * sin, x1 * sin + x2 * cos], axis=-1).astype(x.dtype)


def _split_cols(p):
    offs = np.cumsum(np.array(IN_SIZES))[:-1].tolist()
    return jnp.split(p, offs, axis=-1)


def _dsa_block(q, qi, wi, qpos, k_all, v_all, ki_all, topk):
    B, Tb, H, dh = q.shape
    kpos = jnp.arange(k_all.shape[1])
    s = jnp.einsum('bthd,bsd->bths', qi, ki_all, preferred_element_type=jnp.float32) * (D_IDX ** -0.5)
    score = jnp.einsum('bth,bths->bts', wi.astype(jnp.float32), jax.nn.relu(s))
    admissible = (kpos[None, :] // CHUNK) <= (qpos[:, None] // CHUNK)
    score = jnp.where(admissible[None], score, NEG_INF)
    _, idx = lax.top_k(score, topk)
    valid = (idx // CHUNK) <= (qpos[None, :, None] // CHUNK)
    take = jax.vmap(lambda a, i: a[i])
    k_sel = take(k_all, idx)
    v_sel = take(v_all, idx)
    qg = q.reshape(B, Tb, N_KV_A, H // N_KV_A, dh)
    logits = jnp.einsum('btjgd,btnjd->btjgn', qg, k_sel, preferred_element_type=jnp.float32) * (dh ** -0.5)
    logits = jnp.where(valid[:, :, None, None, :], logits, NEG_INF)
    p = jax.nn.softmax(logits, axis=-1).astype(v_sel.dtype)
    o = jnp.einsum('btjgn,btnjd->btjgd', p, v_sel)
    return o.reshape(B, Tb, H, dh)


def _dsa(q, qi, wi, qpos, k_all, v_all, ki_all, topk):
    B, T = q.shape[:2]
    qb = Q_BLOCK if T % Q_BLOCK == 0 else T
    nb = T // qb

    def blk(a):
        return jnp.moveaxis(a.reshape((B, nb, qb) + a.shape[2:]), 1, 0)

    o = lax.map(lambda args: _dsa_block(*args, k_all, v_all, ki_all, topk),
                (blk(q), blk(qi), blk(wi), qpos.reshape(nb, qb)))
    return jnp.moveaxis(o, 0, 1).reshape(q.shape)


def _rwkv(shifted, state0, w0, w2, a0, a2, k_k, k_a, r_k, ln_w, ln_b):
    f32 = jnp.float32
    B, T, _ = shifted.shape
    r, k, v, wl, al = jnp.split(shifted, [D_R, 2 * D_R, 3 * D_R, 3 * D_R + D_DECAY_LORA], axis=-1)
    w = -jax.nn.softplus(-(w0 + jnp.tanh(wl) @ w2).astype(f32)) - 0.5
    decay = jnp.exp(-jnp.exp(w))
    a = jax.nn.sigmoid((a0 + al @ a2).astype(f32))
    heads = lambda t: t.astype(f32).reshape(B, T, N_HEADS_R, HEAD_DIM_R)
    kk = heads(k * k_k)
    kk = kk / jnp.maximum(jnp.sqrt(jnp.sum(kk * kk, axis=-1, keepdims=True)), 1e-12)
    k = k.astype(f32) * (1.0 + (a - 1.0) * k_a.astype(f32))
    r, k, v, a, decay = heads(r), heads(k), heads(v), heads(a), heads(decay)

    def step(S, inp):
        rt, wt, kt, vt, at, bt = inp
        sa = jnp.einsum('bhij,bhj->bhi', S, at)
        S = S * wt[:, :, None, :] + sa[..., None] * bt[:, :, None, :] + vt[..., None] * kt[:, :, None, :]
        return S, jnp.einsum('bhij,bhj->bhi', S, rt)

    tm = lambda t: jnp.moveaxis(t, 1, 0)
    S_T, y = lax.scan(step, state0.astype(f32), (tm(r), tm(decay), tm(k), tm(v), tm(-kk), tm(kk * a)))
    y = jnp.moveaxis(y, 0, 1)
    mu = jnp.mean(y, axis=-1, keepdims=True)
    var = jnp.mean(jnp.square(y - mu), axis=-1, keepdims=True)
    y = ((y - mu) * lax.rsqrt(var + GN_EPS)).reshape(B, T, D_R) * ln_w.astype(f32) + ln_b.astype(f32)
    bonus = jnp.sum(r * k * r_k.astype(f32), axis=-1, keepdims=True) * v
    y = y + bonus.reshape(B, T, D_R)
    return y.astype(shifted.dtype), S_T


def _mem_kv(mem, g, w_kv):
    B = mem.shape[0]
    mk, mv = jnp.split(_rmsnorm(mem, g) @ w_kv, 2, axis=-1)
    return (mk.reshape(B, N_MEM, N_HEADS_M, HEAD_DIM_M), mv.reshape(B, N_MEM, N_HEADS_M, HEAD_DIM_M))


def _mem_attn(q, mem_k, mem_v):
    logits = jnp.einsum('bthd,bmhd->bthm', q, mem_k, preferred_element_type=jnp.float32) * (HEAD_DIM_M ** -0.5)
    p = jax.nn.softmax(logits, axis=-1).astype(mem_v.dtype)
    return jnp.einsum('bthm,bmhd->bthd', p, mem_v)


def _layer(x, past_k, past_v, past_ki, wkv0, shift0, mem_k, mem_v,
           norm_g, w_in, mu_shift, w0, w2, a0, a2, k_k, k_a, r_k, ln_w, ln_b,
           w_br_a, w_br_r, w_br_m, w_out):
    B, T, _ = x.shape
    pos0 = past_k.shape[1]
    h = _rmsnorm(x, norm_g)
    q, k, v, qi, ki, wi, za, sh, zb, qm, zm, gates = _split_cols(h @ w_in)
    pos = pos0 + jnp.arange(T)
    q = _rotary(q.reshape(B, T, N_HEADS_A, HEAD_DIM_A), pos)
    k = _rotary(k.reshape(B, T, N_KV_A, HEAD_DIM_A), pos)
    v = v.reshape(B, T, N_KV_A, HEAD_DIM_A)
    qi = _rotary(qi.reshape(B, T, N_IDX, D_IDX), pos)
    ki = _rotary(ki.reshape(B, T, 1, D_IDX), pos)[:, :, 0]
    wi = wi * (N_IDX ** -0.5)
    k_all = jnp.concatenate([past_k.astype(k.dtype), k], axis=1)
    v_all = jnp.concatenate([past_v.astype(v.dtype), v], axis=1)
    ki_all = jnp.concatenate([past_ki.astype(ki.dtype), ki], axis=1)
    topk = min(TOPK_MAX, (pos0 + T) // 4)
    o_a = _dsa(q, qi, wi, pos, k_all, v_all, ki_all, topk).reshape(B, T, D_A) * jax.nn.silu(za)
    prev = jnp.concatenate([shift0.astype(sh.dtype), sh[:, :-1]], axis=1)
    shifted = sh + (prev - sh) * mu_shift
    y_r, wkv_T = _rwkv(shifted, wkv0, w0, w2, a0, a2, k_k, k_a, r_k, ln_w, ln_b)
    o_r = y_r * jax.nn.silu(zb)
    o_m = _mem_attn(qm.reshape(B, T, N_HEADS_M, HEAD_DIM_M), mem_k, mem_v).reshape(B, T, D_M) * jax.nn.silu(zm)
    g_a, g_r, g_m = jnp.split(jax.nn.sigmoid(gates), N_BRANCH, axis=-1)
    merged = g_a * (o_a @ w_br_a) + g_r * (o_r @ w_br_r) + g_m * (o_m @ w_br_m)
    x = x + merged @ w_out
    return x, k, v, ki, wkv_T, sh[:, -1:]


def setup_inputs(seed: int = 0) -> dict:
    key = jax.random.key(seed)
    ks = iter(jax.random.split(key, 48))
    f32 = jnp.float32
    nrm = lambda shape, scale=1.0: scale * jax.random.normal(next(ks), shape, f32)
    unif = lambda shape, lo, hi: jax.random.uniform(next(ks), shape, f32, lo, hi)
    return {
        'x_prompt': nrm((BATCH, SEQ, D_MODEL)),
        'x_sample': nrm((DEC_BATCH, DEC_SEQ, D_MODEL)),
        'mem_prompt': nrm((BATCH, N_MEM, D_MODEL)),
        'cache_k': nrm((DEPTH, DEC_BATCH, PAST_LEN, N_KV_A, HEAD_DIM_A)),
        'cache_v': nrm((DEPTH, DEC_BATCH, PAST_LEN, N_KV_A, HEAD_DIM_A)),
        'cache_kidx': nrm((DEPTH, DEC_BATCH, PAST_LEN, D_IDX)),
        'state_wkv': nrm((DEPTH, DEC_BATCH, N_HEADS_R, HEAD_DIM_R, HEAD_DIM_R), 0.5),
        'state_shift': nrm((DEPTH, DEC_BATCH, 1, D_SHIFT)),
        'cache_mem_k': nrm((DEPTH, DEC_BATCH, N_MEM, N_HEADS_M, HEAD_DIM_M)),
        'cache_mem_v': nrm((DEPTH, DEC_BATCH, N_MEM, N_HEADS_M, HEAD_DIM_M)),
        'norm_g': 1.0 + nrm((DEPTH, D_MODEL), 0.02),
        'w_in': nrm((DEPTH, D_MODEL, D_IN), D_MODEL ** -0.5),
        'mu_shift': unif((DEPTH, D_SHIFT), 0.0, 1.0),
        'w0': unif((DEPTH, D_R), -6.0, 1.0),
        'w2': nrm((DEPTH, D_DECAY_LORA, D_R), 0.5 * D_DECAY_LORA ** -0.5),
        'a0': nrm((DEPTH, D_R), 0.1),
        'a2': nrm((DEPTH, D_A_LORA, D_R), 0.5 * D_A_LORA ** -0.5),
        'k_k': 0.85 + nrm((DEPTH, D_R), 0.02),
        'k_a': 1.0 + nrm((DEPTH, D_R), 0.02),
        'r_k': nrm((DEPTH, N_HEADS_R, HEAD_DIM_R), 0.1),
        'ln_x_w': 1.0 + nrm((DEPTH, D_R), 0.02),
        'ln_x_b': nrm((DEPTH, D_R), 0.02),
        'mem_norm_g': 1.0 + nrm((DEPTH, D_MODEL), 0.02),
        'w_mem_kv': nrm((DEPTH, D_MODEL, 2 * D_M), D_MODEL ** -0.5),
        'w_br_a': nrm((DEPTH, D_A, D_MODEL), D_A ** -0.5),
        'w_br_r': nrm((DEPTH, D_R, D_MODEL), D_R ** -0.5),
        'w_br_m': nrm((DEPTH, D_M, D_MODEL), D_M ** -0.5),
        'w_out': nrm((DEPTH, D_MODEL, D_MODEL), D_MODEL ** -0.5),
        'final_norm_g': 1.0 + nrm((D_MODEL,), 0.02),
    }


def reference(x_prompt, x_sample, mem_prompt, cache_k, cache_v, cache_kidx, state_wkv, state_shift,
              cache_mem_k, cache_mem_v, norm_g, w_in, mu_shift, w0, w2, a0, a2, k_k, k_a, r_k,
              ln_x_w, ln_x_b, mem_norm_g, w_mem_kv, w_br_a, w_br_r, w_br_m, w_out, final_norm_g):
    B = x_prompt.shape[0]
    dt = x_prompt.dtype
    xp, xs = x_prompt, x_sample
    pk, pv, pki, pwkv, psh, pmk, pmv = [], [], [], [], [], [], []
    sk, sv, ski, swkv, ssh = [], [], [], [], []
    for l in range(DEPTH):
        lw = (norm_g[l], w_in[l], mu_shift[l], w0[l], w2[l], a0[l], a2[l], k_k[l], k_a[l], r_k[l],
              ln_x_w[l], ln_x_b[l], w_br_a[l], w_br_r[l], w_br_m[l], w_out[l])
        mk, mv = _mem_kv(mem_prompt, mem_norm_g[l], w_mem_kv[l])
        empty_kv = jnp.zeros((B, 0, N_KV_A, HEAD_DIM_A), dt)
        xp, k_n, v_n, ki_n, wkv_n, sh_n = _layer(
            xp, empty_kv, empty_kv, jnp.zeros((B, 0, D_IDX), dt),
            jnp.zeros((B, N_HEADS_R, HEAD_DIM_R, HEAD_DIM_R), jnp.float32),
            jnp.zeros((B, 1, D_SHIFT), dt), mk, mv, *lw)
        pk.append(k_n); pv.append(v_n); pki.append(ki_n); pwkv.append(wkv_n); psh.append(sh_n)
        pmk.append(mk); pmv.append(mv)
        xs, k_n, v_n, ki_n, wkv_n, sh_n = _layer(
            xs, cache_k[l], cache_v[l], cache_kidx[l], state_wkv[l], state_shift[l],
            cache_mem_k[l], cache_mem_v[l], *lw)
        sk.append(k_n); sv.append(v_n); ski.append(ki_n); swkv.append(wkv_n); ssh.append(sh_n)
    y_prompt = _rmsnorm(xp, final_norm_g)
    y_sample = _rmsnorm(xs, final_norm_g)
    return (y_prompt, y_sample,
            jnp.stack(pk), jnp.stack(pv), jnp.stack(pki), jnp.stack(pwkv), jnp.stack(psh),
            jnp.stack(pmk), jnp.stack(pmv),
            jnp.stack(sk), jnp.stack(sv), jnp.stack(ski), jnp.stack(swkv), jnp.stack(ssh))
```

```cpp
#include <hip/hip_runtime.h>
#include <hip/hip_cooperative_groups.h>
#include <stdint.h>
#include <stdio.h>
#include <string.h>
namespace cg = cooperative_groups;

#define DI __device__ __forceinline__
#define PROBE_SKIP 2
typedef unsigned short bf16_t;
typedef __attribute__((ext_vector_type(8))) short bf16x8;
typedef __attribute__((ext_vector_type(4))) float f32x4;
typedef __attribute__((ext_vector_type(2))) float f32x2;

constexpr int DM = 1024;
constexpr int TP = 16384;
constexpr int TOK = 18432;
constexpr int DIN = 7876;
constexpr int N1 = 3328;
constexpr int N2 = 4608;
constexpr int RS = 1792;
constexpr int DSH = 1664;
constexpr int SMEM = 73728;
constexpr int SLOT = SMEM - 16;
constexpr int NROWS = 16384 + 32 * 2112;

constexpr size_t O_Y = 0;
constexpr size_t O_KP = 18874368;
constexpr size_t O_VP = O_KP + 4194304;
constexpr size_t O_KIP = O_VP + 4194304;
constexpr size_t O_WKVP = O_KIP + 2097152;
constexpr size_t O_SHP = O_WKVP + 131072;
constexpr size_t O_MKP = O_SHP + 6656;
constexpr size_t O_MVP = O_MKP + 524288;
constexpr size_t O_KS = O_MVP + 524288;
constexpr size_t O_VS = O_KS + 524288;
constexpr size_t O_KIS = O_VS + 524288;
constexpr size_t O_WKVS = O_KIS + 262144;
constexpr size_t O_SHS = O_WKVS + 2097152;

struct Params {
  const float *x_prompt, *x_sample, *mem_prompt, *cache_k, *cache_v, *cache_kidx, *state_wkv, *state_shift,
      *cache_mem_k, *cache_mem_v, *norm_g, *w_in, *mu_shift, *w0, *w2, *a0, *a2, *k_k, *k_a, *r_k, *ln_w, *ln_b,
      *mem_norm_g, *w_mem_kv, *w_br_a, *w_br_r, *w_br_m, *w_out, *final_g;
  float* out;
  bf16_t *Wt1, *Wt2, *Wmem, *Wbr, *Wout, *cmvT, *pmvT, *memn, *hb, *qa, *qi, *qm, *o_r, *merged, *G, *KB, *VB, *KIB;
  float *rope, *wi, *R, *yscan, *bnd, *bonus;
  unsigned* ctr;
};

DI int otid() { int t = __builtin_amdgcn_workitem_id_x(); asm volatile("" : "+v"(t)); return t; }
typedef __bf16 bf16x2_t __attribute__((ext_vector_type(2)));
DI unsigned pack2(float a, float b) {
  const f32x2 v = {a, b};
  const bf16x2_t r = __builtin_convertvector(v, bf16x2_t);
  return __builtin_bit_cast(unsigned, r);
}
DI bf16_t f2bf(float f) { return (bf16_t)(pack2(f, f) & 0xFFFFu); }
DI float bf2f(bf16_t b) { return __uint_as_float(((unsigned)b) << 16); }
DI bf16x8 cvt8(const float* p) {
  float4 x = *(const float4*)p, y = *(const float4*)(p + 4);
  union { bf16x8 v; unsigned u[4]; } r;
  r.u[0] = pack2(x.x, x.y); r.u[1] = pack2(x.z, x.w); r.u[2] = pack2(y.x, y.y); r.u[3] = pack2(y.z, y.w);
  return r.v;
}
template <int CTRL> DI float dpp_add(float x) {
  int y = __builtin_amdgcn_update_dpp(0, __float_as_int(x), CTRL, 0xF, 0xF, false);
  return x + __int_as_float(y);
}
DI float rowsum16(float x) {
  x = dpp_add<0xB1>(x);
  x = dpp_add<0x4E>(x);
  x = dpp_add<0x141>(x);
  x = dpp_add<0x140>(x);
  return x;
}
DI float wave_sum(float v) {
  v = rowsum16(v);
  const float a = __int_as_float(__builtin_amdgcn_readlane(__float_as_int(v), 0));
  const float b = __int_as_float(__builtin_amdgcn_readlane(__float_as_int(v), 16));
  const float c = __int_as_float(__builtin_amdgcn_readlane(__float_as_int(v), 32));
  const float d = __int_as_float(__builtin_amdgcn_readlane(__float_as_int(v), 48));
  return (a + b) + (c + d);
}
typedef unsigned u32x2 __attribute__((ext_vector_type(2)));
DI float red4_sum(float x) {
  const u32x2 r = __builtin_amdgcn_permlane16_swap(__float_as_uint(x), __float_as_uint(x), false, false);
  const float s = __uint_as_float(r.x) + __uint_as_float(r.y);
  const u32x2 q = __builtin_amdgcn_permlane32_swap(__float_as_uint(s), __float_as_uint(s), false, false);
  return __uint_as_float(q.x) + __uint_as_float(q.y);
}
DI float red4_max(float x) {
  const u32x2 r = __builtin_amdgcn_permlane16_swap(__float_as_uint(x), __float_as_uint(x), false, false);
  const float s = fmaxf(__uint_as_float(r.x), __uint_as_float(r.y));
  const u32x2 q = __builtin_amdgcn_permlane32_swap(__float_as_uint(s), __float_as_uint(s), false, false);
  return fmaxf(__uint_as_float(q.x), __uint_as_float(q.y));
}
DI float sigmoidf_(float x) { return __builtin_amdgcn_rcpf(1.f + __expf(-x)); }
DI float siluf_(float x) { return x * __builtin_amdgcn_rcpf(1.f + __expf(-x)); }
DI f32x4 mfma16(bf16x8 a, bf16x8 b, f32x4 c) { return __builtin_amdgcn_mfma_f32_16x16x32_bf16(a, b, c, 0, 0, 0); }

DI const float* xrow_ptr(const Params& p, int l, int tok) {
  if (l == 0) return tok < TP ? p.x_prompt + (size_t)tok * DM : p.x_sample + (size_t)(tok - TP) * DM;
  return p.out + (size_t)tok * DM;
}


DI unsigned xcc_id() { return (unsigned)__builtin_amdgcn_s_getreg((3 << 11) | 20) & 0xFu; }
struct GBar { unsigned* w; unsigned xcc, mycen, nx, k; };
DI void gbar_init(GBar& g, unsigned* w) {
  g.w = w; g.xcc = (unsigned)__builtin_amdgcn_readfirstlane((int)xcc_id()); g.k = 0;
  unsigned nx = 0, mycen = 0;
  for (unsigned x = 0; x < 16; x++) {
    const unsigned c = __hip_atomic_load(&w[64 + 64 * x], __ATOMIC_RELAXED, __HIP_MEMORY_SCOPE_AGENT);
    if (c) nx++;
    if (x == g.xcc) mycen = c;
  }
  g.nx = (unsigned)__builtin_amdgcn_readfirstlane((int)nx);
  g.mycen = (unsigned)__builtin_amdgcn_readfirstlane((int)mycen);
}
DI void gbar(GBar& g) {
  g.k++;
  asm volatile("s_waitcnt vmcnt(0) lgkmcnt(0)" ::: "memory");
  __syncthreads();
  if (otid() == 0) {
    const unsigned a = __hip_atomic_fetch_add(&g.w[1152 + 64 * g.xcc], 1u, __ATOMIC_RELAXED, __HIP_MEMORY_SCOPE_AGENT) + 1u;
    if (a == g.k * g.mycen) {
      __builtin_amdgcn_fence(__ATOMIC_RELEASE, "agent");
      asm volatile("s_waitcnt vmcnt(0)" ::: "memory");
      __hip_atomic_fetch_add(&g.w[2240], 1u, __ATOMIC_RELAXED, __HIP_MEMORY_SCOPE_AGENT);
    }
    while (__hip_atomic_load(&g.w[2240], __ATOMIC_RELAXED, __HIP_MEMORY_SCOPE_AGENT) < g.k * g.nx) __builtin_amdgcn_s_sleep(1);
    __builtin_amdgcn_fence(__ATOMIC_ACQUIRE, "agent");
    asm volatile("s_waitcnt vmcnt(0)" ::: "memory");
  }
  __syncthreads();
}

DI int colmap(int kind, int n) {
  if (kind == 1) {
    if (n < 1092) return n;
    if (n < 1152) return -1;
    if (n < 2816) return 1604 + (n - 1152);
    return 3780 + (n - 2816);
  } else if (kind == 2) {
    if (n < 512) return 1092 + n;
    if (n < 1024) return 3268 + (n - 512);
    if (n < 1536) return 4292 + (n - 1024);
    return 4804 + (n - 1536);
  }
  return n;
}
DI void transpose_tile(const float* __restrict__ src, int ldsrc, int kind, int k0, int n0, bf16_t* __restrict__ dst,
                       int lddst, float* tile) {
  const int tid = otid();
  float v[16];
#pragma unroll
  for (int r = 0; r < 16; r++) {
    const int kk = r * 4 + (tid >> 6), nn = tid & 63;
    const int sc = colmap(kind, n0 + nn);
    v[r] = sc >= 0 ? src[(size_t)(k0 + kk) * ldsrc + sc] : 0.f;
  }
  __syncthreads();
#pragma unroll
  for (int r = 0; r < 16; r++) tile[(r * 4 + (tid >> 6)) * 65 + (tid & 63)] = v[r];
  __syncthreads();
#pragma unroll
  for (int r = 0; r < 8; r++) {
    const int nn = r * 8 + (tid >> 5), kk = (tid & 31) * 2;
    *(unsigned*)(dst + (size_t)(n0 + nn) * lddst + k0 + kk) = pack2(tile[kk * 65 + nn], tile[(kk + 1) * 65 + nn]);
  }
}
DI void norm_row_bf16(const float* __restrict__ x, const float* __restrict__ g, bf16_t* __restrict__ dst) {
  const int lane = otid() & 63;
  float4 v[4];
  float ss = 0.f;
#pragma unroll
  for (int i = 0; i < 4; i++) {
    v[i] = *(const float4*)(x + i * 256 + lane * 4);
    ss += v[i].x * v[i].x + v[i].y * v[i].y + v[i].z * v[i].z + v[i].w * v[i].w;
  }
  ss = wave_sum(ss);
  float rstd = rsqrtf(ss * (1.f / 1024.f) + 1e-6f);
#pragma unroll
  for (int i = 0; i < 4; i++) {
    float4 gg = *(const float4*)(g + i * 256 + lane * 4);
    uint2 o;
    o.x = pack2(v[i].x * rstd * gg.x, v[i].y * rstd * gg.y);
    o.y = pack2(v[i].z * rstd * gg.z, v[i].w * rstd * gg.w);
    *(uint2*)(dst + i * 256 + lane * 4) = o;
  }
}


DI void convert_caches(const Params& p, int l) {
  const int tid = otid();
  const long total = (long)32 * 2048 * 40;
  for (long e = (long)blockIdx.x * 256 + tid; e < total; e += (long)gridDim.x * 256) {
    const int row = (int)(e / 40), c = (int)(e - (long)row * 40);
    const int b = row >> 11, pos = row & 2047;
    const size_t drow = (size_t)16384 + (size_t)b * 2112 + pos;
    const size_t srow = (size_t)(l * 32 + b) * 2048 + pos;
    if (c < 16) *(bf16x8*)(p.KB + drow * 128 + c * 8) = cvt8(p.cache_k + srow * 128 + c * 8);
    else if (c < 32) *(bf16x8*)(p.VB + drow * 128 + (c - 16) * 8) = cvt8(p.cache_v + srow * 128 + (c - 16) * 8);
    else *(bf16x8*)(p.KIB + drow * 64 + (c - 32) * 8) = cvt8(p.cache_kidx + srow * 64 + (c - 32) * 8);
  }
}

DI void phase0(const Params& p, char* smem) {
  const int tid = otid();
  float* tile = (float*)smem;
  if (tid == 0) __hip_atomic_fetch_add(&p.ctr[64 + 64 * xcc_id()], 1u, __ATOMIC_RELAXED, __HIP_MEMORY_SCOPE_AGENT);
  const int NTW = 2880;
  const int NT_ALL = 2 * NTW + 2048;
  for (int t = blockIdx.x; t < NT_ALL; t += gridDim.x) {
    if (t < 2 * NTW) {
      int l = t / NTW, r = t - l * NTW;
      if (r < 832) {
        int nt = r >> 4, kt = r & 15;
        transpose_tile(p.w_in + (size_t)l * DM * DIN, DIN, 1, kt * 64, nt * 64, p.Wt1 + (size_t)l * N1 * DM, DM, tile);
      } else if (r < 832 + 1152) {
        r -= 832;
        int nt = r >> 4, kt = r & 15;
        transpose_tile(p.w_in + (size_t)l * DM * DIN, DIN, 2, kt * 64, nt * 64, p.Wt2 + (size_t)l * N2 * DM, DM, tile);
      } else if (r < 832 + 1152 + 256) {
        r -= 1984;
        int nt = r >> 4, kt = r & 15;
        transpose_tile(p.w_mem_kv + (size_t)l * DM * DM, DM, 0, kt * 64, nt * 64, p.Wmem + (size_t)l * DM * DM, DM, tile);
      } else if (r < 2240 + 384) {
        r -= 2240;
        int br = r >> 7; r &= 127;
        int nt = r >> 3, kt = r & 7;
        const float* src = (br == 0 ? p.w_br_a : br == 1 ? p.w_br_r : p.w_br_m) + (size_t)l * 512 * DM;
        transpose_tile(src, DM, 0, kt * 64, nt * 64, p.Wbr + (size_t)(l * 3 + br) * DM * 512, 512, tile);
      } else {
        r -= 2624;
        int nt = r >> 4, kt = r & 15;
        transpose_tile(p.w_out + (size_t)l * DM * DM, DM, 0, kt * 64, nt * 64, p.Wout + (size_t)l * DM * DM, DM, tile);
      }
    } else {
      int r = t - 2 * NTW;
      int job = r >> 3, sub = r & 7;
      int lb = job >> 2, h = job & 3;
      int nt = sub >> 2, kt = sub & 3;
      transpose_tile(p.cache_mem_v + (size_t)lb * 256 * 512 + h * 128, 512, 0, kt * 64, nt * 64,
                     p.cmvT + (size_t)(lb * 4 + h) * 128 * 256, 256, tile);
    }
  }
  convert_caches(p, 0);
  for (int e = blockIdx.x * 256 + tid; e < 8192 * 32; e += gridDim.x * 256) {
    int pos = e >> 5, i = e & 31;
    float inv = powf(10000.f, -(float)(2 * i) / 64.f);
    float ang = (float)pos * inv;
    float s, c;
    sincosf(ang, &s, &c);
    p.rope[2 * e] = c;
    p.rope[2 * e + 1] = s;
  }
  const int wave = tid >> 6;
  for (int r = blockIdx.x * 4 + wave; r < 1024 + TOK; r += gridDim.x * 4) {
    if (r < 1024) {
      int l = r >> 9, row = r & 511;
      norm_row_bf16(p.mem_prompt + (size_t)row * DM, p.mem_norm_g + l * DM, p.memn + (size_t)r * DM);
    } else {
      int tok = r - 1024;
      norm_row_bf16(xrow_ptr(p, 0, tok), p.norm_g, p.hb + (size_t)tok * DM);
    }
  }
}

constexpr int LDT = 72;
constexpr int TILE_E = 128 * LDT;
DI void gemm_kloop(const bf16_t* __restrict__ A, int lda, const bf16_t* __restrict__ B, int ldb, int K, bf16_t* sm,
                   f32x4 (&acc)[4][4]) {
  const int tid = otid(), lane = tid & 63, wave = tid >> 6;
  const int wm = wave >> 1, wn = wave & 1;
  const int lrow = tid >> 3, lkc = (tid & 7) * 8;
  const unsigned toa = (unsigned)(lrow * lda + lkc), tob = (unsigned)(lrow * ldb + lkc);
  uint4 ra0_0, ra0_1, ra0_2, ra0_3, rb0_0, rb0_1, rb0_2, rb0_3, ra1_0, ra1_1, ra1_2, ra1_3, rb1_0, rb1_1, rb1_2, rb1_3;
  const int fr = lane & 15, fk = (lane >> 4) * 8;
  const int nk = K >> 6;
#define GLOAD(RA, RB, K0)                                                   \
  {                                                                         \
    RA##_0 = *(const uint4*)((A + (size_t)(K0)) + toa);                     \
    RA##_1 = *(const uint4*)((A + (size_t)(32 * lda + (K0))) + toa);        \
    RA##_2 = *(const uint4*)((A + (size_t)(64 * lda + (K0))) + toa);        \
    RA##_3 = *(const uint4*)((A + (size_t)(96 * lda + (K0))) + toa);        \
    RB##_0 = *(const uint4*)((B + (size_t)(K0)) + tob);                     \
    RB##_1 = *(const uint4*)((B + (size_t)(32 * ldb + (K0))) + tob);        \
    RB##_2 = *(const uint4*)((B + (size_t)(64 * ldb + (K0))) + tob);        \
    RB##_3 = *(const uint4*)((B + (size_t)(96 * ldb + (K0))) + tob);        \
  }
#define SSTORE(RA, RB, BUF)                                                 \
  {                                                                         \
    bf16_t* sd = sm + (BUF) * (2 * TILE_E) + lrow * LDT + lkc;              \
    *(uint4*)(sd) = RA##_0;                                                 \
    *(uint4*)(sd + 32 * LDT) = RA##_1;                                      \
    *(uint4*)(sd + 64 * LDT) = RA##_2;                                      \
    *(uint4*)(sd + 96 * LDT) = RA##_3;                                      \
    *(uint4*)(sd + TILE_E) = RB##_0;                                        \
    *(uint4*)(sd + TILE_E + 32 * LDT) = RB##_1;                             \
    *(uint4*)(sd + TILE_E + 64 * LDT) = RB##_2;                             \
    *(uint4*)(sd + TILE_E + 96 * LDT) = RB##_3;                             \
  }
#define COMPUTE(BUF)                                                        \
  {                                                                         \
    const bf16_t* sa = sm + (BUF) * (2 * TILE_E) + (wm * 64 + fr) * LDT + fk;           \
    const bf16_t* sb = sm + (BUF) * (2 * TILE_E) + TILE_E + (wn * 64 + fr) * LDT + fk;  \
    _Pragma("unroll") for (int s = 0; s < 2; s++) {                         \
      bf16x8 af[4], bfr[4];                                                 \
      _Pragma("unroll") for (int i = 0; i < 4; i++) {                       \
        af[i] = *(const bf16x8*)(sa + i * 16 * LDT + s * 32);               \
        bfr[i] = *(const bf16x8*)(sb + i * 16 * LDT + s * 32);              \
      }                                                                     \
      _Pragma("unroll") for (int i = 0; i < 4; i++)                         \
        _Pragma("unroll") for (int j = 0; j < 4; j++) acc[i][j] = mfma16(af[i], bfr[j], acc[i][j]);  \
    }                                                                       \
  }
  __syncthreads();
  GLOAD(ra0, rb0, 0)
  GLOAD(ra1, rb1, 64)
  SSTORE(ra0, rb0, 0)
  __syncthreads();
  for (int kt = 0; kt < nk - 2; kt += 2) {
    GLOAD(ra0, rb0, (kt + 2) << 6)
    COMPUTE(0)
    SSTORE(ra1, rb1, 1)
    __syncthreads();
    GLOAD(ra1, rb1, (kt + 3) << 6)
    COMPUTE(1)
    SSTORE(ra0, rb0, 0)
    __syncthreads();
  }
  COMPUTE(0)
  SSTORE(ra1, rb1, 1)
  __syncthreads();
  COMPUTE(1)
  __syncthreads();
#undef GLOAD
#undef SSTORE
#undef COMPUTE
}
DI void zero_acc(f32x4 (&acc)[4][4]) {
#pragma unroll
  for (int i = 0; i < 4; i++)
#pragma unroll
    for (int j = 0; j < 4; j++) acc[i][j] = (f32x4){0.f, 0.f, 0.f, 0.f};
}


DI void gemm_kloop64(const bf16_t* __restrict__ A, int lda, const bf16_t* __restrict__ B, int ldb, int K, bf16_t* sm,
                     f32x4 (&acc)[2][4]) {
  const int tid = otid(), lane = tid & 63, wave = tid >> 6;
  const int lrow = tid >> 3, lkc = (tid & 7) * 8;
  const unsigned toa = (unsigned)(lrow * lda + lkc), tob = (unsigned)(lrow * ldb + lkc);
  uint4 ra0_0, ra0_1, ra0_2, ra0_3, rb0_0, rb0_1, ra1_0, ra1_1, ra1_2, ra1_3, rb1_0, rb1_1;
  const int fr = lane & 15, fk = (lane >> 4) * 8;
  const int nk = K >> 6;
#define GLOAD(RA, RB, K0)                                                   \
  {                                                                         \
    RA##_0 = *(const uint4*)((A + (size_t)(K0)) + toa);                     \
    RA##_1 = *(const uint4*)((A + (size_t)(32 * lda + (K0))) + toa);        \
    RA##_2 = *(const uint4*)((A + (size_t)(64 * lda + (K0))) + toa);        \
    RA##_3 = *(const uint4*)((A + (size_t)(96 * lda + (K0))) + toa);        \
    RB##_0 = *(const uint4*)((B + (size_t)(K0)) + tob);                     \
    RB##_1 = *(const uint4*)((B + (size_t)(32 * ldb + (K0))) + tob);        \
  }
#define SSTORE(RA, RB, BUF)                                                 \
  {                                                                         \
    bf16_t* sd = sm + (BUF) * (2 * TILE_E) + lrow * LDT + lkc;              \
    *(uint4*)(sd) = RA##_0;                                                 \
    *(uint4*)(sd + 32 * LDT) = RA##_1;                                      \
    *(uint4*)(sd + 64 * LDT) = RA##_2;                                      \
    *(uint4*)(sd + 96 * LDT) = RA##_3;                                      \
    *(uint4*)(sd + TILE_E) = RB##_0;                                        \
    *(uint4*)(sd + TILE_E + 32 * LDT) = RB##_1;                             \
  }
#define COMPUTE(BUF)                                                                            \
  {                                                                                             \
    const bf16_t* sa = sm + (BUF) * (2 * TILE_E) + (wave * 32 + fr) * LDT + fk;                 \
    const bf16_t* sb = sm + (BUF) * (2 * TILE_E) + TILE_E + fr * LDT + fk;                      \
    _Pragma("unroll") for (int s = 0; s < 2; s++) {                                             \
      bf16x8 af[2], bfr[4];                                                                     \
      _Pragma("unroll") for (int i = 0; i < 2; i++) af[i] = *(const bf16x8*)(sa + i * 16 * LDT + s * 32);   \
      _Pragma("unroll") for (int j = 0; j < 4; j++) bfr[j] = *(const bf16x8*)(sb + j * 16 * LDT + s * 32);  \
      _Pragma("unroll") for (int i = 0; i < 2; i++)                                             \
        _Pragma("unroll") for (int j = 0; j < 4; j++) acc[i][j] = mfma16(af[i], bfr[j], acc[i][j]);         \
    }                                                                                           \
  }
  __syncthreads();
  GLOAD(ra0, rb0, 0)
  GLOAD(ra1, rb1, 64)
  SSTORE(ra0, rb0, 0)
  __syncthreads();
  for (int kt = 0; kt < nk - 2; kt += 2) {
    GLOAD(ra0, rb0, (kt + 2) << 6)
    COMPUTE(0)
    SSTORE(ra1, rb1, 1)
    __syncthreads();
    GLOAD(ra1, rb1, (kt + 3) << 6)
    COMPUTE(1)
    SSTORE(ra0, rb0, 0)
    __syncthreads();
  }
  COMPUTE(0)
  SSTORE(ra1, rb1, 1)
  __syncthreads();
  COMPUTE(1)
  __syncthreads();
#undef GLOAD
#undef SSTORE
#undef COMPUTE
}

DI bool xcd_tile(int e, int NNT, int& mt, int& nt) {
  const int xcd = blockIdx.x & 7;
  const int per_mb = 9 * NNT;
  if (e >= 2 * per_mb) return false;
  const int mb = e >= per_mb ? 1 : 0;
  int r = e - mb * per_mb;
  const int full = NNT >> 3, rem = NNT & 7;
  int nb = r / 72;
  int w = 8;
  if (nb >= full) { nb = full; w = rem; }
  r -= nb * 72;
  const int mi = r / w, ni = r - mi * w;
  mt = xcd * 18 + mb * 9 + mi;
  nt = nb * 8 + ni;
  return true;
}

struct TokInfo { int isP, b, t, pos; };
DI TokInfo tokinfo(int tok) {
  TokInfo ti;
  if (tok < TP) { ti.isP = 1; ti.b = tok >> 13; ti.t = tok & 8191; ti.pos = ti.t; }
  else { int s = tok - TP; ti.isP = 0; ti.b = s >> 6; ti.t = s & 63; ti.pos = 2048 + ti.t; }
  return ti;
}

DI void gemm1_phase(const Params& p, int l, char* smem) {
  bf16_t* sm = (bf16_t*)smem;
  const int tid = otid(), lane = tid & 63, wave = tid >> 6;
  const int wm = wave >> 1, wn = wave & 1, g4 = lane >> 4, cl = lane & 15;
  const int NT1 = 144 * 26;
  const int slots = gridDim.x >> 3, slot = blockIdx.x >> 3;
  const int nmain = 18 * 26;
  const int nextra = (l == 0 ? 8 : 0);
  for (int e = slot; e < nmain + nextra; e += slots) {
    f32x4 acc[4][4];
    zero_acc(acc);
    int mt = 0, nt = 0;
    const bool is_main = xcd_tile(e, 26, mt, nt);
    const int t = is_main ? 0 : NT1 + (e - nmain) * 8 + (blockIdx.x & 7);
    if (is_main) {
      gemm_kloop(p.hb + (size_t)mt * 128 * DM, DM, p.Wt1 + ((size_t)l * N1 + nt * 128) * DM, DM, DM, sm, acc);
      const int nb = nt * 128 + wn * 64;
#pragma unroll
      for (int i = 0; i < 4; i++) {
        float2 csv[4][2];
        if (nb < 1088 && !(nb >= 640 && nb < 768)) {
#pragma unroll
          for (int r = 0; r < 4; r++) {
            const TokInfo tj = tokinfo(mt * 128 + wm * 64 + i * 16 + g4 * 4 + r);
#pragma unroll
            for (int jn = 0; jn < 2; jn++) csv[r][jn] = *(const float2*)(p.rope + (size_t)(tj.pos * 32 + jn * 16 + cl) * 2);
          }
        }
#pragma unroll
        for (int r = 0; r < 4; r++) {
          const int tok = mt * 128 + wm * 64 + i * 16 + g4 * 4 + r;
          const TokInfo ti = tokinfo(tok);
          if (nb < 1088) {
            if (nb >= 640 && nb < 768) {
              float* dst = ti.isP ? p.out + O_VP + ((size_t)(l * 2 + ti.b) * 8192 + ti.t) * 128
                                  : p.out + O_VS + ((size_t)(l * 32 + ti.b) * 64 + ti.t) * 128;
              bf16_t* dvb = p.VB + (size_t)(ti.isP ? ti.b * 8192 + ti.t : 16384 + ti.b * 2112 + 2048 + ti.t) * 128;
#pragma unroll
              for (int jn = 0; jn < 4; jn++) {
                dst[nb - 640 + jn * 16 + cl] = acc[i][jn][r];
                dvb[nb - 640 + jn * 16 + cl] = f2bf(acc[i][jn][r]);
              }
            } else {
#pragma unroll
              for (int jn = 0; jn < 2; jn++) {
                const int d = jn * 16 + cl;
                const float2 cs = csv[r][jn];
                const float x1 = acc[i][jn][r], x2 = acc[i][jn + 2][r];
                const float y1 = x1 * cs.x - x2 * cs.y, y2 = x1 * cs.y + x2 * cs.x;
                const int c1 = nb + d, c2 = nb + d + 32;
                if (nb < 512) {
                  p.qa[(size_t)tok * 512 + c1] = f2bf(y1 * 0.125f);
                  p.qa[(size_t)tok * 512 + c2] = f2bf(y2 * 0.125f);
                } else if (nb < 640) {
                  float* dst = ti.isP ? p.out + O_KP + ((size_t)(l * 2 + ti.b) * 8192 + ti.t) * 128
                                      : p.out + O_KS + ((size_t)(l * 32 + ti.b) * 64 + ti.t) * 128;
                  dst[c1 - 512] = y1;
                  dst[c2 - 512] = y2;
                  bf16_t* dkb = p.KB + (size_t)(ti.isP ? ti.b * 8192 + ti.t : 16384 + ti.b * 2112 + 2048 + ti.t) * 128;
                  dkb[c1 - 512] = f2bf(y1);
                  dkb[c2 - 512] = f2bf(y2);
                } else if (nb < 1024) {
                  p.qi[(size_t)tok * 256 + c1 - 768] = f2bf(y1 * 0.125f);
                  p.qi[(size_t)tok * 256 + c2 - 768] = f2bf(y2 * 0.125f);
                } else {
                  float* dst = ti.isP ? p.out + O_KIP + ((size_t)(l * 2 + ti.b) * 8192 + ti.t) * 64
                                      : p.out + O_KIS + ((size_t)(l * 32 + ti.b) * 64 + ti.t) * 64;
                  dst[c1 - 1024] = y1;
                  dst[c2 - 1024] = y2;
                  bf16_t* dib = p.KIB + (size_t)(ti.isP ? ti.b * 8192 + ti.t : 16384 + ti.b * 2112 + 2048 + ti.t) * 64;
                  dib[c1 - 1024] = f2bf(y1);
                  dib[c2 - 1024] = f2bf(y2);
                }
              }
            }
          } else if (nb == 1088) {
            if (cl < 4) p.wi[(size_t)tok * 4 + cl] = acc[i][0][r] * 0.5f;
          } else if (nb < 2816) {
            const int T = ti.isP ? 8192 : 64;
#pragma unroll
            for (int jn = 0; jn < 4; jn++) {
              const int c = nb - 1152 + jn * 16 + cl;
              const float v = acc[i][jn][r];
              p.R[(size_t)tok * RS + c] = v;
              if (ti.t == T - 1) {
                float* dst = ti.isP ? p.out + O_SHP + (size_t)(l * 2 + ti.b) * DSH : p.out + O_SHS + (size_t)(l * 32 + ti.b) * DSH;
                dst[c] = v;
              }
              if ((tok & 15) == 15) p.bnd[(size_t)(tok >> 4) * DSH + c] = v;
            }
          } else {
#pragma unroll
            for (int jn = 0; jn < 4; jn++)
              p.qm[(size_t)tok * 512 + nb - 2816 + jn * 16 + cl] = f2bf(acc[i][jn][r] * 0.08838834764831845f);
          }
        }
      }
    } else {
      const int u = t - NT1;
      const int lm = u >> 5, mt = (u >> 3) & 3, nt = u & 7;
      gemm_kloop(p.memn + ((size_t)lm * 512 + mt * 128) * DM, DM, p.Wmem + ((size_t)lm * DM + nt * 128) * DM, DM, DM, sm, acc);
#pragma unroll
      for (int i = 0; i < 4; i++)
#pragma unroll
        for (int r = 0; r < 4; r++) {
          const int row = mt * 128 + wm * 64 + i * 16 + g4 * 4 + r;
          const int bm = row >> 8, m = row & 255;
#pragma unroll
          for (int jn = 0; jn < 4; jn++) {
            const int n = nt * 128 + wn * 64 + jn * 16 + cl;
            const float v = acc[i][jn][r];
            if (n < 512) {
              p.out[O_MKP + ((size_t)(lm * 2 + bm) * 256 + m) * 512 + n] = v;
            } else {
              const int n2 = n - 512;
              p.out[O_MVP + ((size_t)(lm * 2 + bm) * 256 + m) * 512 + n2] = v;
              p.pmvT[((size_t)((lm * 2 + bm) * 4 + (n2 >> 7)) * 128 + (n2 & 127)) * 256 + m] = f2bf(v);
            }
          }
        }
    }
  }
}

DI void prep_phase(const Params& p, int l, char* smem, const bool dry = false) {
  float* rows = (float*)smem;
  float* tw = rows + 9 * DSH;
  float* ta = tw + 512;
  const int tid = otid(), lane = tid & 63, wave = tid >> 6;
  const float* mu = p.mu_shift + l * DSH;
  const float* w2 = p.w2 + (size_t)l * 64 * 512;
  const float* a2 = p.a2 + (size_t)l * 64 * 512;
  for (int task = blockIdx.x; task < TOK / 16; task += gridDim.x) {
    const int tok0 = task * 16;
    const TokInfo t0 = tokinfo(tok0);
    __syncthreads();
    for (int c = tid; c < DSH; c += 256) {
      float pv;
      if (t0.t == 0) pv = t0.isP ? 0.f : p.state_shift[(size_t)(l * 32 + t0.b) * DSH + c];
      else pv = p.bnd[(size_t)(task - 1) * DSH + c];
      rows[c] = pv;
    }
    for (int batch = 0; batch < 2; batch++) {
      const int tb = tok0 + batch * 8;
      __syncthreads();
      for (int f = tid; f < 8 * 416; f += 256) {
        int tk = f / 416, c4 = f - tk * 416;
        *(float4*)(rows + (tk + 1) * DSH + c4 * 4) = *(const float4*)(p.R + (size_t)(tb + tk) * RS + c4 * 4);
      }
      __syncthreads();
      for (int idx = tid; idx < 1024; idx += 256) {
        int tk = idx >> 7, ii = idx & 127;
        int col = 1536 + ii;
        float cur = rows[(tk + 1) * DSH + col], prv = rows[tk * DSH + col];
        float m = cur + (prv - cur) * mu[col];
        if (ii < 64) tw[tk * 64 + ii] = 1.f - 2.f * __builtin_amdgcn_rcpf(1.f + __expf(2.f * m));
        else ta[tk * 64 + ii - 64] = m;
      }
      __syncthreads();
      float accw[2][8], acca[2][8];
#pragma unroll
      for (int ch = 0; ch < 2; ch++) {
        const int c = tid + 256 * ch;
        const float bw = p.w0[l * 512 + c], ba = p.a0[l * 512 + c];
#pragma unroll
        for (int tk = 0; tk < 8; tk++) { accw[ch][tk] = bw; acca[ch][tk] = ba; }
      }
      for (int i4 = 0; i4 < 16; i4++) {
        float4 twv[8], tav[8];
#pragma unroll
        for (int tk = 0; tk < 8; tk++) {
          twv[tk] = *(const float4*)(tw + tk * 64 + i4 * 4);
          tav[tk] = *(const float4*)(ta + tk * 64 + i4 * 4);
        }
#pragma unroll
        for (int ii = 0; ii < 4; ii++) {
          const int i = i4 * 4 + ii;
#pragma unroll
          for (int ch = 0; ch < 2; ch++) {
            const int c = tid + 256 * ch;
            const float wv = w2[i * 512 + c], av = a2[i * 512 + c];
#pragma unroll
            for (int tk = 0; tk < 8; tk++) {
              const float x = ii == 0 ? twv[tk].x : ii == 1 ? twv[tk].y : ii == 2 ? twv[tk].z : twv[tk].w;
              const float y = ii == 0 ? tav[tk].x : ii == 1 ? tav[tk].y : ii == 2 ? tav[tk].z : tav[tk].w;
              accw[ch][tk] += x * wv;
              acca[ch][tk] += y * av;
            }
          }
        }
      }
#pragma unroll
      for (int ch = 0; ch < 2; ch++) {
        const int c = tid + 256 * ch;
        const int head = wave + 4 * ch;
        const float muR = mu[c], muK = mu[512 + c], muV = mu[1024 + c];
        const float kkc = p.k_k[l * 512 + c], kac = p.k_a[l * 512 + c], rkc = p.r_k[l * 512 + c];
#pragma unroll
        for (int tk = 0; tk < 8; tk++) {
          const float* rc = rows + (tk + 1) * DSH;
          const float* rp = rows + tk * DSH;
          const float r = rc[c] + (rp[c] - rc[c]) * muR;
          const float k = rc[512 + c] + (rp[512 + c] - rc[512 + c]) * muK;
          const float v = rc[1024 + c] + (rp[1024 + c] - rc[1024 + c]) * muV;
          const float xw = -accw[ch][tk];
          const float sp = fmaxf(xw, 0.f) + __logf(1.f + __expf(-fabsf(xw)));
          const float w = -sp - 0.5f;
          const float decay = __expf(-__expf(w));
          const float ag = __builtin_amdgcn_rcpf(1.f + __expf(-acca[ch][tk]));
          const float kkr = k * kkc;
          const float ss = wave_sum(kkr * kkr);
          const float kk = kkr * fminf(__builtin_amdgcn_rsqf(ss), 1e12f);
          const float kp = k * (1.f + (ag - 1.f) * kac);
          const float bon = wave_sum(r * kp * rkc);
          float* Rrow = p.R + (size_t)(tb + tk) * RS;
          bf16_t* Rb = (bf16_t*)(Rrow + 512);
          if (!dry) {
            Rrow[c] = decay;
            Rb[c] = f2bf(r);
            Rb[512 + c] = f2bf(kp);
            Rb[1024 + c] = f2bf(v);
            Rb[1536 + c] = f2bf(-kk);
            Rb[2048 + c] = f2bf(kk * ag);
            if (lane == 0) p.bonus[(size_t)(tb + tk) * 8 + head] = bon;
          } else if (decay + r + kp + v + kk + bon == 1.2345e30f) p.wi[0] = 1.f;
        }
      }
      __syncthreads();
      for (int c = tid; c < DSH; c += 256) rows[c] = rows[8 * DSH + c];
    }
  }
}

DI void scan_task(const Params& p, int l, int isP, int b, int h, int rg, char* smem, const bool dry) {
  float* buf = (float*)smem;
  float* vbuf = buf + 2 * 5 * 16 * 64;
  const int tid = otid(), lane = tid & 63, wave = tid >> 6;
  const int g4 = lane >> 4, jq = lane & 15;
  const int T = isP ? 8192 : 64;
  const int tokbase = isP ? b * 8192 : TP + b * 64;
  const int i = rg * 16 + wave * 4 + g4;
  f32x2 Sa = {0.f, 0.f}, Sb = {0.f, 0.f};
  if (!isP) {
    const float4 s = *(const float4*)(p.state_wkv + ((size_t)((l * 32 + b) * 8 + h) * 64 + i) * 64 + jq * 4);
    Sa = (f32x2){s.x, s.y}; Sb = (f32x2){s.z, s.w};
  }
  __builtin_amdgcn_s_setprio(3);
  const int ds = tid >> 4, dj = tid & 15;
  float4 rd;
  uint4 rbf[2], rv;
  const int nch = T >> 4;
  auto gload = [&](int c) {
    const int tk = tokbase + c * 16;
    rd = *(const float4*)(p.R + (size_t)(tk + ds) * RS + h * 64 + dj * 4);
#pragma unroll
    for (int u = 0; u < 2; u++) {
      const int id = tid + 256 * u;
      const int arr = id >> 7, s = (id >> 3) & 15, ch8 = id & 7;
      const int aofs = arr == 0 ? 0 : arr == 1 ? 512 : arr == 2 ? 1536 : 2048;
      rbf[u] = *(const uint4*)((const bf16_t*)(p.R + (size_t)(tk + s) * RS + 512) + aofs + h * 64 + ch8 * 8);
    }
    if (tid < 32) {
      const int s = tid >> 1, half = tid & 1;
      rv = *(const uint4*)((const bf16_t*)(p.R + (size_t)(tk + s) * RS + 512) + 1024 + h * 64 + rg * 16 + half * 8);
    }
  };
  auto sstore = [&](int bi) {
    float* bb = buf + bi * (5 * 16 * 64);
    *(float4*)(bb + ds * 64 + dj * 4) = rd;
#pragma unroll
    for (int u = 0; u < 2; u++) {
      const int id = tid + 256 * u;
      const int arr = id >> 7, s = (id >> 3) & 15, ch8 = id & 7;
      float* d = bb + (arr + 1) * (16 * 64) + s * 64 + ch8 * 8;
      const unsigned w[4] = {rbf[u].x, rbf[u].y, rbf[u].z, rbf[u].w};
      float4 lo, hi;
      lo.x = __uint_as_float(w[0] << 16); lo.y = __uint_as_float(w[0] & 0xFFFF0000u);
      lo.z = __uint_as_float(w[1] << 16); lo.w = __uint_as_float(w[1] & 0xFFFF0000u);
      hi.x = __uint_as_float(w[2] << 16); hi.y = __uint_as_float(w[2] & 0xFFFF0000u);
      hi.z = __uint_as_float(w[3] << 16); hi.w = __uint_as_float(w[3] & 0xFFFF0000u);
      *(float4*)d = lo;
      *(float4*)(d + 4) = hi;
    }
    if (tid < 32) {
      const int s = tid >> 1, half = tid & 1;
      float* d = vbuf + bi * 256 + s * 16 + half * 8;
      const unsigned w[4] = {rv.x, rv.y, rv.z, rv.w};
#pragma unroll
      for (int q = 0; q < 4; q++) {
        d[2 * q] = __uint_as_float(w[q] << 16);
        d[2 * q + 1] = __uint_as_float(w[q] & 0xFFFF0000u);
      }
    }
  };
  __syncthreads();
  gload(0);
  sstore(0);
  __syncthreads();
  for (int c = 0; c < nch; c++) {
    const bool more = c + 1 < nch;
    if (more) gload(c + 1);
    const float* bb = buf + (c & 1) * (5 * 16 * 64);
    const float* vb = vbuf + (c & 1) * 256;
    float* yo = p.yscan + (size_t)(tokbase + c * 16 + jq) * 512 + h * 64 + i;
    float ykeep = 0.f;
    f32x4 w4 = *(const f32x4*)(bb + jq * 4);
    f32x4 r4 = *(const f32x4*)(bb + 1024 + jq * 4);
    f32x4 k4 = *(const f32x4*)(bb + 2048 + jq * 4);
    f32x4 a4 = *(const f32x4*)(bb + 3072 + jq * 4);
    f32x4 b4 = *(const f32x4*)(bb + 4096 + jq * 4);
    float v = vb[wave * 4 + g4];
#pragma unroll
    for (int s = 0; s < 16; s++) {
      f32x4 w4n = w4, r4n = r4, k4n = k4, a4n = a4, b4n = b4;
      float vn = v;
      if (s < 15) {
        w4n = *(const f32x4*)(bb + (s + 1) * 64 + jq * 4);
        r4n = *(const f32x4*)(bb + 1024 + (s + 1) * 64 + jq * 4);
        k4n = *(const f32x4*)(bb + 2048 + (s + 1) * 64 + jq * 4);
        a4n = *(const f32x4*)(bb + 3072 + (s + 1) * 64 + jq * 4);
        b4n = *(const f32x4*)(bb + 4096 + (s + 1) * 64 + jq * 4);
        vn = vb[(s + 1) * 16 + wave * 4 + g4];
      }
      __builtin_amdgcn_sched_barrier(0);
      const f32x2 vv = {v, v};
      const f32x2 t = Sa * a4.lo + Sb * a4.hi;
      const f32x2 na = Sa * w4.lo + vv * k4.lo;
      const f32x2 nb = Sb * w4.hi + vv * k4.hi;
      const float sa = rowsum16(t.x + t.y);
      const f32x2 sv = {sa, sa};
      Sa = na + sv * b4.lo;
      Sb = nb + sv * b4.hi;
      const f32x2 yy = Sa * r4.lo + Sb * r4.hi;
      const float y = rowsum16(yy.x + yy.y);
      ykeep = (jq == s) ? y : ykeep;
      w4 = w4n; r4 = r4n; k4 = k4n; a4 = a4n; b4 = b4n; v = vn;
    }
    if (!dry) *yo = ykeep;
    if (more) sstore((c + 1) & 1);
    __syncthreads();
  }
  float* so = isP ? p.out + O_WKVP + ((size_t)((l * 2 + b) * 8 + h) * 64 + i) * 64 + jq * 4
                  : p.out + O_WKVS + ((size_t)((l * 32 + b) * 8 + h) * 64 + i) * 64 + jq * 4;
  if (!dry) *(float4*)so = make_float4(Sa.x, Sa.y, Sb.x, Sb.y);
  __builtin_amdgcn_s_setprio(0);
}

DI void mem_task(const Params& p, int l, int tok0, char* smem, const bool dry) {
  bf16_t* st = (bf16_t*)smem;
  const int tid = otid(), lane = tid & 63, wave = tid >> 6;
  const int g4 = lane >> 4, cl = lane & 15;
  const TokInfo ti = tokinfo(tok0);
  const float* Kb = ti.isP ? p.out + O_MKP + (size_t)(l * 2 + ti.b) * 256 * 512
                           : p.cache_mem_k + (size_t)(l * 32 + ti.b) * 256 * 512;
  const bf16_t* Vb = ti.isP ? p.pmvT + (size_t)(l * 2 + ti.b) * 4 * 128 * 256
                            : p.cmvT + (size_t)(l * 32 + ti.b) * 4 * 128 * 256;
  const int q0 = tok0 + wave * 16;
  for (int h = 0; h < 4; h++) {
    bf16x8 qf[4];
#pragma unroll
    for (int ks = 0; ks < 4; ks++) qf[ks] = *(const bf16x8*)(p.qm + (size_t)(q0 + cl) * 512 + h * 128 + ks * 32 + g4 * 8);
    __syncthreads();
    {
      const float* kp = Kb + (size_t)(tid >> 5) * 512 + h * 128 + (tid & 31) * 4;
      bf16_t* sp = st + (tid >> 5) * 136 + (tid & 31) * 4;
#pragma unroll 1
      for (int hb2 = 0; hb2 < 4; hb2++) {
        float4 kv[8];
#pragma unroll
        for (int u = 0; u < 8; u++) kv[u] = *(const float4*)(kp + (size_t)u * 8 * 512);
#pragma unroll
        for (int u = 0; u < 8; u++) {
          uint2 w;
          w.x = pack2(kv[u].x, kv[u].y);
          w.y = pack2(kv[u].z, kv[u].w);
          *(uint2*)(sp + u * 8 * 136) = w;
        }
        kp += 64 * 512;
        sp += 64 * 136;
      }
    }
    __syncthreads();
    f32x4 S[16];
#pragma unroll
    for (int mt = 0; mt < 16; mt++) {
      f32x4 a = (f32x4){0.f, 0.f, 0.f, 0.f};
      const bf16_t* kr = st + (mt * 16 + cl) * 136 + g4 * 8;
#pragma unroll
      for (int ks = 0; ks < 4; ks++) a = mfma16(*(const bf16x8*)(kr + ks * 32), qf[ks], a);
      S[mt] = a;
      if ((mt & 1) == 1) __builtin_amdgcn_sched_barrier(0);
    }
    float m = -1e30f;
#pragma unroll
    for (int mt = 0; mt < 16; mt++)
#pragma unroll
      for (int r = 0; r < 4; r++) m = fmaxf(m, S[mt][r]);
    m = red4_max(m);
    float sum = 0.f;
#pragma unroll
    for (int mt = 0; mt < 16; mt++)
#pragma unroll
      for (int r = 0; r < 4; r++) {
        const float e = __expf(S[mt][r] - m);
        S[mt][r] = e;
        sum += e;
      }
    sum = red4_sum(sum);
    const float inv = __builtin_amdgcn_rcpf(sum);
    __syncthreads();
    {
      const bf16_t* vp = Vb + (size_t)h * 128 * 256 + (size_t)(tid >> 5) * 256 + (tid & 31) * 8;
      bf16_t* sp = st + (tid >> 5) * 264 + (tid & 31) * 8;
#pragma unroll 1
      for (int hb2 = 0; hb2 < 2; hb2++) {
        uint4 vv[8];
#pragma unroll
        for (int u = 0; u < 8; u++) vv[u] = *(const uint4*)(vp + (size_t)u * 8 * 256);
#pragma unroll
        for (int u = 0; u < 8; u++) *(uint4*)(sp + u * 8 * 264) = vv[u];
        vp += 64 * 256;
        sp += 64 * 264;
      }
    }
    __syncthreads();
    f32x4 o[8];
#pragma unroll
    for (int dt = 0; dt < 8; dt++) o[dt] = (f32x4){0.f, 0.f, 0.f, 0.f};
#pragma unroll
    for (int kk = 0; kk < 8; kk++) {
      union { bf16x8 v; unsigned u[4]; } pf;
      pf.u[0] = pack2(S[2 * kk][0], S[2 * kk][1]);
      pf.u[1] = pack2(S[2 * kk][2], S[2 * kk][3]);
      pf.u[2] = pack2(S[2 * kk + 1][0], S[2 * kk + 1][1]);
      pf.u[3] = pack2(S[2 * kk + 1][2], S[2 * kk + 1][3]);
#pragma unroll
      for (int dt = 0; dt < 8; dt++) {
        const bf16_t* vr = st + (dt * 16 + cl) * 264 + (2 * kk) * 16 + g4 * 4;
        union { bf16x8 v; uint2 u[2]; } vf;
        vf.u[0] = *(const uint2*)vr;
        vf.u[1] = *(const uint2*)(vr + 16);
        o[dt] = mfma16(vf.v, pf.v, o[dt]);
      }
      __builtin_amdgcn_sched_barrier(0);
    }
#pragma unroll
    for (int dt = 0; dt < 8; dt++) {
      uint2 stv;
      stv.x = pack2(o[dt][0] * inv, o[dt][1] * inv);
      stv.y = pack2(o[dt][2] * inv, o[dt][3] * inv);
      if (!dry) *(uint2*)(p.qm + (size_t)(q0 + cl) * 512 + h * 128 + dt * 16 + g4 * 4) = stv;
    }
  }
}

DI unsigned mono_key(float f) {
  const int u = __float_as_int(f + 0.0f);
  return (unsigned)u ^ ((unsigned)(u >> 31) | 0x80000000u);
}
DI float relu_(float x) { return __builtin_amdgcn_fmed3f(x, 0.f, __builtin_inff()); }

DI void dsa_task(const Params& p, int l, int isP, int b, int tq, char* smem, const bool dry) {
  unsigned* hist = (unsigned*)smem;
  unsigned short* idxl = (unsigned short*)(smem + 16384);
  unsigned short* tiel = (unsigned short*)smem;
  bf16_t* kst = (bf16_t*)(smem + 24576);
  float* pl = (float*)(smem + 24576);
  float* op = (float*)(smem + 32768);
  float* ml = (float*)(smem + 40960);
  unsigned* cnt = (unsigned*)(smem + 61440);
  unsigned* res = (unsigned*)(smem + 61504);
  unsigned* ccnt = (unsigned*)(smem + 61632);
  unsigned* ovf = (unsigned*)(smem + 61696);
  unsigned* ckey = (unsigned*)(smem + 61952);
  unsigned* cidx = (unsigned*)(smem + 66048);
  const int tid = otid(), lane = tid & 63, wave = tid >> 6;
  const int g4 = lane >> 4, cl = lane & 15;
  const int tokq0 = (isP ? b * 8192 : TP + b * 64) + tq;
  const int S = isP ? ((tq >> 6) + 1) * 64 : 2112;
  const size_t seqbase = isP ? (size_t)b * 8192 : (size_t)16384 + (size_t)b * 2112;
  const bf16_t* KIs = p.KIB + seqbase * 64;
  const bf16_t* Ks = p.KB + seqbase * 128;
  const bf16_t* Vs = p.VB + seqbase * 128;
  const int nsel = S < 256 ? S : 256;
  __syncthreads();
  if (S <= 256) {
    for (int e = tid; e < 16 * 256; e += 256) idxl[e] = (unsigned short)(e & 255);
  } else {
    const int qloc = wave * 4 + g4;
    bf16x8 aq0, aq1;
    {
      const bf16_t* qp = p.qi + ((size_t)(tokq0 + wave * 4) * 4 + cl) * 64 + g4 * 8;
      aq0 = *(const bf16x8*)qp;
      aq1 = *(const bf16x8*)(qp + 32);
    }
    const float4 wq = *(const float4*)(p.wi + (size_t)(tokq0 + qloc) * 4);
    unsigned prefix = 0u, need = 256u;
    const int nchunks = (S + 255) >> 8;
    const int skey = tid >> 3, sc8 = (tid & 7) * 8;
    for (int pass = 0; pass < 6; pass++) {
      const int kind = (pass == 2) ? 1 : (pass == 5) ? 2 : 0;
      const int shift = pass == 0 ? 24 : pass == 1 ? 16 : pass == 3 ? 8 : 0;
      if (kind == 0) {
        for (int e = tid; e < 1024; e += 256) ((uint4*)hist)[e] = make_uint4(0, 0, 0, 0);
      } else {
        if (tid < 16) { cnt[tid] = 0u; ccnt[tid] = 0u; }
        if (tid == 16) *ovf = 0u;
      }
      unsigned tiecnt = 0u;
      const unsigned G = 256u - need;
      uint4 rg0, rg1, rg2, rg3, rg4, rg5, rg6, rg7;
#define KLOAD(KC)                                                                            \
  {                                                                                          \
    const bf16_t* src = KIs + (size_t)((KC) * 256 + skey) * 64 + sc8;                        \
    const int kb0 = (KC) * 256 + skey;                                                       \
    if (kb0 < S) rg0 = *(const uint4*)(src);                                                 \
    if (kb0 + 32 < S) rg1 = *(const uint4*)(src + 32 * 64);                                  \
    if (kb0 + 64 < S) rg2 = *(const uint4*)(src + 64 * 64);                                  \
    if (kb0 + 96 < S) rg3 = *(const uint4*)(src + 96 * 64);                                  \
    if (kb0 + 128 < S) rg4 = *(const uint4*)(src + 128 * 64);                                \
    if (kb0 + 160 < S) rg5 = *(const uint4*)(src + 160 * 64);                                \
    if (kb0 + 192 < S) rg6 = *(const uint4*)(src + 192 * 64);                                \
    if (kb0 + 224 < S) rg7 = *(const uint4*)(src + 224 * 64);                                \
  }
      rg0 = rg1 = rg2 = rg3 = rg4 = rg5 = rg6 = rg7 = make_uint4(0, 0, 0, 0);
      KLOAD(0)
      for (int kc = 0; kc < nchunks; kc++) {
        __syncthreads();
        {
          bf16_t* d = kst + skey * 72 + sc8;
          *(uint4*)(d) = rg0;
          *(uint4*)(d + 32 * 72) = rg1;
          *(uint4*)(d + 64 * 72) = rg2;
          *(uint4*)(d + 96 * 72) = rg3;
          *(uint4*)(d + 128 * 72) = rg4;
          *(uint4*)(d + 160 * 72) = rg5;
          *(uint4*)(d + 192 * 72) = rg6;
          *(uint4*)(d + 224 * 72) = rg7;
        }
        __syncthreads();
        if (kc + 1 < nchunks) KLOAD(kc + 1)
        const int ngrp = (S - kc * 256) >= 256 ? 4 : ((S - kc * 256) >> 6);
        for (int tg = 0; tg < ngrp; tg++) {
          unsigned keys[4];
#pragma unroll
          for (int tt = 0; tt < 4; tt++) {
            const bf16_t* br = kst + ((tg * 4 + tt) * 16 + cl) * 72 + g4 * 8;
            const bf16x8 b0 = *(const bf16x8*)br;
            const bf16x8 b1 = *(const bf16x8*)(br + 32);
            f32x4 a = (f32x4){0.f, 0.f, 0.f, 0.f};
            a = mfma16(aq0, b0, a);
            a = mfma16(aq1, b1, a);
            const float score = wq.x * relu_(a[0]) + wq.y * relu_(a[1]) + wq.z * relu_(a[2]) + wq.w * relu_(a[3]);
            keys[tt] = mono_key(score);
          }
#pragma unroll
          for (int tt = 0; tt < 4; tt++) {
            const unsigned key = keys[tt];
            const int kidx = kc * 256 + (tg * 4 + tt) * 16 + cl;
            if (kind == 0) {
              const bool match = (pass == 0) || ((key >> (shift + 8)) == prefix);
              if (match) atomicAdd(&hist[qloc * 256 + ((key >> shift) & 255u)], 1u);
            } else if (kind == 1) {
              const unsigned hk = key >> 16;
              const bool tz = (hk == prefix) && ((key & 0xFFFFu) == 0u);
              if (hk > prefix) {
                const unsigned slot = atomicAdd(&cnt[qloc], 1u);
                if (slot < 256u) idxl[qloc * 256 + slot] = (unsigned short)kidx;
              } else if (hk == prefix && !tz) {
                const unsigned c = atomicAdd(&ccnt[qloc], 1u);
                if (c < 64u) { ckey[qloc * 64 + c] = key; cidx[qloc * 64 + c] = (unsigned)kidx; }
              }
              const unsigned long long bm = __ballot(tz);
              if (bm != 0ull) {
                const unsigned mg = (unsigned)(bm >> (g4 * 16)) & 0xFFFFu;
                const unsigned rank = tiecnt + __popc(mg & ((1u << cl) - 1u));
                if (tz && rank < need) tiel[qloc * 256 + rank] = (unsigned short)kidx;
                tiecnt += __popc(mg);
              }
            } else {
              if (key > prefix) {
                const unsigned slot = atomicAdd(&cnt[qloc], 1u);
                if (slot < 256u) idxl[qloc * 256 + slot] = (unsigned short)kidx;
              }
              const bool eq = (key == prefix);
              const unsigned long long bm = __ballot(eq);
              if (bm != 0ull) {
                const unsigned mg = (unsigned)(bm >> (g4 * 16)) & 0xFFFFu;
                const unsigned rank = tiecnt + __popc(mg & ((1u << cl) - 1u));
                if (eq && rank < need) idxl[qloc * 256 + G + rank] = (unsigned short)kidx;
                tiecnt += __popc(mg);
              }
            }
          }
        }
      }
#undef KLOAD
      __syncthreads();
      if (kind == 0) {
        const unsigned* hq = hist + qloc * 256;
        const int top = 255 - 16 * cl;
        unsigned sum = 0u;
#pragma unroll
        for (int u = 0; u < 16; u++) sum += hq[top - u];
        unsigned incl = sum;
#pragma unroll
        for (int d = 1; d < 16; d <<= 1) {
          const unsigned t = __shfl_up(incl, d, 16);
          if (cl >= d) incl += t;
        }
        const unsigned excl = incl - sum;
        if (excl < need && incl >= need) {
          unsigned cum = excl;
          int bsel = top - 15;
          unsigned above = excl;
          bool found = false;
#pragma unroll
          for (int u = 0; u < 16; u++) {
            const unsigned c = hq[top - u];
            if (!found && cum + c >= need) { bsel = top - u; above = cum; found = true; }
            cum += c;
          }
          res[qloc * 2] = (unsigned)bsel;
          res[qloc * 2 + 1] = above;
        }
        __syncthreads();
        const unsigned bstar = res[qloc * 2], above = res[qloc * 2 + 1];
        need -= above;
        prefix = (prefix << 8) | bstar;
      } else if (kind == 1) {
        const unsigned c = ccnt[qloc];
        if (c > 64u) {
          if (cl == 0) *ovf = 1u;
        } else {
          for (unsigned i = cl; i < c; i += 16) {
            const unsigned ki = ckey[qloc * 64 + i], ii = cidx[qloc * 64 + i];
            unsigned rank = 0u;
            for (unsigned j = 0; j < c; j++) {
              const unsigned kj = ckey[qloc * 64 + j], ij = cidx[qloc * 64 + j];
              rank += (kj > ki || (kj == ki && ij < ii)) ? 1u : 0u;
            }
            if (rank < need) idxl[qloc * 256 + G + rank] = (unsigned short)ii;
          }
          const unsigned nso = c < need ? c : need;
          for (unsigned t = cl; t < need - nso; t += 16) idxl[qloc * 256 + G + nso + t] = tiel[qloc * 256 + t];
        }
        __syncthreads();
        if (*ovf == 0u) break;
      }
    }
  }
  __syncthreads();
  const bool active = wave * 64 < nsel;
  unsigned vreg[64];
  bf16x8 kf[2][4][2];
  if (active) {
    const int mypos = idxl[wave * 64 + lane];
#pragma unroll
    for (int n = 0; n < 64; n++) {
      const int pos = __builtin_amdgcn_readlane(mypos, n);
      vreg[n] = *(const unsigned*)(Vs + (size_t)pos * 128 + 2 * lane);
    }
#pragma unroll
    for (int tt = 0; tt < 4; tt++) {
      const int pos = idxl[wave * 64 + tt * 16 + cl];
#pragma unroll
      for (int j = 0; j < 2; j++) {
        const bf16_t* kr = Ks + (size_t)pos * 128 + j * 64 + g4 * 8;
        kf[j][tt][0] = *(const bf16x8*)kr;
        kf[j][tt][1] = *(const bf16x8*)(kr + 32);
      }
    }
  }
  for (int qq = 0; qq < 16; qq++) {
    const int tok = tokq0 + qq;
    const int qn = qq < 15 ? qq + 1 : 15;
    if (active) {
#pragma unroll
      for (int j = 0; j < 2; j++) {
        const bf16_t* qp = p.qa + (size_t)tok * 512 + (j * 4 + (cl & 3)) * 64 + g4 * 8;
        const bf16x8 bq0 = *(const bf16x8*)qp;
        const bf16x8 bq1 = *(const bf16x8*)(qp + 32);
        f32x4 lg[4];
#pragma unroll
        for (int tt = 0; tt < 4; tt++) {
          f32x4 a = (f32x4){0.f, 0.f, 0.f, 0.f};
          a = mfma16(kf[j][tt][0], bq0, a);
          a = mfma16(kf[j][tt][1], bq1, a);
          lg[tt] = a;
        }
        float m = -1e30f;
#pragma unroll
        for (int tt = 0; tt < 4; tt++)
#pragma unroll
          for (int r = 0; r < 4; r++) m = fmaxf(m, lg[tt][r]);
        m = red4_max(m);
        float sum = 0.f;
#pragma unroll
        for (int tt = 0; tt < 4; tt++)
#pragma unroll
          for (int r = 0; r < 4; r++) {
            const float e = __expf(lg[tt][r] - m);
            lg[tt][r] = e;
            sum += e;
          }
        sum = red4_sum(sum);
        if (cl < 4) {
#pragma unroll
          for (int tt = 0; tt < 4; tt++)
#pragma unroll
            for (int r = 0; r < 4; r++) pl[((wave * 2 + j) * 64 + tt * 16 + g4 * 4 + r) * 4 + cl] = lg[tt][r];
          if (g4 == 0) {
            ml[(wave * 8 + j * 4 + cl) * 2] = m;
            ml[(wave * 8 + j * 4 + cl) * 2 + 1] = sum;
          }
        }
      }
#pragma unroll
      for (int tt = 0; tt < 4; tt++) {
        const int pos = idxl[qn * 256 + wave * 64 + tt * 16 + cl];
#pragma unroll
        for (int j = 0; j < 2; j++) {
          const bf16_t* kr = Ks + (size_t)pos * 128 + j * 64 + g4 * 8;
          kf[j][tt][0] = *(const bf16x8*)kr;
          kf[j][tt][1] = *(const bf16x8*)(kr + 32);
        }
      }
    } else {
      if (lane < 8) {
        ml[(wave * 8 + lane) * 2] = -1e30f;
        ml[(wave * 8 + lane) * 2 + 1] = 0.f;
      }
    }
    __syncthreads();
    {
      float ac[4][2];
#pragma unroll
      for (int g = 0; g < 4; g++) { ac[g][0] = 0.f; ac[g][1] = 0.f; }
      const int jv = lane >> 5;
      if (active) {
#pragma unroll
        for (int n = 0; n < 64; n++) {
          const float4 p4 = *(const float4*)(pl + ((wave * 2 + jv) * 64 + n) * 4);
          const float vx = __uint_as_float(vreg[n] << 16), vy = __uint_as_float(vreg[n] & 0xFFFF0000u);
          ac[0][0] += p4.x * vx; ac[0][1] += p4.x * vy;
          ac[1][0] += p4.y * vx; ac[1][1] += p4.y * vy;
          ac[2][0] += p4.z * vx; ac[2][1] += p4.z * vy;
          ac[3][0] += p4.w * vx; ac[3][1] += p4.w * vy;
        }
        const int mypos = idxl[qn * 256 + wave * 64 + lane];
#pragma unroll
        for (int n = 0; n < 64; n++) {
          const int pos = __builtin_amdgcn_readlane(mypos, n);
          vreg[n] = *(const unsigned*)(Vs + (size_t)pos * 128 + 2 * lane);
        }
      }
#pragma unroll
      for (int g = 0; g < 4; g++)
        *(float2*)(op + (wave * 8 + jv * 4 + g) * 64 + ((2 * lane) & 63)) = make_float2(ac[g][0], ac[g][1]);
    }
    __syncthreads();
    {
      const int e = tid * 2, head = e >> 6, d = e & 63;
      float M = -1e30f;
#pragma unroll
      for (int w = 0; w < 4; w++) M = fmaxf(M, ml[(w * 8 + head) * 2]);
      float den = 0.f, n0 = 0.f, n1 = 0.f;
#pragma unroll
      for (int w = 0; w < 4; w++) {
        const float f = __expf(ml[(w * 8 + head) * 2] - M);
        den += ml[(w * 8 + head) * 2 + 1] * f;
        const float2 o2 = *(const float2*)(op + (w * 8 + head) * 64 + d);
        n0 += o2.x * f;
        n1 += o2.y * f;
      }
      const float inv = __builtin_amdgcn_rcpf(den);
      if (!dry) *(unsigned*)(p.qa + (size_t)tok * 512 + e) = pack2(n0 * inv, n1 * inv);
    }
    __syncthreads();
  }
}

DI void mixer_phase(const Params& p, int l, char* smem, const bool dry = false, const int ci = 0) {
  const int tid = otid();
  const int NTASK = 64 + 1024 + 1024 + 128 + 288;
  bool first = true;
  for (;;) {
    int id;
    if (first && blockIdx.x < 64) {
      id = blockIdx.x;
    } else {
      __syncthreads();
      if (tid == 0) *(int*)(smem + SLOT) = 64 + (int)atomicAdd(&p.ctr[l + ci], 1u);
      __syncthreads();
      id = *(const int*)(smem + SLOT);
    }
    first = false;
    if (id >= NTASK) break;
    const int d = id - 64;
    if (id < 64 || d >= 1440) {
      int isP, b, h, rg;
      if (id < 64) { isP = 1; b = id >> 5; h = (id >> 2) & 7; rg = id & 3; }
      else { const int s = d - 1440; isP = 0; b = s >> 5; h = (s >> 2) & 7; rg = s & 3; }
      if (!(dry && (PROBE_SKIP & 2))) scan_task(p, l, isP, b, h, rg, smem, dry);
    } else if (d < 896 || d >= 1184) {
      int isP, b, tq;
      if (d < 768) { isP = 1; b = d & 1; tq = (511 - (d >> 1)) * 16; }
      else if (d < 896) { const int s = d - 768; isP = 0; b = s >> 2; tq = (s & 3) * 16; }
      else { const int s = d - 1184; isP = 1; b = s & 1; tq = (127 - (s >> 1)) * 16; }
      if (!(dry && (PROBE_SKIP & 1))) dsa_task(p, l, isP, b, tq, smem, dry);
    } else {
      if (!(dry && (PROBE_SKIP & 4))) mem_task(p, l, (d - 896) * 64, smem, dry);
    }
  }
}

DI void post_phase(const Params& p, int l) {
  const int tid = otid(), lane = tid & 63, wave = tid >> 6;
  for (int tok = blockIdx.x * 4 + wave; tok < TOK; tok += gridDim.x * 4) {
    float y[8], lw[8], lb[8], vv[8], bo[8];
    const bf16_t* vb = (const bf16_t*)(p.R + (size_t)tok * RS + 512) + 1024;
#pragma unroll
    for (int h = 0; h < 8; h++) {
      const int c = h * 64 + lane;
      y[h] = p.yscan[(size_t)tok * 512 + c];
      lw[h] = p.ln_w[l * 512 + c];
      lb[h] = p.ln_b[l * 512 + c];
      vv[h] = bf2f(vb[c]);
      bo[h] = p.bonus[(size_t)tok * 8 + h];
    }
#pragma unroll
    for (int h = 0; h < 8; h++) {
      const float mean = wave_sum(y[h]) * (1.f / 64.f);
      const float dv = y[h] - mean;
      const float var = wave_sum(dv * dv) * (1.f / 64.f);
      const float yn = dv * rsqrtf(var + 64e-5f) * lw[h] + lb[h];
      y[h] = yn + bo[h] * vv[h];
    }
#pragma unroll
    for (int h = 0; h < 8; h++) p.o_r[(size_t)tok * 512 + h * 64 + lane] = f2bf(y[h]);
  }
}

DI void gemm2_phase(const Params& p, int l, char* smem, const bool dry = false) {
  bf16_t* sm = (bf16_t*)smem;
  const int tid = otid(), lane = tid & 63, wave = tid >> 6;
  const int wm = wave >> 1, wn = wave & 1, g4 = lane >> 4, cl = lane & 15;
  const int slots = gridDim.x >> 3, slot = blockIdx.x >> 3;
  for (int e = slot;; e += slots) {
    int mt, nt;
    if (!xcd_tile(e, 36, mt, nt)) break;
    f32x4 acc[4][4];
    zero_acc(acc);
    gemm_kloop(p.hb + (size_t)mt * 128 * DM, DM, p.Wt2 + ((size_t)l * N2 + nt * 128) * DM, DM, DM, sm, acc);
    const int nb = nt * 128 + wn * 64;
    if (dry) {
      if (acc[0][0][0] == 1.2345e30f) p.wi[0] = acc[1][1][1] + acc[2][2][2] + acc[3][3][3];
    } else if (nb < 1536) {
      bf16_t* base = (nb < 512 ? p.qa : nb < 1024 ? p.o_r : p.qm) + (nb & 511) + cl;
      bf16_t old[4][4][4];
#pragma unroll
      for (int i = 0; i < 4; i++)
#pragma unroll
        for (int r = 0; r < 4; r++) {
          const int tok = mt * 128 + wm * 64 + i * 16 + g4 * 4 + r;
#pragma unroll
          for (int jn = 0; jn < 4; jn++) old[i][r][jn] = base[(size_t)tok * 512 + jn * 16];
        }
#pragma unroll
      for (int i = 0; i < 4; i++)
#pragma unroll
        for (int r = 0; r < 4; r++) {
          const int tok = mt * 128 + wm * 64 + i * 16 + g4 * 4 + r;
#pragma unroll
          for (int jn = 0; jn < 4; jn++) base[(size_t)tok * 512 + jn * 16] = f2bf(bf2f(old[i][r][jn]) * siluf_(acc[i][jn][r]));
        }
    } else {
#pragma unroll
      for (int i = 0; i < 4; i++)
#pragma unroll
        for (int r = 0; r < 4; r++) {
          const int tok = mt * 128 + wm * 64 + i * 16 + g4 * 4 + r;
#pragma unroll
          for (int jn = 0; jn < 4; jn++)
            p.G[(size_t)tok * 3072 + nb - 1536 + jn * 16 + cl] = f2bf(sigmoidf_(acc[i][jn][r]));
        }
    }
  }
}

DI void merge_phase(const Params& p, int l, char* smem) {
  bf16_t* sm = (bf16_t*)smem;
  const int tid = otid(), lane = tid & 63, wave = tid >> 6;
  const int g4 = lane >> 4, cl = lane & 15;
  const int slots = gridDim.x >> 3, slot = blockIdx.x >> 3;
  for (int e = slot;; e += slots) {
    int mt, nt;
    if (!xcd_tile(e, 16, mt, nt)) break;
    f32x4 tot[2][4];
#pragma unroll
    for (int i = 0; i < 2; i++)
#pragma unroll
      for (int j = 0; j < 4; j++) tot[i][j] = (f32x4){0.f, 0.f, 0.f, 0.f};
#pragma unroll 1
    for (int br = 0; br < 3; br++) {
      f32x4 acc[2][4];
#pragma unroll
      for (int i = 0; i < 2; i++)
#pragma unroll
        for (int j = 0; j < 4; j++) acc[i][j] = (f32x4){0.f, 0.f, 0.f, 0.f};
      const bf16_t* A = (br == 0 ? p.qa : br == 1 ? p.o_r : p.qm) + (size_t)mt * 128 * 512;
      gemm_kloop64(A, 512, p.Wbr + ((size_t)(l * 3 + br) * DM + nt * 64) * 512, 512, 512, sm, acc);
#pragma unroll
      for (int i = 0; i < 2; i++)
#pragma unroll
        for (int r = 0; r < 4; r++) {
          const int tok = mt * 128 + wave * 32 + i * 16 + g4 * 4 + r;
#pragma unroll
          for (int jn = 0; jn < 4; jn++) {
            const int n = nt * 64 + jn * 16 + cl;
            const float g = bf2f(p.G[(size_t)tok * 3072 + br * 1024 + n]);
            tot[i][jn][r] += g * acc[i][jn][r];
          }
        }
    }
#pragma unroll
    for (int i = 0; i < 2; i++)
#pragma unroll
      for (int r = 0; r < 4; r++) {
        const int tok = mt * 128 + wave * 32 + i * 16 + g4 * 4 + r;
#pragma unroll
        for (int jn = 0; jn < 4; jn++) {
          const int n = nt * 64 + jn * 16 + cl;
          p.merged[(size_t)tok * DM + n] = f2bf(tot[i][jn][r]);
        }
      }
  }
}

DI void out_phase(const Params& p, int l, char* smem, const bool dry = false) {
  bf16_t* sm = (bf16_t*)smem;
  const int tid = otid(), lane = tid & 63, wave = tid >> 6;
  const int wm = wave >> 1, wn = wave & 1, g4 = lane >> 4, cl = lane & 15;
  const int slots = gridDim.x >> 3, slot = blockIdx.x >> 3;
  for (int e = slot;; e += slots) {
    int mt, nt;
    if (!xcd_tile(e, 8, mt, nt)) break;
    f32x4 acc[4][4];
    zero_acc(acc);
    gemm_kloop(p.merged + (size_t)mt * 128 * DM, DM, p.Wout + ((size_t)l * DM + nt * 128) * DM, DM, DM, sm, acc);
    if (dry) {
      if (acc[0][0][0] == 1.2345e30f) p.wi[0] = acc[1][1][1] + acc[2][2][2] + acc[3][3][3];
      continue;
    }
    float xo[4][4][4];
#pragma unroll
    for (int i = 0; i < 4; i++)
#pragma unroll
      for (int r = 0; r < 4; r++) {
        const int tok = mt * 128 + wm * 64 + i * 16 + g4 * 4 + r;
        const float* xr = xrow_ptr(p, l, tok);
#pragma unroll
        for (int jn = 0; jn < 4; jn++) xo[i][r][jn] = xr[nt * 128 + wn * 64 + jn * 16 + cl];
      }
#pragma unroll
    for (int i = 0; i < 4; i++)
#pragma unroll
      for (int r = 0; r < 4; r++) {
        const int tok = mt * 128 + wm * 64 + i * 16 + g4 * 4 + r;
#pragma unroll
        for (int jn = 0; jn < 4; jn++) {
          const int n = nt * 128 + wn * 64 + jn * 16 + cl;
          p.out[(size_t)tok * DM + n] = xo[i][r][jn] + acc[i][jn][r];
        }
      }
  }
}

DI void norm_phase(const Params& p, int l) {
  const int wave = otid() >> 6;
  for (int tok = blockIdx.x * 4 + wave; tok < TOK; tok += gridDim.x * 4)
    norm_row_bf16(xrow_ptr(p, l, tok), p.norm_g + l * DM, p.hb + (size_t)tok * DM);
}
DI void final_phase(const Params& p) {
  const int lane = otid() & 63, wave = otid() >> 6;
  for (int tok = blockIdx.x * 4 + wave; tok < TOK; tok += gridDim.x * 4) {
    float* x = p.out + (size_t)tok * DM;
    float4 v[4];
    float ss = 0.f;
#pragma unroll
    for (int i = 0; i < 4; i++) {
      v[i] = *(const float4*)(x + i * 256 + lane * 4);
      ss += v[i].x * v[i].x + v[i].y * v[i].y + v[i].z * v[i].z + v[i].w * v[i].w;
    }
    ss = wave_sum(ss);
    const float rstd = rsqrtf(ss * (1.f / 1024.f) + 1e-6f);
#pragma unroll
    for (int i = 0; i < 4; i++) {
      const float4 g = *(const float4*)(p.final_g + i * 256 + lane * 4);
      *(float4*)(x + i * 256 + lane * 4) = make_float4(v[i].x * rstd * g.x, v[i].y * rstd * g.y, v[i].z * rstd * g.z, v[i].w * rstd * g.w);
    }
  }
}

__global__ void __launch_bounds__(256, 2) mega(Params pk) {
  const Params& p = *(const Params*)__builtin_amdgcn_kernarg_segment_ptr();
  cg::grid_group grid = cg::this_grid();
  __shared__ __attribute__((aligned(16))) char smem[SMEM];
  phase0(p, smem);
  grid.sync();
  GBar gb;
  gbar_init(gb, p.ctr);
#ifndef PROBE_DUP
#define PROBE_DUP 0
#endif
  const bool dryv = PROBE_DUP ? (*(volatile unsigned*)&p.ctr[7] == 0u) : false;
  if (PROBE_DUP & 1) { phase0(p, smem); gbar(gb); }
  for (int l = 0; l < 2; l++) {
    if (l == 1) { norm_phase(p, 1); convert_caches(p, 1); gbar(gb); }
    if (PROBE_DUP & 2) { gemm1_phase(p, l, smem); gbar(gb); }
    gemm1_phase(p, l, smem);
    gbar(gb);
    if (PROBE_DUP & 4) { prep_phase(p, l, smem, dryv); gbar(gb); }
    prep_phase(p, l, smem);
    gbar(gb);
    if (PROBE_DUP & 8) { mixer_phase(p, l, smem, dryv, 2); gbar(gb); }
    mixer_phase(p, l, smem);
    gbar(gb);
    if (PROBE_DUP & 16) { post_phase(p, l); gbar(gb); }
    post_phase(p, l);
    gbar(gb);
    if (PROBE_DUP & 32) { gemm2_phase(p, l, smem, dryv); gbar(gb); }
    gemm2_phase(p, l, smem);
    gbar(gb);
    if (PROBE_DUP & 64) { merge_phase(p, l, smem); gbar(gb); }
    merge_phase(p, l, smem);
    gbar(gb);
    if (PROBE_DUP & 128) { out_phase(p, l, smem, dryv); gbar(gb); }
    out_phase(p, l, smem);
    gbar(gb);
  }
  final_phase(p);
}

extern "C" void kernel_launch(void* const* d_in, const int* in_sizes, int n_in, void* d_out, int out_size, void* d_ws,
                              size_t ws_size, hipStream_t stream) {
  Params p;
  ::memset((void*)&p, 0, sizeof(p));
  const float** f = (const float**)&p;
  for (int i = 0; i < 29; i++) f[i] = (const float*)d_in[i];
  p.out = (float*)d_out;
  char* w = (char*)d_ws;
  size_t off = 0;
  auto take = [&](size_t bytes) { char* r = w + off; off += (bytes + 255) & ~(size_t)255; return r; };
  p.Wt1 = (bf16_t*)take((size_t)2 * N1 * DM * 2);
  p.Wt2 = (bf16_t*)take((size_t)2 * N2 * DM * 2);
  p.Wmem = (bf16_t*)take((size_t)2 * DM * DM * 2);
  p.Wbr = (bf16_t*)take((size_t)2 * 3 * DM * 512 * 2);
  p.Wout = (bf16_t*)take((size_t)2 * DM * DM * 2);
  p.cmvT = (bf16_t*)take((size_t)2 * 32 * 4 * 128 * 256 * 2);
  p.pmvT = (bf16_t*)take((size_t)2 * 2 * 4 * 128 * 256 * 2);
  p.memn = (bf16_t*)take((size_t)2 * 512 * DM * 2);
  p.rope = (float*)take((size_t)8192 * 32 * 2 * 4);
  p.hb = (bf16_t*)take((size_t)TOK * DM * 2);
  p.qa = (bf16_t*)take((size_t)TOK * 512 * 2);
  p.qi = (bf16_t*)take((size_t)TOK * 256 * 2);
  p.qm = (bf16_t*)take((size_t)TOK * 512 * 2);
  p.o_r = (bf16_t*)take((size_t)TOK * 512 * 2);
  p.wi = (float*)take((size_t)TOK * 4 * 4);
  p.R = (float*)take((size_t)TOK * RS * 4);
  p.G = (bf16_t*)p.R;
  p.yscan = (float*)take((size_t)TOK * 512 * 4);
  p.merged = (bf16_t*)p.yscan;
  p.bnd = (float*)take((size_t)(TOK / 16) * DSH * 4);
  p.bonus = (float*)take((size_t)TOK * 8 * 4);
  p.ctr = (unsigned*)take(16384);
  p.KB = (bf16_t*)take((size_t)NROWS * 128 * 2);
  p.VB = (bf16_t*)take((size_t)NROWS * 128 * 2);
  p.KIB = (bf16_t*)take((size_t)NROWS * 64 * 2);
  if (off > ws_size) {
    fprintf(stderr, "workspace too small: need %zu have %zu\n", off, ws_size);
    return;
  }
  static int grid_blocks = 0;
  if (!grid_blocks) {
    int dev = 0, cus = 0, per_cu = 0;
    (void)hipGetDevice(&dev);
    (void)hipDeviceGetAttribute(&cus, hipDeviceAttributeMultiprocessorCount, dev);
    (void)hipOccupancyMaxActiveBlocksPerMultiprocessor(&per_cu, mega, 256, 0);
    if (per_cu > 2) per_cu = 2;
    if (per_cu < 1) per_cu = 1;
    grid_blocks = (cus * per_cu) & ~7;
  }
  (void)hipMemsetAsync(p.ctr, 0, 16384, stream);
  void* args[] = {&p};
  hipError_t e = hipLaunchCooperativeKernel((void*)mega, dim3(grid_blocks), dim3(256), args, 0, stream);
  if (e != hipSuccess) fprintf(stderr, "cooperative launch failed: %s (grid %d)\n", hipGetErrorString(e), grid_blocks);
}
```

```cpp
#include <hip/hip_runtime.h>
#include <hip/hip_cooperative_groups.h>
#include <stdint.h>
#include <stdio.h>
#include <string.h>
namespace cg = cooperative_groups;

#define DI __device__ __forceinline__
#define PROBE_SKIP 2
typedef unsigned short bf16_t;
typedef __attribute__((ext_vector_type(8))) short bf16x8;
typedef __attribute__((ext_vector_type(4))) float f32x4;
typedef __attribute__((ext_vector_type(2))) float f32x2;

constexpr int DM = 1024;
constexpr int TP = 16384;
constexpr int TOK = 18432;
constexpr int DIN = 7876;
constexpr int N1 = 3328;
constexpr int N2 = 4608;
constexpr int RS = 1792;
constexpr int DSH = 1664;
constexpr int SMEM = 73728;
constexpr int SLOT = SMEM - 16;
constexpr int NROWS = 16384 + 32 * 2112;

constexpr size_t O_Y = 0;
constexpr size_t O_KP = 18874368;
constexpr size_t O_VP = O_KP + 4194304;
constexpr size_t O_KIP = O_VP + 4194304;
constexpr size_t O_WKVP = O_KIP + 2097152;
constexpr size_t O_SHP = O_WKVP + 131072;
constexpr size_t O_MKP = O_SHP + 6656;
constexpr size_t O_MVP = O_MKP + 524288;
constexpr size_t O_KS = O_MVP + 524288;
constexpr size_t O_VS = O_KS + 524288;
constexpr size_t O_KIS = O_VS + 524288;
constexpr size_t O_WKVS = O_KIS + 262144;
constexpr size_t O_SHS = O_WKVS + 2097152;

struct Params {
  const float *x_prompt, *x_sample, *mem_prompt, *cache_k, *cache_v, *cache_kidx, *state_wkv, *state_shift,
      *cache_mem_k, *cache_mem_v, *norm_g, *w_in, *mu_shift, *w0, *w2, *a0, *a2, *k_k, *k_a, *r_k, *ln_w, *ln_b,
      *mem_norm_g, *w_mem_kv, *w_br_a, *w_br_r, *w_br_m, *w_out, *final_g;
  float* out;
  bf16_t *Wt1, *Wt2, *Wmem, *Wbr, *Wout, *cmvT, *pmvT, *memn, *hb, *qa, *qi, *qm, *o_r, *merged, *G, *KB, *VB, *KIB;
  float *rope, *wi, *R, *yscan, *bnd, *bonus;
  unsigned* ctr;
};

DI int otid() { int t = __builtin_amdgcn_workitem_id_x(); asm volatile("" : "+v"(t)); return t; }
typedef __bf16 bf16x2_t __attribute__((ext_vector_type(2)));
DI unsigned pack2(float a, float b) {
  const f32x2 v = {a, b};
  const bf16x2_t r = __builtin_convertvector(v, bf16x2_t);
  return __builtin_bit_cast(unsigned, r);
}
DI bf16_t f2bf(float f) { return (bf16_t)(pack2(f, f) & 0xFFFFu); }
DI float bf2f(bf16_t b) { return __uint_as_float(((unsigned)b) << 16); }
DI bf16x8 cvt8(const float* p) {
  float4 x = *(const float4*)p, y = *(const float4*)(p + 4);
  union { bf16x8 v; unsigned u[4]; } r;
  r.u[0] = pack2(x.x, x.y); r.u[1] = pack2(x.z, x.w); r.u[2] = pack2(y.x, y.y); r.u[3] = pack2(y.z, y.w);
  return r.v;
}
template <int CTRL> DI float dpp_add(float x) {
  int y = __builtin_amdgcn_update_dpp(0, __float_as_int(x), CTRL, 0xF, 0xF, false);
  return x + __int_as_float(y);
}
DI float rowsum16(float x) {
  x = dpp_add<0xB1>(x);
  x = dpp_add<0x4E>(x);
  x = dpp_add<0x141>(x);
  x = dpp_add<0x140>(x);
  return x;
}
DI float wave_sum(float v) {
  v = rowsum16(v);
  const float a = __int_as_float(__builtin_amdgcn_readlane(__float_as_int(v), 0));
  const float b = __int_as_float(__builtin_amdgcn_readlane(__float_as_int(v), 16));
  const float c = __int_as_float(__builtin_amdgcn_readlane(__float_as_int(v), 32));
  const float d = __int_as_float(__builtin_amdgcn_readlane(__float_as_int(v), 48));
  return (a + b) + (c + d);
}
typedef __attribute__((address_space(3))) const char* lds_cptr;
typedef short v4i16_t __attribute__((ext_vector_type(4)));
typedef __attribute__((ext_vector_type(4))) short s16x4;
DI s16x4 vtr(lds_cptr p) { return __builtin_bit_cast(s16x4, __builtin_amdgcn_ds_read_tr16_b64_v4i16((__attribute__((address_space(3))) v4i16_t*)p)); }
DI float sigmoidf_(float x) { return __builtin_amdgcn_rcpf(1.f + __expf(-x)); }
DI float siluf_(float x) { return x * __builtin_amdgcn_rcpf(1.f + __expf(-x)); }
DI f32x4 mfma16(bf16x8 a, bf16x8 b, f32x4 c) { return __builtin_amdgcn_mfma_f32_16x16x32_bf16(a, b, c, 0, 0, 0); }

DI const float* xrow_ptr(const Params& p, int l, int tok) {
  if (l == 0) return tok < TP ? p.x_prompt + (size_t)tok * DM : p.x_sample + (size_t)(tok - TP) * DM;
  return p.out + (size_t)tok * DM;
}


DI unsigned xcc_id() { return (unsigned)__builtin_amdgcn_s_getreg((3 << 11) | 20) & 0xFu; }
struct GBar { unsigned* w; unsigned xcc, mycen, nx, k; };
DI void gbar_init(GBar& g, unsigned* w) {
  g.w = w; g.xcc = (unsigned)__builtin_amdgcn_readfirstlane((int)xcc_id()); g.k = 0;
  unsigned nx = 0, mycen = 0;
  for (unsigned x = 0; x < 16; x++) {
    const unsigned c = __hip_atomic_load(&w[64 + 64 * x], __ATOMIC_RELAXED, __HIP_MEMORY_SCOPE_AGENT);
    if (c) nx++;
    if (x == g.xcc) mycen = c;
  }
  g.nx = (unsigned)__builtin_amdgcn_readfirstlane((int)nx);
  g.mycen = (unsigned)__builtin_amdgcn_readfirstlane((int)mycen);
}
DI void gbar(GBar& g) {
  g.k++;
  asm volatile("s_waitcnt vmcnt(0) lgkmcnt(0)" ::: "memory");
  __syncthreads();
  if (otid() == 0) {
    const unsigned a = __hip_atomic_fetch_add(&g.w[1152 + 64 * g.xcc], 1u, __ATOMIC_RELAXED, __HIP_MEMORY_SCOPE_AGENT) + 1u;
    if (a == g.k * g.mycen) {
      __builtin_amdgcn_fence(__ATOMIC_RELEASE, "agent");
      asm volatile("s_waitcnt vmcnt(0)" ::: "memory");
      __hip_atomic_fetch_add(&g.w[2240], 1u, __ATOMIC_RELAXED, __HIP_MEMORY_SCOPE_AGENT);
    }
    while (__hip_atomic_load(&g.w[2240], __ATOMIC_RELAXED, __HIP_MEMORY_SCOPE_AGENT) < g.k * g.nx) __builtin_amdgcn_s_sleep(1);
    __builtin_amdgcn_fence(__ATOMIC_ACQUIRE, "agent");
    asm volatile("s_waitcnt vmcnt(0)" ::: "memory");
  }
  __syncthreads();
}

DI int colmap(int kind, int n) {
  if (kind == 1) {
    if (n < 1092) return n;
    if (n < 1152) return -1;
    if (n < 2816) return 1604 + (n - 1152);
    return 3780 + (n - 2816);
  } else if (kind == 2) {
    if (n < 512) return 1092 + n;
    if (n < 1024) return 3268 + (n - 512);
    if (n < 1536) return 4292 + (n - 1024);
    return 4804 + (n - 1536);
  }
  return n;
}
DI void transpose_tile(const float* __restrict__ src, int ldsrc, int kind, int k0, int n0, bf16_t* __restrict__ dst,
                       int lddst, float* tile) {
  const int tid = otid();
  float v[16];
#pragma unroll
  for (int r = 0; r < 16; r++) {
    const int kk = r * 4 + (tid >> 6), nn = tid & 63;
    const int sc = colmap(kind, n0 + nn);
    v[r] = sc >= 0 ? src[(size_t)(k0 + kk) * ldsrc + sc] : 0.f;
  }
  __syncthreads();
#pragma unroll
  for (int r = 0; r < 16; r++) tile[(r * 4 + (tid >> 6)) * 65 + (tid & 63)] = v[r];
  __syncthreads();
#pragma unroll
  for (int r = 0; r < 8; r++) {
    const int nn = r * 8 + (tid >> 5), kk = (tid & 31) * 2;
    *(unsigned*)(dst + (size_t)(n0 + nn) * lddst + k0 + kk) = pack2(tile[kk * 65 + nn], tile[(kk + 1) * 65 + nn]);
  }
}
DI void norm_row_bf16(const float* __restrict__ x, const float* __restrict__ g, bf16_t* __restrict__ dst) {
  const int lane = otid() & 63;
  float4 v[4];
  float ss = 0.f;
#pragma unroll
  for (int i = 0; i < 4; i++) {
    v[i] = *(const float4*)(x + i * 256 + lane * 4);
    ss += v[i].x * v[i].x + v[i].y * v[i].y + v[i].z * v[i].z + v[i].w * v[i].w;
  }
  ss = wave_sum(ss);
  float rstd = rsqrtf(ss * (1.f / 1024.f) + 1e-6f);
#pragma unroll
  for (int i = 0; i < 4; i++) {
    float4 gg = *(const float4*)(g + i * 256 + lane * 4);
    uint2 o;
    o.x = pack2(v[i].x * rstd * gg.x, v[i].y * rstd * gg.y);
    o.y = pack2(v[i].z * rstd * gg.z, v[i].w * rstd * gg.w);
    *(uint2*)(dst + i * 256 + lane * 4) = o;
  }
}


DI void convert_caches(const Params& p, int l) {
  const int tid = otid();
  const long total = (long)32 * 2048 * 40;
  for (long e = (long)blockIdx.x * 256 + tid; e < total; e += (long)gridDim.x * 256) {
    const int row = (int)(e / 40), c = (int)(e - (long)row * 40);
    const int b = row >> 11, pos = row & 2047;
    const size_t drow = (size_t)16384 + (size_t)b * 2112 + pos;
    const size_t srow = (size_t)(l * 32 + b) * 2048 + pos;
    if (c < 16) *(bf16x8*)(p.KB + drow * 128 + c * 8) = cvt8(p.cache_k + srow * 128 + c * 8);
    else if (c < 32) *(bf16x8*)(p.VB + drow * 128 + (c - 16) * 8) = cvt8(p.cache_v + srow * 128 + (c - 16) * 8);
    else *(bf16x8*)(p.KIB + drow * 64 + (c - 32) * 8) = cvt8(p.cache_kidx + srow * 64 + (c - 32) * 8);
  }
}

DI void phase0(const Params& p, char* smem) {
  const int tid = otid();
  float* tile = (float*)smem;
  if (tid == 0) __hip_atomic_fetch_add(&p.ctr[64 + 64 * xcc_id()], 1u, __ATOMIC_RELAXED, __HIP_MEMORY_SCOPE_AGENT);
  const int NTW = 2880;
  const int NT_ALL = 2 * NTW + 2048;
  for (int t = blockIdx.x; t < NT_ALL; t += gridDim.x) {
    if (t < 2 * NTW) {
      int l = t / NTW, r = t - l * NTW;
      if (r < 832) {
        int nt = r >> 4, kt = r & 15;
        transpose_tile(p.w_in + (size_t)l * DM * DIN, DIN, 1, kt * 64, nt * 64, p.Wt1 + (size_t)l * N1 * DM, DM, tile);
      } else if (r < 832 + 1152) {
        r -= 832;
        int nt = r >> 4, kt = r & 15;
        transpose_tile(p.w_in + (size_t)l * DM * DIN, DIN, 2, kt * 64, nt * 64, p.Wt2 + (size_t)l * N2 * DM, DM, tile);
      } else if (r < 832 + 1152 + 256) {
        r -= 1984;
        int nt = r >> 4, kt = r & 15;
        transpose_tile(p.w_mem_kv + (size_t)l * DM * DM, DM, 0, kt * 64, nt * 64, p.Wmem + (size_t)l * DM * DM, DM, tile);
      } else if (r < 2240 + 384) {
        r -= 2240;
        int br = r >> 7; r &= 127;
        int nt = r >> 3, kt = r & 7;
        const float* src = (br == 0 ? p.w_br_a : br == 1 ? p.w_br_r : p.w_br_m) + (size_t)l * 512 * DM;
        transpose_tile(src, DM, 0, kt * 64, nt * 64, p.Wbr + (size_t)(l * 3 + br) * DM * 512, 512, tile);
      } else {
        r -= 2624;
        int nt = r >> 4, kt = r & 15;
        transpose_tile(p.w_out + (size_t)l * DM * DM, DM, 0, kt * 64, nt * 64, p.Wout + (size_t)l * DM * DM, DM, tile);
      }
    } else {
      int r = t - 2 * NTW;
      int job = r >> 3, sub = r & 7;
      int lb = job >> 2, h = job & 3;
      int nt = sub >> 2, kt = sub & 3;
      transpose_tile(p.cache_mem_v + (size_t)lb * 256 * 512 + h * 128, 512, 0, kt * 64, nt * 64,
                     p.cmvT + (size_t)(lb * 4 + h) * 128 * 256, 256, tile);
    }
  }
  convert_caches(p, 0);
  for (int e = blockIdx.x * 256 + tid; e < 8192 * 32; e += gridDim.x * 256) {
    int pos = e >> 5, i = e & 31;
    float inv = powf(10000.f, -(float)(2 * i) / 64.f);
    float ang = (float)pos * inv;
    float s, c;
    sincosf(ang, &s, &c);
    p.rope[2 * e] = c;
    p.rope[2 * e + 1] = s;
  }
  const int wave = tid >> 6;
  for (int r = blockIdx.x * 4 + wave; r < 1024 + TOK; r += gridDim.x * 4) {
    if (r < 1024) {
      int l = r >> 9, row = r & 511;
      norm_row_bf16(p.mem_prompt + (size_t)row * DM, p.mem_norm_g + l * DM, p.memn + (size_t)r * DM);
    } else {
      int tok = r - 1024;
      norm_row_bf16(xrow_ptr(p, 0, tok), p.norm_g, p.hb + (size_t)tok * DM);
    }
  }
}

constexpr int LDT = 72;
constexpr int TILE_E = 128 * LDT;
DI void gemm_kloop(const bf16_t* __restrict__ A, int lda, const bf16_t* __restrict__ B, int ldb, int K, bf16_t* sm,
                   f32x4 (&acc)[4][4]) {
  const int tid = otid(), lane = tid & 63, wave = tid >> 6;
  const int wm = wave >> 1, wn = wave & 1;
  const int lrow = tid >> 3, lkc = (tid & 7) * 8;
  const unsigned toa = (unsigned)(lrow * lda + lkc), tob = (unsigned)(lrow * ldb + lkc);
  uint4 ra0_0, ra0_1, ra0_2, ra0_3, rb0_0, rb0_1, rb0_2, rb0_3, ra1_0, ra1_1, ra1_2, ra1_3, rb1_0, rb1_1, rb1_2, rb1_3;
  const int fr = lane & 15, fk = (lane >> 4) * 8;
  const int nk = K >> 6;
#define GLOAD(RA, RB, K0)                                                   \
  {                                                                         \
    RA##_0 = *(const uint4*)((A + (size_t)(K0)) + toa);                     \
    RA##_1 = *(const uint4*)((A + (size_t)(32 * lda + (K0))) + toa);        \
    RA##_2 = *(const uint4*)((A + (size_t)(64 * lda + (K0))) + toa);        \
    RA##_3 = *(const uint4*)((A + (size_t)(96 * lda + (K0))) + toa);        \
    RB##_0 = *(const uint4*)((B + (size_t)(K0)) + tob);                     \
    RB##_1 = *(const uint4*)((B + (size_t)(32 * ldb + (K0))) + tob);        \
    RB##_2 = *(const uint4*)((B + (size_t)(64 * ldb + (K0))) + tob);        \
    RB##_3 = *(const uint4*)((B + (size_t)(96 * ldb + (K0))) + tob);        \
  }
#define SSTORE(RA, RB, BUF)                                                 \
  {                                                                         \
    bf16_t* sd = sm + (BUF) * (2 * TILE_E) + lrow * LDT + lkc;              \
    *(uint4*)(sd) = RA##_0;                                                 \
    *(uint4*)(sd + 32 * LDT) = RA##_1;                                      \
    *(uint4*)(sd + 64 * LDT) = RA##_2;                                      \
    *(uint4*)(sd + 96 * LDT) = RA##_3;                                      \
    *(uint4*)(sd + TILE_E) = RB##_0;                                        \
    *(uint4*)(sd + TILE_E + 32 * LDT) = RB##_1;                             \
    *(uint4*)(sd + TILE_E + 64 * LDT) = RB##_2;                             \
    *(uint4*)(sd + TILE_E + 96 * LDT) = RB##_3;                             \
  }
#define COMPUTE(BUF)                                                        \
  {                                                                         \
    const bf16_t* sa = sm + (BUF) * (2 * TILE_E) + (wm * 64 + fr) * LDT + fk;           \
    const bf16_t* sb = sm + (BUF) * (2 * TILE_E) + TILE_E + (wn * 64 + fr) * LDT + fk;  \
    _Pragma("unroll") for (int s = 0; s < 2; s++) {                         \
      bf16x8 af[4], bfr[4];                                                 \
      _Pragma("unroll") for (int i = 0; i < 4; i++) {                       \
        af[i] = *(const bf16x8*)(sa + i * 16 * LDT + s * 32);               \
        bfr[i] = *(const bf16x8*)(sb + i * 16 * LDT + s * 32);              \
      }                                                                     \
      _Pragma("unroll") for (int i = 0; i < 4; i++)                         \
        _Pragma("unroll") for (int j = 0; j < 4; j++) acc[i][j] = mfma16(af[i], bfr[j], acc[i][j]);  \
    }                                                                       \
  }
  __syncthreads();
  GLOAD(ra0, rb0, 0)
  GLOAD(ra1, rb1, 64)
  SSTORE(ra0, rb0, 0)
  __syncthreads();
  for (int kt = 0; kt < nk - 2; kt += 2) {
    GLOAD(ra0, rb0, (kt + 2) << 6)
    COMPUTE(0)
    SSTORE(ra1, rb1, 1)
    __syncthreads();
    GLOAD(ra1, rb1, (kt + 3) << 6)
    COMPUTE(1)
    SSTORE(ra0, rb0, 0)
    __syncthreads();
  }
  COMPUTE(0)
  SSTORE(ra1, rb1, 1)
  __syncthreads();
  COMPUTE(1)
  __syncthreads();
#undef GLOAD
#undef SSTORE
#undef COMPUTE
}
DI void zero_acc(f32x4 (&acc)[4][4]) {
#pragma unroll
  for (int i = 0; i < 4; i++)
#pragma unroll
    for (int j = 0; j < 4; j++) acc[i][j] = (f32x4){0.f, 0.f, 0.f, 0.f};
}


DI void gemm_kloop64(const bf16_t* __restrict__ A, int lda, const bf16_t* __restrict__ B, int ldb, int K, bf16_t* sm,
                     f32x4 (&acc)[2][4]) {
  const int tid = otid(), lane = tid & 63, wave = tid >> 6;
  const int lrow = tid >> 3, lkc = (tid & 7) * 8;
  const unsigned toa = (unsigned)(lrow * lda + lkc), tob = (unsigned)(lrow * ldb + lkc);
  uint4 ra0_0, ra0_1, ra0_2, ra0_3, rb0_0, rb0_1, ra1_0, ra1_1, ra1_2, ra1_3, rb1_0, rb1_1;
  const int fr = lane & 15, fk = (lane >> 4) * 8;
  const int nk = K >> 6;
#define GLOAD(RA, RB, K0)                                                   \
  {                                                                         \
    RA##_0 = *(const uint4*)((A + (size_t)(K0)) + toa);                     \
    RA##_1 = *(const uint4*)((A + (size_t)(32 * lda + (K0))) + toa);        \
    RA##_2 = *(const uint4*)((A + (size_t)(64 * lda + (K0))) + toa);        \
    RA##_3 = *(const uint4*)((A + (size_t)(96 * lda + (K0))) + toa);        \
    RB##_0 = *(const uint4*)((B + (size_t)(K0)) + tob);                     \
    RB##_1 = *(const uint4*)((B + (size_t)(32 * ldb + (K0))) + tob);        \
  }
#define SSTORE(RA, RB, BUF)                                                 \
  {                                                                         \
    bf16_t* sd = sm + (BUF) * (2 * TILE_E) + lrow * LDT + lkc;              \
    *(uint4*)(sd) = RA##_0;                                                 \
    *(uint4*)(sd + 32 * LDT) = RA##_1;                                      \
    *(uint4*)(sd + 64 * LDT) = RA##_2;                                      \
    *(uint4*)(sd + 96 * LDT) = RA##_3;                                      \
    *(uint4*)(sd + TILE_E) = RB##_0;                                        \
    *(uint4*)(sd + TILE_E + 32 * LDT) = RB##_1;                             \
  }
#define COMPUTE(BUF)                                                                            \
  {                                                                                             \
    const bf16_t* sa = sm + (BUF) * (2 * TILE_E) + (wave * 32 + fr) * LDT + fk;                 \
    const bf16_t* sb = sm + (BUF) * (2 * TILE_E) + TILE_E + fr * LDT + fk;                      \
    _Pragma("unroll") for (int s = 0; s < 2; s++) {                                             \
      bf16x8 af[2], bfr[4];                                                                     \
      _Pragma("unroll") for (int i = 0; i < 2; i++) af[i] = *(const bf16x8*)(sa + i * 16 * LDT + s * 32);   \
      _Pragma("unroll") for (int j = 0; j < 4; j++) bfr[j] = *(const bf16x8*)(sb + j * 16 * LDT + s * 32);  \
      _Pragma("unroll") for (int i = 0; i < 2; i++)                                             \
        _Pragma("unroll") for (int j = 0; j < 4; j++) acc[i][j] = mfma16(af[i], bfr[j], acc[i][j]);         \
    }                                                                                           \
  }
  __syncthreads();
  GLOAD(ra0, rb0, 0)
  GLOAD(ra1, rb1, 64)
  SSTORE(ra0, rb0, 0)
  __syncthreads();
  for (int kt = 0; kt < nk - 2; kt += 2) {
    GLOAD(ra0, rb0, (kt + 2) << 6)
    COMPUTE(0)
    SSTORE(ra1, rb1, 1)
    __syncthreads();
    GLOAD(ra1, rb1, (kt + 3) << 6)
    COMPUTE(1)
    SSTORE(ra0, rb0, 0)
    __syncthreads();
  }
  COMPUTE(0)
  SSTORE(ra1, rb1, 1)
  __syncthreads();
  COMPUTE(1)
  __syncthreads();
#undef GLOAD
#undef SSTORE
#undef COMPUTE
}

DI bool xcd_tile(int e, int NNT, int& mt, int& nt) {
  const int xcd = blockIdx.x & 7;
  const int per_mb = 9 * NNT;
  if (e >= 2 * per_mb) return false;
  const int mb = e >= per_mb ? 1 : 0;
  int r = e - mb * per_mb;
  const int full = NNT >> 3, rem = NNT & 7;
  int nb = r / 72;
  int w = 8;
  if (nb >= full) { nb = full; w = rem; }
  r -= nb * 72;
  const int mi = r / w, ni = r - mi * w;
  mt = xcd * 18 + mb * 9 + mi;
  nt = nb * 8 + ni;
  return true;
}

struct TokInfo { int isP, b, t, pos; };
DI TokInfo tokinfo(int tok) {
  TokInfo ti;
  if (tok < TP) { ti.isP = 1; ti.b = tok >> 13; ti.t = tok & 8191; ti.pos = ti.t; }
  else { int s = tok - TP; ti.isP = 0; ti.b = s >> 6; ti.t = s & 63; ti.pos = 2048 + ti.t; }
  return ti;
}

DI void gemm1_phase(const Params& p, int l, char* smem) {
  bf16_t* sm = (bf16_t*)smem;
  const int tid = otid(), lane = tid & 63, wave = tid >> 6;
  const int wm = wave >> 1, wn = wave & 1, g4 = lane >> 4, cl = lane & 15;
  const int NT1 = 144 * 26;
  const int slots = gridDim.x >> 3, slot = blockIdx.x >> 3;
  const int nmain = 18 * 26;
  const int nextra = (l == 0 ? 8 : 0);
  for (int e = slot; e < nmain + nextra; e += slots) {
    f32x4 acc[4][4];
    zero_acc(acc);
    int mt = 0, nt = 0;
    const bool is_main = xcd_tile(e, 26, mt, nt);
    const int t = is_main ? 0 : NT1 + (e - nmain) * 8 + (blockIdx.x & 7);
    if (is_main) {
      gemm_kloop(p.hb + (size_t)mt * 128 * DM, DM, p.Wt1 + ((size_t)l * N1 + nt * 128) * DM, DM, DM, sm, acc);
      const int nb = nt * 128 + wn * 64;
#pragma unroll
      for (int i = 0; i < 4; i++) {
        float2 csv[4][2];
        if (nb < 1088 && !(nb >= 640 && nb < 768)) {
#pragma unroll
          for (int r = 0; r < 4; r++) {
            const TokInfo tj = tokinfo(mt * 128 + wm * 64 + i * 16 + g4 * 4 + r);
#pragma unroll
            for (int jn = 0; jn < 2; jn++) csv[r][jn] = *(const float2*)(p.rope + (size_t)(tj.pos * 32 + jn * 16 + cl) * 2);
          }
        }
#pragma unroll
        for (int r = 0; r < 4; r++) {
          const int tok = mt * 128 + wm * 64 + i * 16 + g4 * 4 + r;
          const TokInfo ti = tokinfo(tok);
          if (nb < 1088) {
            if (nb >= 640 && nb < 768) {
              float* dst = ti.isP ? p.out + O_VP + ((size_t)(l * 2 + ti.b) * 8192 + ti.t) * 128
                                  : p.out + O_VS + ((size_t)(l * 32 + ti.b) * 64 + ti.t) * 128;
              bf16_t* dvb = p.VB + (size_t)(ti.isP ? ti.b * 8192 + ti.t : 16384 + ti.b * 2112 + 2048 + ti.t) * 128;
#pragma unroll
              for (int jn = 0; jn < 4; jn++) {
                dst[nb - 640 + jn * 16 + cl] = acc[i][jn][r];
                dvb[nb - 640 + jn * 16 + cl] = f2bf(acc[i][jn][r]);
              }
            } else {
#pragma unroll
              for (int jn = 0; jn < 2; jn++) {
                const int d = jn * 16 + cl;
                const float2 cs = csv[r][jn];
                const float x1 = acc[i][jn][r], x2 = acc[i][jn + 2][r];
                const float y1 = x1 * cs.x - x2 * cs.y, y2 = x1 * cs.y + x2 * cs.x;
                const int c1 = nb + d, c2 = nb + d + 32;
                if (nb < 512) {
                  p.qa[(size_t)tok * 512 + c1] = f2bf(y1 * 0.125f);
                  p.qa[(size_t)tok * 512 + c2] = f2bf(y2 * 0.125f);
                } else if (nb < 640) {
                  float* dst = ti.isP ? p.out + O_KP + ((size_t)(l * 2 + ti.b) * 8192 + ti.t) * 128
                                      : p.out + O_KS + ((size_t)(l * 32 + ti.b) * 64 + ti.t) * 128;
                  dst[c1 - 512] = y1;
                  dst[c2 - 512] = y2;
                  bf16_t* dkb = p.KB + (size_t)(ti.isP ? ti.b * 8192 + ti.t : 16384 + ti.b * 2112 + 2048 + ti.t) * 128;
                  dkb[c1 - 512] = f2bf(y1);
                  dkb[c2 - 512] = f2bf(y2);
                } else if (nb < 1024) {
                  p.qi[(size_t)tok * 256 + c1 - 768] = f2bf(y1 * 0.125f);
                  p.qi[(size_t)tok * 256 + c2 - 768] = f2bf(y2 * 0.125f);
                } else {
                  float* dst = ti.isP ? p.out + O_KIP + ((size_t)(l * 2 + ti.b) * 8192 + ti.t) * 64
                                      : p.out + O_KIS + ((size_t)(l * 32 + ti.b) * 64 + ti.t) * 64;
                  dst[c1 - 1024] = y1;
                  dst[c2 - 1024] = y2;
                  bf16_t* dib = p.KIB + (size_t)(ti.isP ? ti.b * 8192 + ti.t : 16384 + ti.b * 2112 + 2048 + ti.t) * 64;
                  dib[c1 - 1024] = f2bf(y1);
                  dib[c2 - 1024] = f2bf(y2);
                }
              }
            }
          } else if (nb == 1088) {
            if (cl < 4) p.wi[(size_t)tok * 4 + cl] = acc[i][0][r] * 0.5f;
          } else if (nb < 2816) {
            const int T = ti.isP ? 8192 : 64;
#pragma unroll
            for (int jn = 0; jn < 4; jn++) {
              const int c = nb - 1152 + jn * 16 + cl;
              const float v = acc[i][jn][r];
              p.R[(size_t)tok * RS + c] = v;
              if (ti.t == T - 1) {
                float* dst = ti.isP ? p.out + O_SHP + (size_t)(l * 2 + ti.b) * DSH : p.out + O_SHS + (size_t)(l * 32 + ti.b) * DSH;
                dst[c] = v;
              }
              if ((tok & 15) == 15) p.bnd[(size_t)(tok >> 4) * DSH + c] = v;
            }
          } else {
#pragma unroll
            for (int jn = 0; jn < 4; jn++)
              p.qm[(size_t)tok * 512 + nb - 2816 + jn * 16 + cl] = f2bf(acc[i][jn][r] * 0.08838834764831845f);
          }
        }
      }
    } else {
      const int u = t - NT1;
      const int lm = u >> 5, mt = (u >> 3) & 3, nt = u & 7;
      gemm_kloop(p.memn + ((size_t)lm * 512 + mt * 128) * DM, DM, p.Wmem + ((size_t)lm * DM + nt * 128) * DM, DM, DM, sm, acc);
#pragma unroll
      for (int i = 0; i < 4; i++)
#pragma unroll
        for (int r = 0; r < 4; r++) {
          const int row = mt * 128 + wm * 64 + i * 16 + g4 * 4 + r;
          const int bm = row >> 8, m = row & 255;
#pragma unroll
          for (int jn = 0; jn < 4; jn++) {
            const int n = nt * 128 + wn * 64 + jn * 16 + cl;
            const float v = acc[i][jn][r];
            if (n < 512) {
              p.out[O_MKP + ((size_t)(lm * 2 + bm) * 256 + m) * 512 + n] = v;
            } else {
              const int n2 = n - 512;
              p.out[O_MVP + ((size_t)(lm * 2 + bm) * 256 + m) * 512 + n2] = v;
              p.pmvT[((size_t)((lm * 2 + bm) * 4 + (n2 >> 7)) * 128 + (n2 & 127)) * 256 + m] = f2bf(v);
            }
          }
        }
    }
  }
}

DI void prep_phase(const Params& p, int l, char* smem, const bool dry = false) {
  float* rows = (float*)smem;
  float* tw = rows + 9 * DSH;
  float* ta = tw + 512;
  const int tid = otid(), lane = tid & 63, wave = tid >> 6;
  const float* mu = p.mu_shift + l * DSH;
  const float* w2 = p.w2 + (size_t)l * 64 * 512;
  const float* a2 = p.a2 + (size_t)l * 64 * 512;
  for (int task = blockIdx.x; task < TOK / 16; task += gridDim.x) {
    const int tok0 = task * 16;
    const TokInfo t0 = tokinfo(tok0);
    __syncthreads();
    for (int c = tid; c < DSH; c += 256) {
      float pv;
      if (t0.t == 0) pv = t0.isP ? 0.f : p.state_shift[(size_t)(l * 32 + t0.b) * DSH + c];
      else pv = p.bnd[(size_t)(task - 1) * DSH + c];
      rows[c] = pv;
    }
    for (int batch = 0; batch < 2; batch++) {
      const int tb = tok0 + batch * 8;
      __syncthreads();
      for (int f = tid; f < 8 * 416; f += 256) {
        int tk = f / 416, c4 = f - tk * 416;
        *(float4*)(rows + (tk + 1) * DSH + c4 * 4) = *(const float4*)(p.R + (size_t)(tb + tk) * RS + c4 * 4);
      }
      __syncthreads();
      for (int idx = tid; idx < 1024; idx += 256) {
        int tk = idx >> 7, ii = idx & 127;
        int col = 1536 + ii;
        float cur = rows[(tk + 1) * DSH + col], prv = rows[tk * DSH + col];
        float m = cur + (prv - cur) * mu[col];
        if (ii < 64) tw[tk * 64 + ii] = 1.f - 2.f * __builtin_amdgcn_rcpf(1.f + __expf(2.f * m));
        else ta[tk * 64 + ii - 64] = m;
      }
      __syncthreads();
      float accw[2][8], acca[2][8];
#pragma unroll
      for (int ch = 0; ch < 2; ch++) {
        const int c = tid + 256 * ch;
        const float bw = p.w0[l * 512 + c], ba = p.a0[l * 512 + c];
#pragma unroll
        for (int tk = 0; tk < 8; tk++) { accw[ch][tk] = bw; acca[ch][tk] = ba; }
      }
      for (int i4 = 0; i4 < 16; i4++) {
        float4 twv[8], tav[8];
#pragma unroll
        for (int tk = 0; tk < 8; tk++) {
          twv[tk] = *(const float4*)(tw + tk * 64 + i4 * 4);
          tav[tk] = *(const float4*)(ta + tk * 64 + i4 * 4);
        }
#pragma unroll
        for (int ii = 0; ii < 4; ii++) {
          const int i = i4 * 4 + ii;
#pragma unroll
          for (int ch = 0; ch < 2; ch++) {
            const int c = tid + 256 * ch;
            const float wv = w2[i * 512 + c], av = a2[i * 512 + c];
#pragma unroll
            for (int tk = 0; tk < 8; tk++) {
              const float x = ii == 0 ? twv[tk].x : ii == 1 ? twv[tk].y : ii == 2 ? twv[tk].z : twv[tk].w;
              const float y = ii == 0 ? tav[tk].x : ii == 1 ? tav[tk].y : ii == 2 ? tav[tk].z : tav[tk].w;
              accw[ch][tk] += x * wv;
              acca[ch][tk] += y * av;
            }
          }
        }
      }
#pragma unroll
      for (int ch = 0; ch < 2; ch++) {
        const int c = tid + 256 * ch;
        const int head = wave + 4 * ch;
        const float muR = mu[c], muK = mu[512 + c], muV = mu[1024 + c];
        const float kkc = p.k_k[l * 512 + c], kac = p.k_a[l * 512 + c], rkc = p.r_k[l * 512 + c];
#pragma unroll
        for (int tk = 0; tk < 8; tk++) {
          const float* rc = rows + (tk + 1) * DSH;
          const float* rp = rows + tk * DSH;
          const float r = rc[c] + (rp[c] - rc[c]) * muR;
          const float k = rc[512 + c] + (rp[512 + c] - rc[512 + c]) * muK;
          const float v = rc[1024 + c] + (rp[1024 + c] - rc[1024 + c]) * muV;
          const float xw = -accw[ch][tk];
          const float sp = fmaxf(xw, 0.f) + __logf(1.f + __expf(-fabsf(xw)));
          const float w = -sp - 0.5f;
          const float decay = __expf(-__expf(w));
          const float ag = __builtin_amdgcn_rcpf(1.f + __expf(-acca[ch][tk]));
          const float kkr = k * kkc;
          const float ss = wave_sum(kkr * kkr);
          const float kk = kkr * fminf(__builtin_amdgcn_rsqf(ss), 1e12f);
          const float kp = k * (1.f + (ag - 1.f) * kac);
          const float bon = wave_sum(r * kp * rkc);
          float* Rrow = p.R + (size_t)(tb + tk) * RS;
          bf16_t* Rb = (bf16_t*)(Rrow + 512);
          if (!dry) {
            Rrow[c] = decay;
            Rb[c] = f2bf(r);
            Rb[512 + c] = f2bf(kp);
            Rb[1024 + c] = f2bf(v);
            Rb[1536 + c] = f2bf(-kk);
            Rb[2048 + c] = f2bf(kk * ag);
            if (lane == 0) p.bonus[(size_t)(tb + tk) * 8 + head] = bon;
          } else if (decay + r + kp + v + kk + bon == 1.2345e30f) p.wi[0] = 1.f;
        }
      }
      __syncthreads();
      for (int c = tid; c < DSH; c += 256) rows[c] = rows[8 * DSH + c];
    }
  }
}

DI void scan_task(const Params& p, int l, int isP, int b, int h, int rg, char* smem, const bool dry) {
  float* buf = (float*)smem;
  float* vbuf = buf + 2 * 5 * 16 * 64;
  const int tid = otid(), lane = tid & 63, wave = tid >> 6;
  const int g4 = lane >> 4, jq = lane & 15;
  const int T = isP ? 8192 : 64;
  const int tokbase = isP ? b * 8192 : TP + b * 64;
  const int i = rg * 16 + wave * 4 + g4;
  f32x2 Sa = {0.f, 0.f}, Sb = {0.f, 0.f};
  if (!isP) {
    const float4 s = *(const float4*)(p.state_wkv + ((size_t)((l * 32 + b) * 8 + h) * 64 + i) * 64 + jq * 4);
    Sa = (f32x2){s.x, s.y}; Sb = (f32x2){s.z, s.w};
  }
  __builtin_amdgcn_s_setprio(3);
  const int ds = tid >> 4, dj = tid & 15;
  float4 rd;
  uint4 rbf[2], rv;
  const int nch = T >> 4;
  auto gload = [&](int c) {
    const int tk = tokbase + c * 16;
    rd = *(const float4*)(p.R + (size_t)(tk + ds) * RS + h * 64 + dj * 4);
#pragma unroll
    for (int u = 0; u < 2; u++) {
      const int id = tid + 256 * u;
      const int arr = id >> 7, s = (id >> 3) & 15, ch8 = id & 7;
      const int aofs = arr == 0 ? 0 : arr == 1 ? 512 : arr == 2 ? 1536 : 2048;
      rbf[u] = *(const uint4*)((const bf16_t*)(p.R + (size_t)(tk + s) * RS + 512) + aofs + h * 64 + ch8 * 8);
    }
    if (tid < 32) {
      const int s = tid >> 1, half = tid & 1;
      rv = *(const uint4*)((const bf16_t*)(p.R + (size_t)(tk + s) * RS + 512) + 1024 + h * 64 + rg * 16 + half * 8);
    }
  };
  auto sstore = [&](int bi) {
    float* bb = buf + bi * (5 * 16 * 64);
    *(float4*)(bb + ds * 64 + dj * 4) = rd;
#pragma unroll
    for (int u = 0; u < 2; u++) {
      const int id = tid + 256 * u;
      const int arr = id >> 7, s = (id >> 3) & 15, ch8 = id & 7;
      float* d = bb + (arr + 1) * (16 * 64) + s * 64 + ch8 * 8;
      const unsigned w[4] = {rbf[u].x, rbf[u].y, rbf[u].z, rbf[u].w};
      float4 lo, hi;
      lo.x = __uint_as_float(w[0] << 16); lo.y = __uint_as_float(w[0] & 0xFFFF0000u);
      lo.z = __uint_as_float(w[1] << 16); lo.w = __uint_as_float(w[1] & 0xFFFF0000u);
      hi.x = __uint_as_float(w[2] << 16); hi.y = __uint_as_float(w[2] & 0xFFFF0000u);
      hi.z = __uint_as_float(w[3] << 16); hi.w = __uint_as_float(w[3] & 0xFFFF0000u);
      *(float4*)d = lo;
      *(float4*)(d + 4) = hi;
    }
    if (tid < 32) {
      const int s = tid >> 1, half = tid & 1;
      float* d = vbuf + bi * 256 + s * 16 + half * 8;
      const unsigned w[4] = {rv.x, rv.y, rv.z, rv.w};
#pragma unroll
      for (int q = 0; q < 4; q++) {
        d[2 * q] = __uint_as_float(w[q] << 16);
        d[2 * q + 1] = __uint_as_float(w[q] & 0xFFFF0000u);
      }
    }
  };
  __syncthreads();
  gload(0);
  sstore(0);
  __syncthreads();
  for (int c = 0; c < nch; c++) {
    const bool more = c + 1 < nch;
    if (more) gload(c + 1);
    const float* bb = buf + (c & 1) * (5 * 16 * 64);
    const float* vb = vbuf + (c & 1) * 256;
    float* yo = p.yscan + (size_t)(tokbase + c * 16 + jq) * 512 + h * 64 + i;
    float ykeep = 0.f;
    f32x4 w4 = *(const f32x4*)(bb + jq * 4);
    f32x4 r4 = *(const f32x4*)(bb + 1024 + jq * 4);
    f32x4 k4 = *(const f32x4*)(bb + 2048 + jq * 4);
    f32x4 a4 = *(const f32x4*)(bb + 3072 + jq * 4);
    f32x4 b4 = *(const f32x4*)(bb + 4096 + jq * 4);
    float v = vb[wave * 4 + g4];
#pragma unroll
    for (int s = 0; s < 16; s++) {
      f32x4 w4n = w4, r4n = r4, k4n = k4, a4n = a4, b4n = b4;
      float vn = v;
      if (s < 15) {
        w4n = *(const f32x4*)(bb + (s + 1) * 64 + jq * 4);
        r4n = *(const f32x4*)(bb + 1024 + (s + 1) * 64 + jq * 4);
        k4n = *(const f32x4*)(bb + 2048 + (s + 1) * 64 + jq * 4);
        a4n = *(const f32x4*)(bb + 3072 + (s + 1) * 64 + jq * 4);
        b4n = *(const f32x4*)(bb + 4096 + (s + 1) * 64 + jq * 4);
        vn = vb[(s + 1) * 16 + wave * 4 + g4];
      }
      __builtin_amdgcn_sched_barrier(0);
      const f32x2 vv = {v, v};
      const f32x2 t = Sa * a4.lo + Sb * a4.hi;
      const f32x2 na = Sa * w4.lo + vv * k4.lo;
      const f32x2 nb = Sb * w4.hi + vv * k4.hi;
      const float sa = rowsum16(t.x + t.y);
      const f32x2 sv = {sa, sa};
      Sa = na + sv * b4.lo;
      Sb = nb + sv * b4.hi;
      const f32x2 yy = Sa * r4.lo + Sb * r4.hi;
      const float y = rowsum16(yy.x + yy.y);
      ykeep = (jq == s) ? y : ykeep;
      w4 = w4n; r4 = r4n; k4 = k4n; a4 = a4n; b4 = b4n; v = vn;
    }
    if (!dry) *yo = ykeep;
    if (more) sstore((c + 1) & 1);
    __syncthreads();
  }
  float* so = isP ? p.out + O_WKVP + ((size_t)((l * 2 + b) * 8 + h) * 64 + i) * 64 + jq * 4
                  : p.out + O_WKVS + ((size_t)((l * 32 + b) * 8 + h) * 64 + i) * 64 + jq * 4;
  if (!dry) *(float4*)so = make_float4(Sa.x, Sa.y, Sb.x, Sb.y);
  __builtin_amdgcn_s_setprio(0);
}

DI void mem_task(const Params& p, int l, int tok0, char* smem, const bool dry) {
  bf16_t* st = (bf16_t*)smem;
  const int tid = otid(), lane = tid & 63, wave = tid >> 6;
  const int g4 = lane >> 4, cl = lane & 15;
  const TokInfo ti = tokinfo(tok0);
  const float* Kb = ti.isP ? p.out + O_MKP + (size_t)(l * 2 + ti.b) * 256 * 512
                           : p.cache_mem_k + (size_t)(l * 32 + ti.b) * 256 * 512;
  const bf16_t* Vb = ti.isP ? p.pmvT + (size_t)(l * 2 + ti.b) * 4 * 128 * 256
                            : p.cmvT + (size_t)(l * 32 + ti.b) * 4 * 128 * 256;
  const int q0 = tok0 + wave * 16;
  for (int h = 0; h < 4; h++) {
    bf16x8 qf[4];
#pragma unroll
    for (int ks = 0; ks < 4; ks++) qf[ks] = *(const bf16x8*)(p.qm + (size_t)(q0 + cl) * 512 + h * 128 + ks * 32 + g4 * 8);
    __syncthreads();
    {
      const float* kp = Kb + (size_t)(tid >> 5) * 512 + h * 128 + (tid & 31) * 4;
      bf16_t* sp = st + (tid >> 5) * 136 + (tid & 31) * 4;
#pragma unroll 1
      for (int hb2 = 0; hb2 < 4; hb2++) {
        float4 kv[8];
#pragma unroll
        for (int u = 0; u < 8; u++) kv[u] = *(const float4*)(kp + (size_t)u * 8 * 512);
#pragma unroll
        for (int u = 0; u < 8; u++) {
          uint2 w;
          w.x = pack2(kv[u].x, kv[u].y);
          w.y = pack2(kv[u].z, kv[u].w);
          *(uint2*)(sp + u * 8 * 136) = w;
        }
        kp += 64 * 512;
        sp += 64 * 136;
      }
    }
    __syncthreads();
    f32x4 S[16];
#pragma unroll
    for (int mt = 0; mt < 16; mt++) {
      f32x4 a = (f32x4){0.f, 0.f, 0.f, 0.f};
      const bf16_t* kr = st + (mt * 16 + cl) * 136 + g4 * 8;
#pragma unroll
      for (int ks = 0; ks < 4; ks++) a = mfma16(*(const bf16x8*)(kr + ks * 32), qf[ks], a);
      S[mt] = a;
      if ((mt & 1) == 1) __builtin_amdgcn_sched_barrier(0);
    }
    float m = -1e30f;
#pragma unroll
    for (int mt = 0; mt < 16; mt++)
#pragma unroll
      for (int r = 0; r < 4; r++) m = fmaxf(m, S[mt][r]);
    m = fmaxf(m, __shfl_xor(m, 16));
    m = fmaxf(m, __shfl_xor(m, 32));
    float sum = 0.f;
#pragma unroll
    for (int mt = 0; mt < 16; mt++)
#pragma unroll
      for (int r = 0; r < 4; r++) {
        const float e = __expf(S[mt][r] - m);
        S[mt][r] = e;
        sum += e;
      }
    sum += __shfl_xor(sum, 16);
    sum += __shfl_xor(sum, 32);
    const float inv = __builtin_amdgcn_rcpf(sum);
    __syncthreads();
    {
      const bf16_t* vp = Vb + (size_t)h * 128 * 256 + (size_t)(tid >> 5) * 256 + (tid & 31) * 8;
      bf16_t* sp = st + (tid >> 5) * 264 + (tid & 31) * 8;
#pragma unroll 1
      for (int hb2 = 0; hb2 < 2; hb2++) {
        uint4 vv[8];
#pragma unroll
        for (int u = 0; u < 8; u++) vv[u] = *(const uint4*)(vp + (size_t)u * 8 * 256);
#pragma unroll
        for (int u = 0; u < 8; u++) *(uint4*)(sp + u * 8 * 264) = vv[u];
        vp += 64 * 256;
        sp += 64 * 264;
      }
    }
    __syncthreads();
    f32x4 o[8];
#pragma unroll
    for (int dt = 0; dt < 8; dt++) o[dt] = (f32x4){0.f, 0.f, 0.f, 0.f};
#pragma unroll
    for (int kk = 0; kk < 8; kk++) {
      union { bf16x8 v; unsigned u[4]; } pf;
      pf.u[0] = pack2(S[2 * kk][0], S[2 * kk][1]);
      pf.u[1] = pack2(S[2 * kk][2], S[2 * kk][3]);
      pf.u[2] = pack2(S[2 * kk + 1][0], S[2 * kk + 1][1]);
      pf.u[3] = pack2(S[2 * kk + 1][2], S[2 * kk + 1][3]);
#pragma unroll
      for (int dt = 0; dt < 8; dt++) {
        const bf16_t* vr = st + (dt * 16 + cl) * 264 + (2 * kk) * 16 + g4 * 4;
        union { bf16x8 v; uint2 u[2]; } vf;
        vf.u[0] = *(const uint2*)vr;
        vf.u[1] = *(const uint2*)(vr + 16);
        o[dt] = mfma16(vf.v, pf.v, o[dt]);
      }
      __builtin_amdgcn_sched_barrier(0);
    }
#pragma unroll
    for (int dt = 0; dt < 8; dt++) {
      uint2 stv;
      stv.x = pack2(o[dt][0] * inv, o[dt][1] * inv);
      stv.y = pack2(o[dt][2] * inv, o[dt][3] * inv);
      if (!dry) *(uint2*)(p.qm + (size_t)(q0 + cl) * 512 + h * 128 + dt * 16 + g4 * 4) = stv;
    }
  }
}

DI unsigned mono_key(float f) {
  const int u = __float_as_int(f + 0.0f);
  return (unsigned)u ^ ((unsigned)(u >> 31) | 0x80000000u);
}
DI float relu_(float x) { return __builtin_amdgcn_fmed3f(x, 0.f, __builtin_inff()); }

DI void dsa_task(const Params& p, int l, int isP, int b, int tq, char* smem, const bool dry) {
  unsigned* hist = (unsigned*)smem;
  unsigned short* idxl = (unsigned short*)(smem + 16384);
  unsigned short* tiel = (unsigned short*)smem;
  bf16_t* kst = (bf16_t*)(smem + 24576);
  float* pl = (float*)(smem + 24576);
  float* op = (float*)(smem + 32768);
  float* ml = (float*)(smem + 40960);
  unsigned* cnt = (unsigned*)(smem + 61440);
  unsigned* res = (unsigned*)(smem + 61504);
  unsigned* ccnt = (unsigned*)(smem + 61632);
  unsigned* ovf = (unsigned*)(smem + 61696);
  unsigned* ckey = (unsigned*)(smem + 61952);
  unsigned* cidx = (unsigned*)(smem + 66048);
  const int tid = otid(), lane = tid & 63, wave = tid >> 6;
  const int g4 = lane >> 4, cl = lane & 15;
  const int tokq0 = (isP ? b * 8192 : TP + b * 64) + tq;
  const int S = isP ? ((tq >> 6) + 1) * 64 : 2112;
  const size_t seqbase = isP ? (size_t)b * 8192 : (size_t)16384 + (size_t)b * 2112;
  const bf16_t* KIs = p.KIB + seqbase * 64;
  const bf16_t* Ks = p.KB + seqbase * 128;
  const bf16_t* Vs = p.VB + seqbase * 128;
  const int nsel = S < 256 ? S : 256;
  __syncthreads();
  if (S <= 256) {
    for (int e = tid; e < 16 * 256; e += 256) idxl[e] = (unsigned short)(e & 255);
  } else {
    const int qloc = wave * 4 + g4;
    bf16x8 aq0, aq1;
    {
      const bf16_t* qp = p.qi + ((size_t)(tokq0 + wave * 4) * 4 + cl) * 64 + g4 * 8;
      aq0 = *(const bf16x8*)qp;
      aq1 = *(const bf16x8*)(qp + 32);
    }
    const float4 wq = *(const float4*)(p.wi + (size_t)(tokq0 + qloc) * 4);
    unsigned prefix = 0u, need = 256u;
    const int nchunks = (S + 255) >> 8;
    const int skey = tid >> 3, sc8 = (tid & 7) * 8;
    for (int pass = 0; pass < 6; pass++) {
      const int kind = (pass == 2) ? 1 : (pass == 5) ? 2 : 0;
      const int shift = pass == 0 ? 24 : pass == 1 ? 16 : pass == 3 ? 8 : 0;
      if (kind == 0) {
        for (int e = tid; e < 1024; e += 256) ((uint4*)hist)[e] = make_uint4(0, 0, 0, 0);
      } else {
        if (tid < 16) { cnt[tid] = 0u; ccnt[tid] = 0u; }
        if (tid == 16) *ovf = 0u;
      }
      unsigned tiecnt = 0u;
      const unsigned G = 256u - need;
      uint4 rg0, rg1, rg2, rg3, rg4, rg5, rg6, rg7;
#define KLOAD(KC)                                                                            \
  {                                                                                          \
    const bf16_t* src = KIs + (size_t)((KC) * 256 + skey) * 64 + sc8;                        \
    const int kb0 = (KC) * 256 + skey;                                                       \
    if (kb0 < S) rg0 = *(const uint4*)(src);                                                 \
    if (kb0 + 32 < S) rg1 = *(const uint4*)(src + 32 * 64);                                  \
    if (kb0 + 64 < S) rg2 = *(const uint4*)(src + 64 * 64);                                  \
    if (kb0 + 96 < S) rg3 = *(const uint4*)(src + 96 * 64);                                  \
    if (kb0 + 128 < S) rg4 = *(const uint4*)(src + 128 * 64);                                \
    if (kb0 + 160 < S) rg5 = *(const uint4*)(src + 160 * 64);                                \
    if (kb0 + 192 < S) rg6 = *(const uint4*)(src + 192 * 64);                                \
    if (kb0 + 224 < S) rg7 = *(const uint4*)(src + 224 * 64);                                \
  }
      rg0 = rg1 = rg2 = rg3 = rg4 = rg5 = rg6 = rg7 = make_uint4(0, 0, 0, 0);
      KLOAD(0)
      for (int kc = 0; kc < nchunks; kc++) {
        __syncthreads();
        {
          bf16_t* d = kst + skey * 72 + sc8;
          *(uint4*)(d) = rg0;
          *(uint4*)(d + 32 * 72) = rg1;
          *(uint4*)(d + 64 * 72) = rg2;
          *(uint4*)(d + 96 * 72) = rg3;
          *(uint4*)(d + 128 * 72) = rg4;
          *(uint4*)(d + 160 * 72) = rg5;
          *(uint4*)(d + 192 * 72) = rg6;
          *(uint4*)(d + 224 * 72) = rg7;
        }
        __syncthreads();
        if (kc + 1 < nchunks) KLOAD(kc + 1)
        const int ngrp = (S - kc * 256) >= 256 ? 4 : ((S - kc * 256) >> 6);
        for (int tg = 0; tg < ngrp; tg++) {
          unsigned keys[4];
#pragma unroll
          for (int tt = 0; tt < 4; tt++) {
            const bf16_t* br = kst + ((tg * 4 + tt) * 16 + cl) * 72 + g4 * 8;
            const bf16x8 b0 = *(const bf16x8*)br;
            const bf16x8 b1 = *(const bf16x8*)(br + 32);
            f32x4 a = (f32x4){0.f, 0.f, 0.f, 0.f};
            a = mfma16(aq0, b0, a);
            a = mfma16(aq1, b1, a);
            const float score = wq.x * relu_(a[0]) + wq.y * relu_(a[1]) + wq.z * relu_(a[2]) + wq.w * relu_(a[3]);
            keys[tt] = mono_key(score);
          }
#pragma unroll
          for (int tt = 0; tt < 4; tt++) {
            const unsigned key = keys[tt];
            const int kidx = kc * 256 + (tg * 4 + tt) * 16 + cl;
            if (kind == 0) {
              const bool match = (pass == 0) || ((key >> (shift + 8)) == prefix);
              if (match) atomicAdd(&hist[qloc * 256 + ((key >> shift) & 255u)], 1u);
            } else if (kind == 1) {
              const unsigned hk = key >> 16;
              const bool tz = (hk == prefix) && ((key & 0xFFFFu) == 0u);
              if (hk > prefix) {
                const unsigned slot = atomicAdd(&cnt[qloc], 1u);
                if (slot < 256u) idxl[qloc * 256 + slot] = (unsigned short)kidx;
              } else if (hk == prefix && !tz) {
                const unsigned c = atomicAdd(&ccnt[qloc], 1u);
                if (c < 64u) { ckey[qloc * 64 + c] = key; cidx[qloc * 64 + c] = (unsigned)kidx; }
              }
              const unsigned long long bm = __ballot(tz);
              if (bm != 0ull) {
                const unsigned mg = (unsigned)(bm >> (g4 * 16)) & 0xFFFFu;
                const unsigned rank = tiecnt + __popc(mg & ((1u << cl) - 1u));
                if (tz && rank < need) tiel[qloc * 256 + rank] = (unsigned short)kidx;
                tiecnt += __popc(mg);
              }
            } else {
              if (key > prefix) {
                const unsigned slot = atomicAdd(&cnt[qloc], 1u);
                if (slot < 256u) idxl[qloc * 256 + slot] = (unsigned short)kidx;
              }
              const bool eq = (key == prefix);
              const unsigned long long bm = __ballot(eq);
              if (bm != 0ull) {
                const unsigned mg = (unsigned)(bm >> (g4 * 16)) & 0xFFFFu;
                const unsigned rank = tiecnt + __popc(mg & ((1u << cl) - 1u));
                if (eq && rank < need) idxl[qloc * 256 + G + rank] = (unsigned short)kidx;
                tiecnt += __popc(mg);
              }
            }
          }
        }
      }
#undef KLOAD
      __syncthreads();
      if (kind == 0) {
        const unsigned* hq = hist + qloc * 256;
        const int top = 255 - 16 * cl;
        unsigned sum = 0u;
#pragma unroll
        for (int u = 0; u < 16; u++) sum += hq[top - u];
        unsigned incl = sum;
#pragma unroll
        for (int d = 1; d < 16; d <<= 1) {
          const unsigned t = __shfl_up(incl, d, 16);
          if (cl >= d) incl += t;
        }
        const unsigned excl = incl - sum;
        if (excl < need && incl >= need) {
          unsigned cum = excl;
          int bsel = top - 15;
          unsigned above = excl;
          bool found = false;
#pragma unroll
          for (int u = 0; u < 16; u++) {
            const unsigned c = hq[top - u];
            if (!found && cum + c >= need) { bsel = top - u; above = cum; found = true; }
            cum += c;
          }
          res[qloc * 2] = (unsigned)bsel;
          res[qloc * 2 + 1] = above;
        }
        __syncthreads();
        const unsigned bstar = res[qloc * 2], above = res[qloc * 2 + 1];
        need -= above;
        prefix = (prefix << 8) | bstar;
      } else if (kind == 1) {
        const unsigned c = ccnt[qloc];
        if (c > 64u) {
          if (cl == 0) *ovf = 1u;
        } else {
          for (unsigned i = cl; i < c; i += 16) {
            const unsigned ki = ckey[qloc * 64 + i], ii = cidx[qloc * 64 + i];
            unsigned rank = 0u;
            for (unsigned j = 0; j < c; j++) {
              const unsigned kj = ckey[qloc * 64 + j], ij = cidx[qloc * 64 + j];
              rank += (kj > ki || (kj == ki && ij < ii)) ? 1u : 0u;
            }
            if (rank < need) idxl[qloc * 256 + G + rank] = (unsigned short)ii;
          }
          const unsigned nso = c < need ? c : need;
          for (unsigned t = cl; t < need - nso; t += 16) idxl[qloc * 256 + G + nso + t] = tiel[qloc * 256 + t];
        }
        __syncthreads();
        if (*ovf == 0u) break;
      }
    }
  }
  __syncthreads();
  float* opq = (float*)smem;
  float* mlq = (float*)(smem + 61952);
  char* vst = smem + 24576 + wave * 9216;
  const bool active = wave * 64 < nsel;
  uint4 vq0, vq1, vq2, vq3, vq4, vq5, vq6, vq7, vq8, vq9, vq10, vq11, vq12, vq13, vq14, vq15;
  bf16x8 kf[2][4][2];
  if (active) {
    vq0 = *(const uint4*)(Vs + (size_t)idxl[wave * 64 + 0 + g4] * 128 + cl * 8);
    vq1 = *(const uint4*)(Vs + (size_t)idxl[wave * 64 + 4 + g4] * 128 + cl * 8);
    vq2 = *(const uint4*)(Vs + (size_t)idxl[wave * 64 + 8 + g4] * 128 + cl * 8);
    vq3 = *(const uint4*)(Vs + (size_t)idxl[wave * 64 + 12 + g4] * 128 + cl * 8);
    vq4 = *(const uint4*)(Vs + (size_t)idxl[wave * 64 + 16 + g4] * 128 + cl * 8);
    vq5 = *(const uint4*)(Vs + (size_t)idxl[wave * 64 + 20 + g4] * 128 + cl * 8);
    vq6 = *(const uint4*)(Vs + (size_t)idxl[wave * 64 + 24 + g4] * 128 + cl * 8);
    vq7 = *(const uint4*)(Vs + (size_t)idxl[wave * 64 + 28 + g4] * 128 + cl * 8);
    vq8 = *(const uint4*)(Vs + (size_t)idxl[wave * 64 + 32 + g4] * 128 + cl * 8);
    vq9 = *(const uint4*)(Vs + (size_t)idxl[wave * 64 + 36 + g4] * 128 + cl * 8);
    vq10 = *(const uint4*)(Vs + (size_t)idxl[wave * 64 + 40 + g4] * 128 + cl * 8);
    vq11 = *(const uint4*)(Vs + (size_t)idxl[wave * 64 + 44 + g4] * 128 + cl * 8);
    vq12 = *(const uint4*)(Vs + (size_t)idxl[wave * 64 + 48 + g4] * 128 + cl * 8);
    vq13 = *(const uint4*)(Vs + (size_t)idxl[wave * 64 + 52 + g4] * 128 + cl * 8);
    vq14 = *(const uint4*)(Vs + (size_t)idxl[wave * 64 + 56 + g4] * 128 + cl * 8);
    vq15 = *(const uint4*)(Vs + (size_t)idxl[wave * 64 + 60 + g4] * 128 + cl * 8);
#pragma unroll
    for (int tt = 0; tt < 4; tt++) {
      const int pos = idxl[wave * 64 + tt * 16 + cl];
#pragma unroll
      for (int j = 0; j < 2; j++) {
        const bf16_t* kr = Ks + (size_t)pos * 128 + j * 64 + g4 * 8;
        kf[j][tt][0] = *(const bf16x8*)kr;
        kf[j][tt][1] = *(const bf16x8*)(kr + 32);
      }
    }
  }
  for (int qq = 0; qq < 16; qq++) {
    const int tok = tokq0 + qq;
    const int qn = qq < 15 ? qq + 1 : 15;
    float* opb = opq + (qq & 1) * 2048;
    float* mlb = mlq + (qq & 1) * 64;
    if (active) {
      union PB { bf16x8 v; unsigned u[4]; };
      PB pb[2][2];
#pragma unroll
      for (int j = 0; j < 2; j++) {
        const bf16_t* qp = p.qa + (size_t)tok * 512 + (j * 4 + (cl & 3)) * 64 + g4 * 8;
        const bf16x8 bq0 = *(const bf16x8*)qp;
        const bf16x8 bq1 = *(const bf16x8*)(qp + 32);
        f32x4 lg[4];
#pragma unroll
        for (int tt = 0; tt < 4; tt++) {
          f32x4 a = (f32x4){0.f, 0.f, 0.f, 0.f};
          a = mfma16(kf[j][tt][0], bq0, a);
          a = mfma16(kf[j][tt][1], bq1, a);
          lg[tt] = a;
        }
        float m = -1e30f;
#pragma unroll
        for (int tt = 0; tt < 4; tt++)
#pragma unroll
          for (int r = 0; r < 4; r++) m = fmaxf(m, lg[tt][r]);
        m = fmaxf(m, __shfl_xor(m, 16));
        m = fmaxf(m, __shfl_xor(m, 32));
        float sum = 0.f;
#pragma unroll
        for (int tt = 0; tt < 4; tt++)
#pragma unroll
          for (int r = 0; r < 4; r++) {
            const float e = __expf(lg[tt][r] - m);
            lg[tt][r] = e;
            sum += e;
          }
        sum += __shfl_xor(sum, 16);
        sum += __shfl_xor(sum, 32);
#pragma unroll
        for (int sI = 0; sI < 2; sI++) {
          pb[j][sI].u[0] = pack2(lg[2 * sI][0], lg[2 * sI][1]);
          pb[j][sI].u[1] = pack2(lg[2 * sI][2], lg[2 * sI][3]);
          pb[j][sI].u[2] = pack2(lg[2 * sI + 1][0], lg[2 * sI + 1][1]);
          pb[j][sI].u[3] = pack2(lg[2 * sI + 1][2], lg[2 * sI + 1][3]);
        }
        if (cl < 4 && g4 == 0) {
          mlb[(wave * 8 + j * 4 + cl) * 2] = m;
          mlb[(wave * 8 + j * 4 + cl) * 2 + 1] = sum;
        }
      }
#pragma unroll
      for (int tt = 0; tt < 4; tt++) {
        const int pos = idxl[qn * 256 + wave * 64 + tt * 16 + cl];
#pragma unroll
        for (int j = 0; j < 2; j++) {
          const bf16_t* kr = Ks + (size_t)pos * 128 + j * 64 + g4 * 8;
          kf[j][tt][0] = *(const bf16x8*)kr;
          kf[j][tt][1] = *(const bf16x8*)(kr + 32);
        }
      }
      f32x4 o[2][4];
#pragma unroll
      for (int j = 0; j < 2; j++)
#pragma unroll
        for (int dt = 0; dt < 4; dt++) o[j][dt] = (f32x4){0.f, 0.f, 0.f, 0.f};
      const lds_cptr vb = (lds_cptr)(vst + (g4 * 4 + (cl >> 2)) * 288 + (cl & 3) * 8);
      {
        *(uint4*)(vst + (0 + g4) * 288 + cl * 16) = vq0;
        *(uint4*)(vst + (4 + g4) * 288 + cl * 16) = vq1;
        *(uint4*)(vst + (8 + g4) * 288 + cl * 16) = vq2;
        *(uint4*)(vst + (12 + g4) * 288 + cl * 16) = vq3;
        *(uint4*)(vst + (16 + g4) * 288 + cl * 16) = vq4;
        *(uint4*)(vst + (20 + g4) * 288 + cl * 16) = vq5;
        *(uint4*)(vst + (24 + g4) * 288 + cl * 16) = vq6;
        *(uint4*)(vst + (28 + g4) * 288 + cl * 16) = vq7;
        __builtin_amdgcn_wave_barrier();
#pragma unroll
        for (int j = 0; j < 2; j++)
#pragma unroll
          for (int dt = 0; dt < 4; dt++) {
            const s16x4 alo = vtr(vb + (j * 64 + dt * 16) * 2);
            const s16x4 ahi = vtr(vb + (j * 64 + dt * 16) * 2 + 16 * 288);
            const bf16x8 af = __builtin_shufflevector(alo, ahi, 0, 1, 2, 3, 4, 5, 6, 7);
            o[j][dt] = mfma16(af, pb[j][0].v, o[j][dt]);
          }
        __builtin_amdgcn_wave_barrier();
      }
      {
        *(uint4*)(vst + (0 + g4) * 288 + cl * 16) = vq8;
        *(uint4*)(vst + (4 + g4) * 288 + cl * 16) = vq9;
        *(uint4*)(vst + (8 + g4) * 288 + cl * 16) = vq10;
        *(uint4*)(vst + (12 + g4) * 288 + cl * 16) = vq11;
        *(uint4*)(vst + (16 + g4) * 288 + cl * 16) = vq12;
        *(uint4*)(vst + (20 + g4) * 288 + cl * 16) = vq13;
        *(uint4*)(vst + (24 + g4) * 288 + cl * 16) = vq14;
        *(uint4*)(vst + (28 + g4) * 288 + cl * 16) = vq15;
        __builtin_amdgcn_wave_barrier();
#pragma unroll
        for (int j = 0; j < 2; j++)
#pragma unroll
          for (int dt = 0; dt < 4; dt++) {
            const s16x4 alo = vtr(vb + (j * 64 + dt * 16) * 2);
            const s16x4 ahi = vtr(vb + (j * 64 + dt * 16) * 2 + 16 * 288);
            const bf16x8 af = __builtin_shufflevector(alo, ahi, 0, 1, 2, 3, 4, 5, 6, 7);
            o[j][dt] = mfma16(af, pb[j][1].v, o[j][dt]);
          }
        __builtin_amdgcn_wave_barrier();
      }
      vq0 = *(const uint4*)(Vs + (size_t)idxl[qn * 256 + wave * 64 + 0 + g4] * 128 + cl * 8);
      vq1 = *(const uint4*)(Vs + (size_t)idxl[qn * 256 + wave * 64 + 4 + g4] * 128 + cl * 8);
      vq2 = *(const uint4*)(Vs + (size_t)idxl[qn * 256 + wave * 64 + 8 + g4] * 128 + cl * 8);
      vq3 = *(const uint4*)(Vs + (size_t)idxl[qn * 256 + wave * 64 + 12 + g4] * 128 + cl * 8);
      vq4 = *(const uint4*)(Vs + (size_t)idxl[qn * 256 + wave * 64 + 16 + g4] * 128 + cl * 8);
      vq5 = *(const uint4*)(Vs + (size_t)idxl[qn * 256 + wave * 64 + 20 + g4] * 128 + cl * 8);
      vq6 = *(const uint4*)(Vs + (size_t)idxl[qn * 256 + wave * 64 + 24 + g4] * 128 + cl * 8);
      vq7 = *(const uint4*)(Vs + (size_t)idxl[qn * 256 + wave * 64 + 28 + g4] * 128 + cl * 8);
      vq8 = *(const uint4*)(Vs + (size_t)idxl[qn * 256 + wave * 64 + 32 + g4] * 128 + cl * 8);
      vq9 = *(const uint4*)(Vs + (size_t)idxl[qn * 256 + wave * 64 + 36 + g4] * 128 + cl * 8);
      vq10 = *(const uint4*)(Vs + (size_t)idxl[qn * 256 + wave * 64 + 40 + g4] * 128 + cl * 8);
      vq11 = *(const uint4*)(Vs + (size_t)idxl[qn * 256 + wave * 64 + 44 + g4] * 128 + cl * 8);
      vq12 = *(const uint4*)(Vs + (size_t)idxl[qn * 256 + wave * 64 + 48 + g4] * 128 + cl * 8);
      vq13 = *(const uint4*)(Vs + (size_t)idxl[qn * 256 + wave * 64 + 52 + g4] * 128 + cl * 8);
      vq14 = *(const uint4*)(Vs + (size_t)idxl[qn * 256 + wave * 64 + 56 + g4] * 128 + cl * 8);
      vq15 = *(const uint4*)(Vs + (size_t)idxl[qn * 256 + wave * 64 + 60 + g4] * 128 + cl * 8);
      if (cl < 4) {
#pragma unroll
        for (int j = 0; j < 2; j++)
#pragma unroll
          for (int dt = 0; dt < 4; dt++) *(f32x4*)(opb + (wave * 8 + j * 4 + cl) * 64 + dt * 16 + g4 * 4) = o[j][dt];
      }
    } else {
      if (lane < 8) {
        mlb[(wave * 8 + lane) * 2] = -1e30f;
        mlb[(wave * 8 + lane) * 2 + 1] = 0.f;
      }
      *(f32x4*)(opb + wave * 512 + lane * 8) = (f32x4){0.f, 0.f, 0.f, 0.f};
      *(f32x4*)(opb + wave * 512 + lane * 8 + 4) = (f32x4){0.f, 0.f, 0.f, 0.f};
    }
    __syncthreads();
    {
      const int e = tid * 2, head = e >> 6, d = e & 63;
      float M = -1e30f;
#pragma unroll
      for (int w = 0; w < 4; w++) M = fmaxf(M, mlb[(w * 8 + head) * 2]);
      float den = 0.f, n0 = 0.f, n1 = 0.f;
#pragma unroll
      for (int w = 0; w < 4; w++) {
        const float f = __expf(mlb[(w * 8 + head) * 2] - M);
        den += mlb[(w * 8 + head) * 2 + 1] * f;
        const float2 o2 = *(const float2*)(opb + (w * 8 + head) * 64 + d);
        n0 += o2.x * f;
        n1 += o2.y * f;
      }
      const float inv = __builtin_amdgcn_rcpf(den);
      if (!dry) *(unsigned*)(p.qa + (size_t)tok * 512 + e) = pack2(n0 * inv, n1 * inv);
    }
  }
  __syncthreads();
}

DI void mixer_phase(const Params& p, int l, char* smem, const bool dry = false, const int ci = 0) {
  const int tid = otid();
  const int NTASK = 64 + 1024 + 1024 + 128 + 288;
  bool first = true;
  for (;;) {
    int id;
    if (first && blockIdx.x < 64) {
      id = blockIdx.x;
    } else {
      __syncthreads();
      if (tid == 0) *(int*)(smem + SLOT) = 64 + (int)atomicAdd(&p.ctr[l + ci], 1u);
      __syncthreads();
      id = *(const int*)(smem + SLOT);
    }
    first = false;
    if (id >= NTASK) break;
    const int d = id - 64;
    if (id < 64 || d >= 1440) {
      int isP, b, h, rg;
      if (id < 64) { isP = 1; b = id >> 5; h = (id >> 2) & 7; rg = id & 3; }
      else { const int s = d - 1440; isP = 0; b = s >> 5; h = (s >> 2) & 7; rg = s & 3; }
      if (!(dry && (PROBE_SKIP & 2))) scan_task(p, l, isP, b, h, rg, smem, dry);
    } else if (d < 896 || d >= 1184) {
      int isP, b, tq;
      if (d < 768) { isP = 1; b = d & 1; tq = (511 - (d >> 1)) * 16; }
      else if (d < 896) { const int s = d - 768; isP = 0; b = s >> 2; tq = (s & 3) * 16; }
      else { const int s = d - 1184; isP = 1; b = s & 1; tq = (127 - (s >> 1)) * 16; }
      if (!(dry && (PROBE_SKIP & 1))) dsa_task(p, l, isP, b, tq, smem, dry);
    } else {
      if (!(dry && (PROBE_SKIP & 4))) mem_task(p, l, (d - 896) * 64, smem, dry);
    }
  }
}

DI void post_phase(const Params& p, int l) {
  const int tid = otid(), lane = tid & 63, wave = tid >> 6;
  for (int tok = blockIdx.x * 4 + wave; tok < TOK; tok += gridDim.x * 4) {
    float y[8], lw[8], lb[8], vv[8], bo[8];
    const bf16_t* vb = (const bf16_t*)(p.R + (size_t)tok * RS + 512) + 1024;
#pragma unroll
    for (int h = 0; h < 8; h++) {
      const int c = h * 64 + lane;
      y[h] = p.yscan[(size_t)tok * 512 + c];
      lw[h] = p.ln_w[l * 512 + c];
      lb[h] = p.ln_b[l * 512 + c];
      vv[h] = bf2f(vb[c]);
      bo[h] = p.bonus[(size_t)tok * 8 + h];
    }
#pragma unroll
    for (int h = 0; h < 8; h++) {
      const float mean = wave_sum(y[h]) * (1.f / 64.f);
      const float dv = y[h] - mean;
      const float var = wave_sum(dv * dv) * (1.f / 64.f);
      const float yn = dv * rsqrtf(var + 64e-5f) * lw[h] + lb[h];
      y[h] = yn + bo[h] * vv[h];
    }
#pragma unroll
    for (int h = 0; h < 8; h++) p.o_r[(size_t)tok * 512 + h * 64 + lane] = f2bf(y[h]);
  }
}

DI void gemm2_phase(const Params& p, int l, char* smem, const bool dry = false) {
  bf16_t* sm = (bf16_t*)smem;
  const int tid = otid(), lane = tid & 63, wave = tid >> 6;
  const int wm = wave >> 1, wn = wave & 1, g4 = lane >> 4, cl = lane & 15;
  const int slots = gridDim.x >> 3, slot = blockIdx.x >> 3;
  for (int e = slot;; e += slots) {
    int mt, nt;
    if (!xcd_tile(e, 36, mt, nt)) break;
    f32x4 acc[4][4];
    zero_acc(acc);
    gemm_kloop(p.hb + (size_t)mt * 128 * DM, DM, p.Wt2 + ((size_t)l * N2 + nt * 128) * DM, DM, DM, sm, acc);
    const int nb = nt * 128 + wn * 64;
    if (dry) {
      if (acc[0][0][0] == 1.2345e30f) p.wi[0] = acc[1][1][1] + acc[2][2][2] + acc[3][3][3];
    } else if (nb < 1536) {
      bf16_t* base = (nb < 512 ? p.qa : nb < 1024 ? p.o_r : p.qm) + (nb & 511) + cl;
      bf16_t old[4][4][4];
#pragma unroll
      for (int i = 0; i < 4; i++)
#pragma unroll
        for (int r = 0; r < 4; r++) {
          const int tok = mt * 128 + wm * 64 + i * 16 + g4 * 4 + r;
#pragma unroll
          for (int jn = 0; jn < 4; jn++) old[i][r][jn] = base[(size_t)tok * 512 + jn * 16];
        }
#pragma unroll
      for (int i = 0; i < 4; i++)
#pragma unroll
        for (int r = 0; r < 4; r++) {
          const int tok = mt * 128 + wm * 64 + i * 16 + g4 * 4 + r;
#pragma unroll
          for (int jn = 0; jn < 4; jn++) base[(size_t)tok * 512 + jn * 16] = f2bf(bf2f(old[i][r][jn]) * siluf_(acc[i][jn][r]));
        }
    } else {
#pragma unroll
      for (int i = 0; i < 4; i++)
#pragma unroll
        for (int r = 0; r < 4; r++) {
          const int tok = mt * 128 + wm * 64 + i * 16 + g4 * 4 + r;
#pragma unroll
          for (int jn = 0; jn < 4; jn++)
            p.G[(size_t)tok * 3072 + nb - 1536 + jn * 16 + cl] = f2bf(sigmoidf_(acc[i][jn][r]));
        }
    }
  }
}

DI void merge_phase(const Params& p, int l, char* smem) {
  bf16_t* sm = (bf16_t*)smem;
  const int tid = otid(), lane = tid & 63, wave = tid >> 6;
  const int g4 = lane >> 4, cl = lane & 15;
  const int slots = gridDim.x >> 3, slot = blockIdx.x >> 3;
  for (int e = slot;; e += slots) {
    int mt, nt;
    if (!xcd_tile(e, 16, mt, nt)) break;
    f32x4 tot[2][4];
#pragma unroll
    for (int i = 0; i < 2; i++)
#pragma unroll
      for (int j = 0; j < 4; j++) tot[i][j] = (f32x4){0.f, 0.f, 0.f, 0.f};
#pragma unroll 1
    for (int br = 0; br < 3; br++) {
      f32x4 acc[2][4];
#pragma unroll
      for (int i = 0; i < 2; i++)
#pragma unroll
        for (int j = 0; j < 4; j++) acc[i][j] = (f32x4){0.f, 0.f, 0.f, 0.f};
      const bf16_t* A = (br == 0 ? p.qa : br == 1 ? p.o_r : p.qm) + (size_t)mt * 128 * 512;
      gemm_kloop64(A, 512, p.Wbr + ((size_t)(l * 3 + br) * DM + nt * 64) * 512, 512, 512, sm, acc);
#pragma unroll
      for (int i = 0; i < 2; i++)
#pragma unroll
        for (int r = 0; r < 4; r++) {
          const int tok = mt * 128 + wave * 32 + i * 16 + g4 * 4 + r;
#pragma unroll
          for (int jn = 0; jn < 4; jn++) {
            const int n = nt * 64 + jn * 16 + cl;
            const float g = bf2f(p.G[(size_t)tok * 3072 + br * 1024 + n]);
            tot[i][jn][r] += g * acc[i][jn][r];
          }
        }
    }
#pragma unroll
    for (int i = 0; i < 2; i++)
#pragma unroll
      for (int r = 0; r < 4; r++) {
        const int tok = mt * 128 + wave * 32 + i * 16 + g4 * 4 + r;
#pragma unroll
        for (int jn = 0; jn < 4; jn++) {
          const int n = nt * 64 + jn * 16 + cl;
          p.merged[(size_t)tok * DM + n] = f2bf(tot[i][jn][r]);
        }
      }
  }
}

DI void out_phase(const Params& p, int l, char* smem, const bool dry = false) {
  bf16_t* sm = (bf16_t*)smem;
  const int tid = otid(), lane = tid & 63, wave = tid >> 6;
  const int wm = wave >> 1, wn = wave & 1, g4 = lane >> 4, cl = lane & 15;
  const int slots = gridDim.x >> 3, slot = blockIdx.x >> 3;
  for (int e = slot;; e += slots) {
    int mt, nt;
    if (!xcd_tile(e, 8, mt, nt)) break;
    f32x4 acc[4][4];
    zero_acc(acc);
    gemm_kloop(p.merged + (size_t)mt * 128 * DM, DM, p.Wout + ((size_t)l * DM + nt * 128) * DM, DM, DM, sm, acc);
    if (dry) {
      if (acc[0][0][0] == 1.2345e30f) p.wi[0] = acc[1][1][1] + acc[2][2][2] + acc[3][3][3];
      continue;
    }
    float xo[4][4][4];
#pragma unroll
    for (int i = 0; i < 4; i++)
#pragma unroll
      for (int r = 0; r < 4; r++) {
        const int tok = mt * 128 + wm * 64 + i * 16 + g4 * 4 + r;
        const float* xr = xrow_ptr(p, l, tok);
#pragma unroll
        for (int jn = 0; jn < 4; jn++) xo[i][r][jn] = xr[nt * 128 + wn * 64 + jn * 16 + cl];
      }
#pragma unroll
    for (int i = 0; i < 4; i++)
#pragma unroll
      for (int r = 0; r < 4; r++) {
        const int tok = mt * 128 + wm * 64 + i * 16 + g4 * 4 + r;
#pragma unroll
        for (int jn = 0; jn < 4; jn++) {
          const int n = nt * 128 + wn * 64 + jn * 16 + cl;
          p.out[(size_t)tok * DM + n] = xo[i][r][jn] + acc[i][jn][r];
        }
      }
  }
}

DI void norm_phase(const Params& p, int l) {
  const int wave = otid() >> 6;
  for (int tok = blockIdx.x * 4 + wave; tok < TOK; tok += gridDim.x * 4)
    norm_row_bf16(xrow_ptr(p, l, tok), p.norm_g + l * DM, p.hb + (size_t)tok * DM);
}
DI void final_phase(const Params& p) {
  const int lane = otid() & 63, wave = otid() >> 6;
  for (int tok = blockIdx.x * 4 + wave; tok < TOK; tok += gridDim.x * 4) {
    float* x = p.out + (size_t)tok * DM;
    float4 v[4];
    float ss = 0.f;
#pragma unroll
    for (int i = 0; i < 4; i++) {
      v[i] = *(const float4*)(x + i * 256 + lane * 4);
      ss += v[i].x * v[i].x + v[i].y * v[i].y + v[i].z * v[i].z + v[i].w * v[i].w;
    }
    ss = wave_sum(ss);
    const float rstd = rsqrtf(ss * (1.f / 1024.f) + 1e-6f);
#pragma unroll
    for (int i = 0; i < 4; i++) {
      const float4 g = *(const float4*)(p.final_g + i * 256 + lane * 4);
      *(float4*)(x + i * 256 + lane * 4) = make_float4(v[i].x * rstd * g.x, v[i].y * rstd * g.y, v[i].z * rstd * g.z, v[i].w * rstd * g.w);
    }
  }
}

__global__ void __launch_bounds__(256, 2) mega(Params pk) {
  const Params& p = *(const Params*)__builtin_amdgcn_kernarg_segment_ptr();
  cg::grid_group grid = cg::this_grid();
  __shared__ __attribute__((aligned(16))) char smem[SMEM];
  phase0(p, smem);
  grid.sync();
  GBar gb;
  gbar_init(gb, p.ctr);
#ifndef PROBE_DUP
#define PROBE_DUP 0
#endif
  const bool dryv = PROBE_DUP ? (*(volatile unsigned*)&p.ctr[7] == 0u) : false;
  if (PROBE_DUP & 1) { phase0(p, smem); gbar(gb); }
  for (int l = 0; l < 2; l++) {
    if (l == 1) { norm_phase(p, 1); convert_caches(p, 1); gbar(gb); }
    if (PROBE_DUP & 2) { gemm1_phase(p, l, smem); gbar(gb); }
    gemm1_phase(p, l, smem);
    gbar(gb);
    if (PROBE_DUP & 4) { prep_phase(p, l, smem, dryv); gbar(gb); }
    prep_phase(p, l, smem);
    gbar(gb);
    if (PROBE_DUP & 8) { mixer_phase(p, l, smem, dryv, 2); gbar(gb); }
    mixer_phase(p, l, smem);
    gbar(gb);
    if (PROBE_DUP & 16) { post_phase(p, l); gbar(gb); }
    post_phase(p, l);
    gbar(gb);
    if (PROBE_DUP & 32) { gemm2_phase(p, l, smem, dryv); gbar(gb); }
    gemm2_phase(p, l, smem);
    gbar(gb);
    if (PROBE_DUP & 64) { merge_phase(p, l, smem); gbar(gb); }
    merge_phase(p, l, smem);
    gbar(gb);
    if (PROBE_DUP & 128) { out_phase(p, l, smem, dryv); gbar(gb); }
    out_phase(p, l, smem);
    gbar(gb);
  }
  final_phase(p);
}

extern "C" void kernel_launch(void* const* d_in, const int* in_sizes, int n_in, void* d_out, int out_size, void* d_ws,
                              size_t ws_size, hipStream_t stream) {
  Params p;
  ::memset((void*)&p, 0, sizeof(p));
  const float** f = (const float**)&p;
  for (int i = 0; i < 29; i++) f[i] = (const float*)d_in[i];
  p.out = (float*)d_out;
  char* w = (char*)d_ws;
  size_t off = 0;
  auto take = [&](size_t bytes) { char* r = w + off; off += (bytes + 255) & ~(size_t)255; return r; };
  p.Wt1 = (bf16_t*)take((size_t)2 * N1 * DM * 2);
  p.Wt2 = (bf16_t*)take((size_t)2 * N2 * DM * 2);
  p.Wmem = (bf16_t*)take((size_t)2 * DM * DM * 2);
  p.Wbr = (bf16_t*)take((size_t)2 * 3 * DM * 512 * 2);
  p.Wout = (bf16_t*)take((size_t)2 * DM * DM * 2);
  p.cmvT = (bf16_t*)take((size_t)2 * 32 * 4 * 128 * 256 * 2);
  p.pmvT = (bf16_t*)take((size_t)2 * 2 * 4 * 128 * 256 * 2);
  p.memn = (bf16_t*)take((size_t)2 * 512 * DM * 2);
  p.rope = (float*)take((size_t)8192 * 32 * 2 * 4);
  p.hb = (bf16_t*)take((size_t)TOK * DM * 2);
  p.qa = (bf16_t*)take((size_t)TOK * 512 * 2);
  p.qi = (bf16_t*)take((size_t)TOK * 256 * 2);
  p.qm = (bf16_t*)take((size_t)TOK * 512 * 2);
  p.o_r = (bf16_t*)take((size_t)TOK * 512 * 2);
  p.wi = (float*)take((size_t)TOK * 4 * 4);
  p.R = (float*)take((size_t)TOK * RS * 4);
  p.G = (bf16_t*)p.R;
  p.yscan = (float*)take((size_t)TOK * 512 * 4);
  p.merged = (bf16_t*)p.yscan;
  p.bnd = (float*)take((size_t)(TOK / 16) * DSH * 4);
  p.bonus = (float*)take((size_t)TOK * 8 * 4);
  p.ctr = (unsigned*)take(16384);
  p.KB = (bf16_t*)take((size_t)NROWS * 128 * 2);
  p.VB = (bf16_t*)take((size_t)NROWS * 128 * 2);
  p.KIB = (bf16_t*)take((size_t)NROWS * 64 * 2);
  if (off > ws_size) {
    fprintf(stderr, "workspace too small: need %zu have %zu\n", off, ws_size);
    return;
  }
  static int grid_blocks = 0;
  if (!grid_blocks) {
    int dev = 0, cus = 0, per_cu = 0;
    (void)hipGetDevice(&dev);
    (void)hipDeviceGetAttribute(&cus, hipDeviceAttributeMultiprocessorCount, dev);
    (void)hipOccupancyMaxActiveBlocksPerMultiprocessor(&per_cu, mega, 256, 0);
    if (per_cu > 2) per_cu = 2;
    if (per_cu < 1) per_cu = 1;
    grid_blocks = (cus * per_cu) & ~7;
  }
  (void)hipMemsetAsync(p.ctr, 0, 16384, stream);
  void* args[] = {&p};
  hipError_t e = hipLaunchCooperativeKernel((void*)mega, dim3(grid_blocks), dim3(256), args, 0, stream);
  if (e != hipSuccess) fprintf(stderr, "cooperative launch failed: %s (grid %d)\n", hipGetErrorString(e), grid_blocks);
}
```

```cpp
#include <hip/hip_runtime.h>
#include <hip/hip_cooperative_groups.h>
#include <stdint.h>
#include <stdio.h>
#include <string.h>
namespace cg = cooperative_groups;

#define DI __device__ __forceinline__
#define PROBE_SKIP 2
typedef unsigned short bf16_t;
typedef __attribute__((ext_vector_type(8))) short bf16x8;
typedef __attribute__((ext_vector_type(4))) float f32x4;
typedef __attribute__((ext_vector_type(2))) float f32x2;

constexpr int DM = 1024;
constexpr int TP = 16384;
constexpr int TOK = 18432;
constexpr int DIN = 7876;
constexpr int N1 = 3328;
constexpr int N2 = 4608;
constexpr int RS = 1792;
constexpr int DSH = 1664;
constexpr int SMEM = 73728;
constexpr int SLOT = SMEM - 16;
constexpr int NROWS = 16384 + 32 * 2112;

constexpr size_t O_Y = 0;
constexpr size_t O_KP = 18874368;
constexpr size_t O_VP = O_KP + 4194304;
constexpr size_t O_KIP = O_VP + 4194304;
constexpr size_t O_WKVP = O_KIP + 2097152;
constexpr size_t O_SHP = O_WKVP + 131072;
constexpr size_t O_MKP = O_SHP + 6656;
constexpr size_t O_MVP = O_MKP + 524288;
constexpr size_t O_KS = O_MVP + 524288;
constexpr size_t O_VS = O_KS + 524288;
constexpr size_t O_KIS = O_VS + 524288;
constexpr size_t O_WKVS = O_KIS + 262144;
constexpr size_t O_SHS = O_WKVS + 2097152;

struct Params {
  const float *x_prompt, *x_sample, *mem_prompt, *cache_k, *cache_v, *cache_kidx, *state_wkv, *state_shift,
      *cache_mem_k, *cache_mem_v, *norm_g, *w_in, *mu_shift, *w0, *w2, *a0, *a2, *k_k, *k_a, *r_k, *ln_w, *ln_b,
      *mem_norm_g, *w_mem_kv, *w_br_a, *w_br_r, *w_br_m, *w_out, *final_g;
  float* out;
  bf16_t *Wt1, *Wt2, *Wmem, *Wbr, *Wout, *cmvT, *pmvT, *memn, *hb, *qa, *qi, *qm, *o_r, *merged, *G, *KB, *VB, *KIB;
  float *rope, *wi, *R, *yscan, *bnd, *bonus;
  unsigned* ctr;
};

DI int otid() { int t = __builtin_amdgcn_workitem_id_x(); asm volatile("" : "+v"(t)); return t; }
typedef __bf16 bf16x2_t __attribute__((ext_vector_type(2)));
DI unsigned pack2(float a, float b) {
  const f32x2 v = {a, b};
  const bf16x2_t r = __builtin_convertvector(v, bf16x2_t);
  return __builtin_bit_cast(unsigned, r);
}
DI bf16_t f2bf(float f) { return (bf16_t)(pack2(f, f) & 0xFFFFu); }
DI float bf2f(bf16_t b) { return __uint_as_float(((unsigned)b) << 16); }
DI bf16x8 cvt8(const float* p) {
  float4 x = *(const float4*)p, y = *(const float4*)(p + 4);
  union { bf16x8 v; unsigned u[4]; } r;
  r.u[0] = pack2(x.x, x.y); r.u[1] = pack2(x.z, x.w); r.u[2] = pack2(y.x, y.y); r.u[3] = pack2(y.z, y.w);
  return r.v;
}
template <int CTRL> DI float dpp_add(float x) {
  int y = __builtin_amdgcn_update_dpp(0, __float_as_int(x), CTRL, 0xF, 0xF, false);
  return x + __int_as_float(y);
}
DI float rowsum16(float x) {
  x = dpp_add<0xB1>(x);
  x = dpp_add<0x4E>(x);
  x = dpp_add<0x141>(x);
  x = dpp_add<0x140>(x);
  return x;
}
DI float wave_sum(float v) {
  v = rowsum16(v);
  const float a = __int_as_float(__builtin_amdgcn_readlane(__float_as_int(v), 0));
  const float b = __int_as_float(__builtin_amdgcn_readlane(__float_as_int(v), 16));
  const float c = __int_as_float(__builtin_amdgcn_readlane(__float_as_int(v), 32));
  const float d = __int_as_float(__builtin_amdgcn_readlane(__float_as_int(v), 48));
  return (a + b) + (c + d);
}
typedef __attribute__((address_space(3))) const char* lds_cptr;
typedef short v4i16_t __attribute__((ext_vector_type(4)));
typedef __attribute__((ext_vector_type(4))) short s16x4;
DI s16x4 vtr(lds_cptr p) { return __builtin_bit_cast(s16x4, __builtin_amdgcn_ds_read_tr16_b64_v4i16((__attribute__((address_space(3))) v4i16_t*)p)); }
DI float sigmoidf_(float x) { return __builtin_amdgcn_rcpf(1.f + __expf(-x)); }
DI float siluf_(float x) { return x * __builtin_amdgcn_rcpf(1.f + __expf(-x)); }
DI f32x4 mfma16(bf16x8 a, bf16x8 b, f32x4 c) { return __builtin_amdgcn_mfma_f32_16x16x32_bf16(a, b, c, 0, 0, 0); }

DI const float* xrow_ptr(const Params& p, int l, int tok) {
  if (l == 0) return tok < TP ? p.x_prompt + (size_t)tok * DM : p.x_sample + (size_t)(tok - TP) * DM;
  return p.out + (size_t)tok * DM;
}


DI unsigned xcc_id() { return (unsigned)__builtin_amdgcn_s_getreg((3 << 11) | 20) & 0xFu; }
struct GBar { unsigned* w; unsigned xcc, mycen, nx, k; };
DI void gbar_init(GBar& g, unsigned* w) {
  g.w = w; g.xcc = (unsigned)__builtin_amdgcn_readfirstlane((int)xcc_id()); g.k = 0;
  unsigned nx = 0, mycen = 0;
  for (unsigned x = 0; x < 16; x++) {
    const unsigned c = __hip_atomic_load(&w[64 + 64 * x], __ATOMIC_RELAXED, __HIP_MEMORY_SCOPE_AGENT);
    if (c) nx++;
    if (x == g.xcc) mycen = c;
  }
  g.nx = (unsigned)__builtin_amdgcn_readfirstlane((int)nx);
  g.mycen = (unsigned)__builtin_amdgcn_readfirstlane((int)mycen);
}
DI void gbar(GBar& g) {
  g.k++;
  asm volatile("s_waitcnt vmcnt(0) lgkmcnt(0)" ::: "memory");
  __syncthreads();
  if (otid() == 0) {
    const unsigned a = __hip_atomic_fetch_add(&g.w[1152 + 64 * g.xcc], 1u, __ATOMIC_RELAXED, __HIP_MEMORY_SCOPE_AGENT) + 1u;
    if (a == g.k * g.mycen) {
      __builtin_amdgcn_fence(__ATOMIC_RELEASE, "agent");
      asm volatile("s_waitcnt vmcnt(0)" ::: "memory");
      __hip_atomic_fetch_add(&g.w[2240], 1u, __ATOMIC_RELAXED, __HIP_MEMORY_SCOPE_AGENT);
    }
    while (__hip_atomic_load(&g.w[2240], __ATOMIC_RELAXED, __HIP_MEMORY_SCOPE_AGENT) < g.k * g.nx) __builtin_amdgcn_s_sleep(1);
    __builtin_amdgcn_fence(__ATOMIC_ACQUIRE, "agent");
    asm volatile("s_waitcnt vmcnt(0)" ::: "memory");
  }
  __syncthreads();
}

DI int colmap(int kind, int n) {
  if (kind == 1) {
    if (n < 1092) return n;
    if (n < 1152) return -1;
    if (n < 2816) return 1604 + (n - 1152);
    return 3780 + (n - 2816);
  } else if (kind == 2) {
    if (n < 512) return 1092 + n;
    if (n < 1024) return 3268 + (n - 512);
    if (n < 1536) return 4292 + (n - 1024);
    return 4804 + (n - 1536);
  }
  return n;
}
DI void transpose_tile(const float* __restrict__ src, int ldsrc, int kind, int k0, int n0, bf16_t* __restrict__ dst,
                       int lddst, float* tile) {
  const int tid = otid();
  float v[16];
#pragma unroll
  for (int r = 0; r < 16; r++) {
    const int kk = r * 4 + (tid >> 6), nn = tid & 63;
    const int sc = colmap(kind, n0 + nn);
    v[r] = sc >= 0 ? src[(size_t)(k0 + kk) * ldsrc + sc] : 0.f;
  }
  __syncthreads();
#pragma unroll
  for (int r = 0; r < 16; r++) tile[(r * 4 + (tid >> 6)) * 65 + (tid & 63)] = v[r];
  __syncthreads();
#pragma unroll
  for (int r = 0; r < 8; r++) {
    const int nn = r * 8 + (tid >> 5), kk = (tid & 31) * 2;
    *(unsigned*)(dst + (size_t)(n0 + nn) * lddst + k0 + kk) = pack2(tile[kk * 65 + nn], tile[(kk + 1) * 65 + nn]);
  }
}
DI void norm_row_bf16(const float* __restrict__ x, const float* __restrict__ g, bf16_t* __restrict__ dst) {
  const int lane = otid() & 63;
  float4 v[4];
  float ss = 0.f;
#pragma unroll
  for (int i = 0; i < 4; i++) {
    v[i] = *(const float4*)(x + i * 256 + lane * 4);
    ss += v[i].x * v[i].x + v[i].y * v[i].y + v[i].z * v[i].z + v[i].w * v[i].w;
  }
  ss = wave_sum(ss);
  float rstd = rsqrtf(ss * (1.f / 1024.f) + 1e-6f);
#pragma unroll
  for (int i = 0; i < 4; i++) {
    float4 gg = *(const float4*)(g + i * 256 + lane * 4);
    uint2 o;
    o.x = pack2(v[i].x * rstd * gg.x, v[i].y * rstd * gg.y);
    o.y = pack2(v[i].z * rstd * gg.z, v[i].w * rstd * gg.w);
    *(uint2*)(dst + i * 256 + lane * 4) = o;
  }
}


DI void convert_caches(const Params& p, int l) {
  const int tid = otid();
  const long total = (long)32 * 2048 * 40;
  for (long e = (long)blockIdx.x * 256 + tid; e < total; e += (long)gridDim.x * 256) {
    const int row = (int)(e / 40), c = (int)(e - (long)row * 40);
    const int b = row >> 11, pos = row & 2047;
    const size_t drow = (size_t)16384 + (size_t)b * 2112 + pos;
    const size_t srow = (size_t)(l * 32 + b) * 2048 + pos;
    if (c < 16) *(bf16x8*)(p.KB + drow * 128 + c * 8) = cvt8(p.cache_k + srow * 128 + c * 8);
    else if (c < 32) *(bf16x8*)(p.VB + drow * 128 + (c - 16) * 8) = cvt8(p.cache_v + srow * 128 + (c - 16) * 8);
    else *(bf16x8*)(p.KIB + drow * 64 + (c - 32) * 8) = cvt8(p.cache_kidx + srow * 64 + (c - 32) * 8);
  }
}

DI void transpose_job(const Params& p, int t, float* tile) {
  const int NTW = 2880;
  if (t < 2 * NTW) {
    int l = t / NTW, r = t - l * NTW;
    if (r < 832) {
      int nt = r >> 4, kt = r & 15;
      transpose_tile(p.w_in + (size_t)l * DM * DIN, DIN, 1, kt * 64, nt * 64, p.Wt1 + (size_t)l * N1 * DM, DM, tile);
    } else if (r < 832 + 1152) {
      r -= 832;
      int nt = r >> 4, kt = r & 15;
      transpose_tile(p.w_in + (size_t)l * DM * DIN, DIN, 2, kt * 64, nt * 64, p.Wt2 + (size_t)l * N2 * DM, DM, tile);
    } else if (r < 832 + 1152 + 256) {
      r -= 1984;
      int nt = r >> 4, kt = r & 15;
      transpose_tile(p.w_mem_kv + (size_t)l * DM * DM, DM, 0, kt * 64, nt * 64, p.Wmem + (size_t)l * DM * DM, DM, tile);
    } else if (r < 2240 + 384) {
      r -= 2240;
      int br = r >> 7; r &= 127;
      int nt = r >> 3, kt = r & 7;
      const float* src = (br == 0 ? p.w_br_a : br == 1 ? p.w_br_r : p.w_br_m) + (size_t)l * 512 * DM;
      transpose_tile(src, DM, 0, kt * 64, nt * 64, p.Wbr + (size_t)(l * 3 + br) * DM * 512, 512, tile);
    } else {
      r -= 2624;
      int nt = r >> 4, kt = r & 15;
      transpose_tile(p.w_out + (size_t)l * DM * DM, DM, 0, kt * 64, nt * 64, p.Wout + (size_t)l * DM * DM, DM, tile);
    }
  } else {
    int r = t - 2 * NTW;
    int job = r >> 3, sub = r & 7;
    int lb = job >> 2, h = job & 3;
    int nt = sub >> 2, kt = sub & 3;
    transpose_tile(p.cache_mem_v + (size_t)lb * 256 * 512 + h * 128, 512, 0, kt * 64, nt * 64,
                   p.cmvT + (size_t)(lb * 4 + h) * 128 * 256, 256, tile);
  }
}

DI void phase0(const Params& p, char* smem) {
  const int tid = otid();
  float* tile = (float*)smem;
  if (tid == 0) __hip_atomic_fetch_add(&p.ctr[64 + 64 * xcc_id()], 1u, __ATOMIC_RELAXED, __HIP_MEMORY_SCOPE_AGENT);
  for (int t = blockIdx.x; t < 2 * 2880 + 2048; t += gridDim.x) {
    const bool deferred = (t >= 2880 && t < 5760 && !(t - 2880 >= 1984 && t - 2880 < 2240)) || (t >= 5760 + 1024);
    if (!deferred) transpose_job(p, t, tile);
  }
  convert_caches(p, 0);
  for (int e = blockIdx.x * 256 + tid; e < 8192 * 32; e += gridDim.x * 256) {
    int pos = e >> 5, i = e & 31;
    float inv = powf(10000.f, -(float)(2 * i) / 64.f);
    float ang = (float)pos * inv;
    float s, c;
    sincosf(ang, &s, &c);
    p.rope[2 * e] = c;
    p.rope[2 * e + 1] = s;
  }
  const int wave = tid >> 6;
  for (int r = blockIdx.x * 4 + wave; r < 1024 + TOK; r += gridDim.x * 4) {
    if (r < 1024) {
      int l = r >> 9, row = r & 511;
      norm_row_bf16(p.mem_prompt + (size_t)row * DM, p.mem_norm_g + l * DM, p.memn + (size_t)r * DM);
    } else {
      int tok = r - 1024;
      norm_row_bf16(xrow_ptr(p, 0, tok), p.norm_g, p.hb + (size_t)tok * DM);
    }
  }
}

constexpr int LDT = 72;
constexpr int TILE_E = 128 * LDT;
DI void gemm_kloop(const bf16_t* __restrict__ A, int lda, const bf16_t* __restrict__ B, int ldb, int K, bf16_t* sm,
                   f32x4 (&acc)[4][4]) {
  const int tid = otid(), lane = tid & 63, wave = tid >> 6;
  const int wm = wave >> 1, wn = wave & 1;
  const int lrow = tid >> 3, lkc = (tid & 7) * 8;
  const unsigned toa = (unsigned)(lrow * lda + lkc), tob = (unsigned)(lrow * ldb + lkc);
  uint4 ra0_0, ra0_1, ra0_2, ra0_3, rb0_0, rb0_1, rb0_2, rb0_3, ra1_0, ra1_1, ra1_2, ra1_3, rb1_0, rb1_1, rb1_2, rb1_3;
  const int fr = lane & 15, fk = (lane >> 4) * 8;
  const int nk = K >> 6;
#define GLOAD(RA, RB, K0)                                                   \
  {                                                                         \
    RA##_0 = *(const uint4*)((A + (size_t)(K0)) + toa);                     \
    RA##_1 = *(const uint4*)((A + (size_t)(32 * lda + (K0))) + toa);        \
    RA##_2 = *(const uint4*)((A + (size_t)(64 * lda + (K0))) + toa);        \
    RA##_3 = *(const uint4*)((A + (size_t)(96 * lda + (K0))) + toa);        \
    RB##_0 = *(const uint4*)((B + (size_t)(K0)) + tob);                     \
    RB##_1 = *(const uint4*)((B + (size_t)(32 * ldb + (K0))) + tob);        \
    RB##_2 = *(const uint4*)((B + (size_t)(64 * ldb + (K0))) + tob);        \
    RB##_3 = *(const uint4*)((B + (size_t)(96 * ldb + (K0))) + tob);        \
  }
#define SSTORE(RA, RB, BUF)                                                 \
  {                                                                         \
    bf16_t* sd = sm + (BUF) * (2 * TILE_E) + lrow * LDT + lkc;              \
    *(uint4*)(sd) = RA##_0;                                                 \
    *(uint4*)(sd + 32 * LDT) = RA##_1;                                      \
    *(uint4*)(sd + 64 * LDT) = RA##_2;                                      \
    *(uint4*)(sd + 96 * LDT) = RA##_3;                                      \
    *(uint4*)(sd + TILE_E) = RB##_0;                                        \
    *(uint4*)(sd + TILE_E + 32 * LDT) = RB##_1;                             \
    *(uint4*)(sd + TILE_E + 64 * LDT) = RB##_2;                             \
    *(uint4*)(sd + TILE_E + 96 * LDT) = RB##_3;                             \
  }
#define COMPUTE(BUF)                                                        \
  {                                                                         \
    const bf16_t* sa = sm + (BUF) * (2 * TILE_E) + (wm * 64 + fr) * LDT + fk;           \
    const bf16_t* sb = sm + (BUF) * (2 * TILE_E) + TILE_E + (wn * 64 + fr) * LDT + fk;  \
    _Pragma("unroll") for (int s = 0; s < 2; s++) {                         \
      bf16x8 af[4], bfr[4];                                                 \
      _Pragma("unroll") for (int i = 0; i < 4; i++) {                       \
        af[i] = *(const bf16x8*)(sa + i * 16 * LDT + s * 32);               \
        bfr[i] = *(const bf16x8*)(sb + i * 16 * LDT + s * 32);              \
      }                                                                     \
      _Pragma("unroll") for (int i = 0; i < 4; i++)                         \
        _Pragma("unroll") for (int j = 0; j < 4; j++) acc[i][j] = mfma16(af[i], bfr[j], acc[i][j]);  \
    }                                                                       \
  }
  __syncthreads();
  GLOAD(ra0, rb0, 0)
  GLOAD(ra1, rb1, 64)
  SSTORE(ra0, rb0, 0)
  __syncthreads();
  for (int kt = 0; kt < nk - 2; kt += 2) {
    GLOAD(ra0, rb0, (kt + 2) << 6)
    COMPUTE(0)
    SSTORE(ra1, rb1, 1)
    __syncthreads();
    GLOAD(ra1, rb1, (kt + 3) << 6)
    COMPUTE(1)
    SSTORE(ra0, rb0, 0)
    __syncthreads();
  }
  COMPUTE(0)
  SSTORE(ra1, rb1, 1)
  __syncthreads();
  COMPUTE(1)
  __syncthreads();
#undef GLOAD
#undef SSTORE
#undef COMPUTE
}
DI void zero_acc(f32x4 (&acc)[4][4]) {
#pragma unroll
  for (int i = 0; i < 4; i++)
#pragma unroll
    for (int j = 0; j < 4; j++) acc[i][j] = (f32x4){0.f, 0.f, 0.f, 0.f};
}


DI void gemm_kloop64(const bf16_t* __restrict__ A, int lda, const bf16_t* __restrict__ B, int ldb, int K, bf16_t* sm,
                     f32x4 (&acc)[2][4]) {
  const int tid = otid(), lane = tid & 63, wave = tid >> 6;
  const int lrow = tid >> 3, lkc = (tid & 7) * 8;
  const unsigned toa = (unsigned)(lrow * lda + lkc), tob = (unsigned)(lrow * ldb + lkc);
  uint4 ra0_0, ra0_1, ra0_2, ra0_3, rb0_0, rb0_1, ra1_0, ra1_1, ra1_2, ra1_3, rb1_0, rb1_1;
  const int fr = lane & 15, fk = (lane >> 4) * 8;
  const int nk = K >> 6;
#define GLOAD(RA, RB, K0)                                                   \
  {                                                                         \
    RA##_0 = *(const uint4*)((A + (size_t)(K0)) + toa);                     \
    RA##_1 = *(const uint4*)((A + (size_t)(32 * lda + (K0))) + toa);        \
    RA##_2 = *(const uint4*)((A + (size_t)(64 * lda + (K0))) + toa);        \
    RA##_3 = *(const uint4*)((A + (size_t)(96 * lda + (K0))) + toa);        \
    RB##_0 = *(const uint4*)((B + (size_t)(K0)) + tob);                     \
    RB##_1 = *(const uint4*)((B + (size_t)(32 * ldb + (K0))) + tob);        \
  }
#define SSTORE(RA, RB, BUF)                                                 \
  {                                                                         \
    bf16_t* sd = sm + (BUF) * (2 * TILE_E) + lrow * LDT + lkc;              \
    *(uint4*)(sd) = RA##_0;                                                 \
    *(uint4*)(sd + 32 * LDT) = RA##_1;                                      \
    *(uint4*)(sd + 64 * LDT) = RA##_2;                                      \
    *(uint4*)(sd + 96 * LDT) = RA##_3;                                      \
    *(uint4*)(sd + TILE_E) = RB##_0;                                        \
    *(uint4*)(sd + TILE_E + 32 * LDT) = RB##_1;                             \
  }
#define COMPUTE(BUF)                                                                            \
  {                                                                                             \
    const bf16_t* sa = sm + (BUF) * (2 * TILE_E) + (wave * 32 + fr) * LDT + fk;                 \
    const bf16_t* sb = sm + (BUF) * (2 * TILE_E) + TILE_E + fr * LDT + fk;                      \
    _Pragma("unroll") for (int s = 0; s < 2; s++) {                                             \
      bf16x8 af[2], bfr[4];                                                                     \
      _Pragma("unroll") for (int i = 0; i < 2; i++) af[i] = *(const bf16x8*)(sa + i * 16 * LDT + s * 32);   \
      _Pragma("unroll") for (int j = 0; j < 4; j++) bfr[j] = *(const bf16x8*)(sb + j * 16 * LDT + s * 32);  \
      _Pragma("unroll") for (int i = 0; i < 2; i++)                                             \
        _Pragma("unroll") for (int j = 0; j < 4; j++) acc[i][j] = mfma16(af[i], bfr[j], acc[i][j]);         \
    }                                                                                           \
  }
  __syncthreads();
  GLOAD(ra0, rb0, 0)
  GLOAD(ra1, rb1, 64)
  SSTORE(ra0, rb0, 0)
  __syncthreads();
  for (int kt = 0; kt < nk - 2; kt += 2) {
    GLOAD(ra0, rb0, (kt + 2) << 6)
    COMPUTE(0)
    SSTORE(ra1, rb1, 1)
    __syncthreads();
    GLOAD(ra1, rb1, (kt + 3) << 6)
    COMPUTE(1)
    SSTORE(ra0, rb0, 0)
    __syncthreads();
  }
  COMPUTE(0)
  SSTORE(ra1, rb1, 1)
  __syncthreads();
  COMPUTE(1)
  __syncthreads();
#undef GLOAD
#undef SSTORE
#undef COMPUTE
}

DI bool xcd_tile(int e, int NNT, int& mt, int& nt) {
  const int xcd = blockIdx.x & 7;
  const int per_mb = 9 * NNT;
  if (e >= 2 * per_mb) return false;
  const int mb = e >= per_mb ? 1 : 0;
  int r = e - mb * per_mb;
  const int full = NNT >> 3, rem = NNT & 7;
  int nb = r / 72;
  int w = 8;
  if (nb >= full) { nb = full; w = rem; }
  r -= nb * 72;
  const int mi = r / w, ni = r - mi * w;
  mt = xcd * 18 + mb * 9 + mi;
  nt = nb * 8 + ni;
  return true;
}

struct TokInfo { int isP, b, t, pos; };
DI TokInfo tokinfo(int tok) {
  TokInfo ti;
  if (tok < TP) { ti.isP = 1; ti.b = tok >> 13; ti.t = tok & 8191; ti.pos = ti.t; }
  else { int s = tok - TP; ti.isP = 0; ti.b = s >> 6; ti.t = s & 63; ti.pos = 2048 + ti.t; }
  return ti;
}

DI void gemm1_phase(const Params& p, int l, char* smem) {
  bf16_t* sm = (bf16_t*)smem;
  const int tid = otid(), lane = tid & 63, wave = tid >> 6;
  const int wm = wave >> 1, wn = wave & 1, g4 = lane >> 4, cl = lane & 15;
  const int NT1 = 144 * 26;
  const int slots = gridDim.x >> 3, slot = blockIdx.x >> 3;
  const int nmain = 18 * 26;
  const int nextra = (l == 0 ? 8 : 0);
  for (int e = slot; e < nmain + nextra; e += slots) {
    f32x4 acc[4][4];
    zero_acc(acc);
    int mt = 0, nt = 0;
    const bool is_main = xcd_tile(e, 26, mt, nt);
    const int t = is_main ? 0 : NT1 + (e - nmain) * 8 + (blockIdx.x & 7);
    if (is_main) {
      gemm_kloop(p.hb + (size_t)mt * 128 * DM, DM, p.Wt1 + ((size_t)l * N1 + nt * 128) * DM, DM, DM, sm, acc);
      const int nb = nt * 128 + wn * 64;
#pragma unroll
      for (int i = 0; i < 4; i++) {
        float2 csv[4][2];
        if (nb < 1088 && !(nb >= 640 && nb < 768)) {
#pragma unroll
          for (int r = 0; r < 4; r++) {
            const TokInfo tj = tokinfo(mt * 128 + wm * 64 + i * 16 + g4 * 4 + r);
#pragma unroll
            for (int jn = 0; jn < 2; jn++) csv[r][jn] = *(const float2*)(p.rope + (size_t)(tj.pos * 32 + jn * 16 + cl) * 2);
          }
        }
#pragma unroll
        for (int r = 0; r < 4; r++) {
          const int tok = mt * 128 + wm * 64 + i * 16 + g4 * 4 + r;
          const TokInfo ti = tokinfo(tok);
          if (nb < 1088) {
            if (nb >= 640 && nb < 768) {
              float* dst = ti.isP ? p.out + O_VP + ((size_t)(l * 2 + ti.b) * 8192 + ti.t) * 128
                                  : p.out + O_VS + ((size_t)(l * 32 + ti.b) * 64 + ti.t) * 128;
              bf16_t* dvb = p.VB + (size_t)(ti.isP ? ti.b * 8192 + ti.t : 16384 + ti.b * 2112 + 2048 + ti.t) * 128;
#pragma unroll
              for (int jn = 0; jn < 4; jn++) {
                dst[nb - 640 + jn * 16 + cl] = acc[i][jn][r];
                dvb[nb - 640 + jn * 16 + cl] = f2bf(acc[i][jn][r]);
              }
            } else {
#pragma unroll
              for (int jn = 0; jn < 2; jn++) {
                const int d = jn * 16 + cl;
                const float2 cs = csv[r][jn];
                const float x1 = acc[i][jn][r], x2 = acc[i][jn + 2][r];
                const float y1 = x1 * cs.x - x2 * cs.y, y2 = x1 * cs.y + x2 * cs.x;
                const int c1 = nb + d, c2 = nb + d + 32;
                if (nb < 512) {
                  p.qa[(size_t)tok * 512 + c1] = f2bf(y1 * 0.125f);
                  p.qa[(size_t)tok * 512 + c2] = f2bf(y2 * 0.125f);
                } else if (nb < 640) {
                  float* dst = ti.isP ? p.out + O_KP + ((size_t)(l * 2 + ti.b) * 8192 + ti.t) * 128
                                      : p.out + O_KS + ((size_t)(l * 32 + ti.b) * 64 + ti.t) * 128;
                  dst[c1 - 512] = y1;
                  dst[c2 - 512] = y2;
                  bf16_t* dkb = p.KB + (size_t)(ti.isP ? ti.b * 8192 + ti.t : 16384 + ti.b * 2112 + 2048 + ti.t) * 128;
                  dkb[c1 - 512] = f2bf(y1);
                  dkb[c2 - 512] = f2bf(y2);
                } else if (nb < 1024) {
                  p.qi[(size_t)tok * 256 + c1 - 768] = f2bf(y1 * 0.125f);
                  p.qi[(size_t)tok * 256 + c2 - 768] = f2bf(y2 * 0.125f);
                } else {
                  float* dst = ti.isP ? p.out + O_KIP + ((size_t)(l * 2 + ti.b) * 8192 + ti.t) * 64
                                      : p.out + O_KIS + ((size_t)(l * 32 + ti.b) * 64 + ti.t) * 64;
                  dst[c1 - 1024] = y1;
                  dst[c2 - 1024] = y2;
                  bf16_t* dib = p.KIB + (size_t)(ti.isP ? ti.b * 8192 + ti.t : 16384 + ti.b * 2112 + 2048 + ti.t) * 64;
                  dib[c1 - 1024] = f2bf(y1);
                  dib[c2 - 1024] = f2bf(y2);
                }
              }
            }
          } else if (nb == 1088) {
            if (cl < 4) p.wi[(size_t)tok * 4 + cl] = acc[i][0][r] * 0.5f;
          } else if (nb < 2816) {
            const int T = ti.isP ? 8192 : 64;
#pragma unroll
            for (int jn = 0; jn < 4; jn++) {
              const int c = nb - 1152 + jn * 16 + cl;
              const float v = acc[i][jn][r];
              p.R[(size_t)tok * RS + c] = v;
              if (ti.t == T - 1) {
                float* dst = ti.isP ? p.out + O_SHP + (size_t)(l * 2 + ti.b) * DSH : p.out + O_SHS + (size_t)(l * 32 + ti.b) * DSH;
                dst[c] = v;
              }
              if ((tok & 15) == 15) p.bnd[(size_t)(tok >> 4) * DSH + c] = v;
            }
          } else {
#pragma unroll
            for (int jn = 0; jn < 4; jn++)
              p.qm[(size_t)tok * 512 + nb - 2816 + jn * 16 + cl] = f2bf(acc[i][jn][r] * 0.08838834764831845f);
          }
        }
      }
    } else {
      const int u = t - NT1;
      const int lm = u >> 5, mt = (u >> 3) & 3, nt = u & 7;
      gemm_kloop(p.memn + ((size_t)lm * 512 + mt * 128) * DM, DM, p.Wmem + ((size_t)lm * DM + nt * 128) * DM, DM, DM, sm, acc);
#pragma unroll
      for (int i = 0; i < 4; i++)
#pragma unroll
        for (int r = 0; r < 4; r++) {
          const int row = mt * 128 + wm * 64 + i * 16 + g4 * 4 + r;
          const int bm = row >> 8, m = row & 255;
#pragma unroll
          for (int jn = 0; jn < 4; jn++) {
            const int n = nt * 128 + wn * 64 + jn * 16 + cl;
            const float v = acc[i][jn][r];
            if (n < 512) {
              p.out[O_MKP + ((size_t)(lm * 2 + bm) * 256 + m) * 512 + n] = v;
            } else {
              const int n2 = n - 512;
              p.out[O_MVP + ((size_t)(lm * 2 + bm) * 256 + m) * 512 + n2] = v;
              p.pmvT[((size_t)((lm * 2 + bm) * 4 + (n2 >> 7)) * 128 + (n2 & 127)) * 256 + m] = f2bf(v);
            }
          }
        }
    }
  }
}

DI void prep_phase(const Params& p, int l, char* smem, const bool dry = false) {
  float* rows = (float*)smem;
  float* tw = rows + 9 * DSH;
  float* ta = tw + 512;
  const int tid = otid(), lane = tid & 63, wave = tid >> 6;
  const float* mu = p.mu_shift + l * DSH;
  const float* w2 = p.w2 + (size_t)l * 64 * 512;
  const float* a2 = p.a2 + (size_t)l * 64 * 512;
  for (int task = blockIdx.x; task < TOK / 16; task += gridDim.x) {
    const int tok0 = task * 16;
    const TokInfo t0 = tokinfo(tok0);
    __syncthreads();
    for (int c = tid; c < DSH; c += 256) {
      float pv;
      if (t0.t == 0) pv = t0.isP ? 0.f : p.state_shift[(size_t)(l * 32 + t0.b) * DSH + c];
      else pv = p.bnd[(size_t)(task - 1) * DSH + c];
      rows[c] = pv;
    }
    for (int batch = 0; batch < 2; batch++) {
      const int tb = tok0 + batch * 8;
      __syncthreads();
      for (int f = tid; f < 8 * 416; f += 256) {
        int tk = f / 416, c4 = f - tk * 416;
        *(float4*)(rows + (tk + 1) * DSH + c4 * 4) = *(const float4*)(p.R + (size_t)(tb + tk) * RS + c4 * 4);
      }
      __syncthreads();
      for (int idx = tid; idx < 1024; idx += 256) {
        int tk = idx >> 7, ii = idx & 127;
        int col = 1536 + ii;
        float cur = rows[(tk + 1) * DSH + col], prv = rows[tk * DSH + col];
        float m = cur + (prv - cur) * mu[col];
        if (ii < 64) tw[tk * 64 + ii] = 1.f - 2.f * __builtin_amdgcn_rcpf(1.f + __expf(2.f * m));
        else ta[tk * 64 + ii - 64] = m;
      }
      __syncthreads();
      float accw[2][8], acca[2][8];
#pragma unroll
      for (int ch = 0; ch < 2; ch++) {
        const int c = tid + 256 * ch;
        const float bw = p.w0[l * 512 + c], ba = p.a0[l * 512 + c];
#pragma unroll
        for (int tk = 0; tk < 8; tk++) { accw[ch][tk] = bw; acca[ch][tk] = ba; }
      }
      for (int i4 = 0; i4 < 16; i4++) {
        float4 twv[8], tav[8];
#pragma unroll
        for (int tk = 0; tk < 8; tk++) {
          twv[tk] = *(const float4*)(tw + tk * 64 + i4 * 4);
          tav[tk] = *(const float4*)(ta + tk * 64 + i4 * 4);
        }
#pragma unroll
        for (int ii = 0; ii < 4; ii++) {
          const int i = i4 * 4 + ii;
#pragma unroll
          for (int ch = 0; ch < 2; ch++) {
            const int c = tid + 256 * ch;
            const float wv = w2[i * 512 + c], av = a2[i * 512 + c];
#pragma unroll
            for (int tk = 0; tk < 8; tk++) {
              const float x = ii == 0 ? twv[tk].x : ii == 1 ? twv[tk].y : ii == 2 ? twv[tk].z : twv[tk].w;
              const float y = ii == 0 ? tav[tk].x : ii == 1 ? tav[tk].y : ii == 2 ? tav[tk].z : tav[tk].w;
              accw[ch][tk] += x * wv;
              acca[ch][tk] += y * av;
            }
          }
        }
      }
#pragma unroll
      for (int ch = 0; ch < 2; ch++) {
        const int c = tid + 256 * ch;
        const int head = wave + 4 * ch;
        const float muR = mu[c], muK = mu[512 + c], muV = mu[1024 + c];
        const float kkc = p.k_k[l * 512 + c], kac = p.k_a[l * 512 + c], rkc = p.r_k[l * 512 + c];
#pragma unroll
        for (int tk = 0; tk < 8; tk++) {
          const float* rc = rows + (tk + 1) * DSH;
          const float* rp = rows + tk * DSH;
          const float r = rc[c] + (rp[c] - rc[c]) * muR;
          const float k = rc[512 + c] + (rp[512 + c] - rc[512 + c]) * muK;
          const float v = rc[1024 + c] + (rp[1024 + c] - rc[1024 + c]) * muV;
          const float xw = -accw[ch][tk];
          const float sp = fmaxf(xw, 0.f) + __logf(1.f + __expf(-fabsf(xw)));
          const float w = -sp - 0.5f;
          const float decay = __expf(-__expf(w));
          const float ag = __builtin_amdgcn_rcpf(1.f + __expf(-acca[ch][tk]));
          const float kkr = k * kkc;
          const float ss = wave_sum(kkr * kkr);
          const float kk = kkr * fminf(__builtin_amdgcn_rsqf(ss), 1e12f);
          const float kp = k * (1.f + (ag - 1.f) * kac);
          const float bon = wave_sum(r * kp * rkc);
          float* Rrow = p.R + (size_t)(tb + tk) * RS;
          bf16_t* Rb = (bf16_t*)(Rrow + 512);
          if (!dry) {
            Rrow[c] = decay;
            Rb[c] = f2bf(r);
            Rb[512 + c] = f2bf(kp);
            Rb[1024 + c] = f2bf(v);
            Rb[1536 + c] = f2bf(-kk);
            Rb[2048 + c] = f2bf(kk * ag);
            if (lane == 0) p.bonus[(size_t)(tb + tk) * 8 + head] = bon;
          } else if (decay + r + kp + v + kk + bon == 1.2345e30f) p.wi[0] = 1.f;
        }
      }
      __syncthreads();
      for (int c = tid; c < DSH; c += 256) rows[c] = rows[8 * DSH + c];
    }
  }
}

DI void scan_task(const Params& p, int l, int isP, int b, int h, int rg, char* smem, const bool dry) {
  float* buf = (float*)smem;
  float* vbuf = buf + 2 * 5 * 16 * 64;
  const int tid = otid(), lane = tid & 63, wave = tid >> 6;
  const int g4 = lane >> 4, jq = lane & 15;
  const int T = isP ? 8192 : 64;
  const int tokbase = isP ? b * 8192 : TP + b * 64;
  const int i = rg * 16 + wave * 4 + g4;
  f32x2 Sa = {0.f, 0.f}, Sb = {0.f, 0.f};
  if (!isP) {
    const float4 s = *(const float4*)(p.state_wkv + ((size_t)((l * 32 + b) * 8 + h) * 64 + i) * 64 + jq * 4);
    Sa = (f32x2){s.x, s.y}; Sb = (f32x2){s.z, s.w};
  }
  __builtin_amdgcn_s_setprio(3);
  const int ds = tid >> 4, dj = tid & 15;
  float4 rd;
  uint4 rbf[2], rv;
  const int nch = T >> 4;
  auto gload = [&](int c) {
    const int tk = tokbase + c * 16;
    rd = *(const float4*)(p.R + (size_t)(tk + ds) * RS + h * 64 + dj * 4);
#pragma unroll
    for (int u = 0; u < 2; u++) {
      const int id = tid + 256 * u;
      const int arr = id >> 7, s = (id >> 3) & 15, ch8 = id & 7;
      const int aofs = arr == 0 ? 0 : arr == 1 ? 512 : arr == 2 ? 1536 : 2048;
      rbf[u] = *(const uint4*)((const bf16_t*)(p.R + (size_t)(tk + s) * RS + 512) + aofs + h * 64 + ch8 * 8);
    }
    if (tid < 32) {
      const int s = tid >> 1, half = tid & 1;
      rv = *(const uint4*)((const bf16_t*)(p.R + (size_t)(tk + s) * RS + 512) + 1024 + h * 64 + rg * 16 + half * 8);
    }
  };
  auto sstore = [&](int bi) {
    float* bb = buf + bi * (5 * 16 * 64);
    *(float4*)(bb + ds * 64 + dj * 4) = rd;
#pragma unroll
    for (int u = 0; u < 2; u++) {
      const int id = tid + 256 * u;
      const int arr = id >> 7, s = (id >> 3) & 15, ch8 = id & 7;
      float* d = bb + (arr + 1) * (16 * 64) + s * 64 + ch8 * 8;
      const unsigned w[4] = {rbf[u].x, rbf[u].y, rbf[u].z, rbf[u].w};
      float4 lo, hi;
      lo.x = __uint_as_float(w[0] << 16); lo.y = __uint_as_float(w[0] & 0xFFFF0000u);
      lo.z = __uint_as_float(w[1] << 16); lo.w = __uint_as_float(w[1] & 0xFFFF0000u);
      hi.x = __uint_as_float(w[2] << 16); hi.y = __uint_as_float(w[2] & 0xFFFF0000u);
      hi.z = __uint_as_float(w[3] << 16); hi.w = __uint_as_float(w[3] & 0xFFFF0000u);
      *(float4*)d = lo;
      *(float4*)(d + 4) = hi;
    }
    if (tid < 32) {
      const int s = tid >> 1, half = tid & 1;
      float* d = vbuf + bi * 256 + s * 16 + half * 8;
      const unsigned w[4] = {rv.x, rv.y, rv.z, rv.w};
#pragma unroll
      for (int q = 0; q < 4; q++) {
        d[2 * q] = __uint_as_float(w[q] << 16);
        d[2 * q + 1] = __uint_as_float(w[q] & 0xFFFF0000u);
      }
    }
  };
  __syncthreads();
  gload(0);
  sstore(0);
  __syncthreads();
  for (int c = 0; c < nch; c++) {
    const bool more = c + 1 < nch;
    if (more) gload(c + 1);
    const float* bb = buf + (c & 1) * (5 * 16 * 64);
    const float* vb = vbuf + (c & 1) * 256;
    float* yo = p.yscan + (size_t)(tokbase + c * 16 + jq) * 512 + h * 64 + i;
    float ykeep = 0.f;
    f32x4 w4 = *(const f32x4*)(bb + jq * 4);
    f32x4 r4 = *(const f32x4*)(bb + 1024 + jq * 4);
    f32x4 k4 = *(const f32x4*)(bb + 2048 + jq * 4);
    f32x4 a4 = *(const f32x4*)(bb + 3072 + jq * 4);
    f32x4 b4 = *(const f32x4*)(bb + 4096 + jq * 4);
    float v = vb[wave * 4 + g4];
#pragma unroll
    for (int s = 0; s < 16; s++) {
      f32x4 w4n = w4, r4n = r4, k4n = k4, a4n = a4, b4n = b4;
      float vn = v;
      if (s < 15) {
        w4n = *(const f32x4*)(bb + (s + 1) * 64 + jq * 4);
        r4n = *(const f32x4*)(bb + 1024 + (s + 1) * 64 + jq * 4);
        k4n = *(const f32x4*)(bb + 2048 + (s + 1) * 64 + jq * 4);
        a4n = *(const f32x4*)(bb + 3072 + (s + 1) * 64 + jq * 4);
        b4n = *(const f32x4*)(bb + 4096 + (s + 1) * 64 + jq * 4);
        vn = vb[(s + 1) * 16 + wave * 4 + g4];
      }
      __builtin_amdgcn_sched_barrier(0);
      const f32x2 vv = {v, v};
      const f32x2 t = Sa * a4.lo + Sb * a4.hi;
      const f32x2 na = Sa * w4.lo + vv * k4.lo;
      const f32x2 nb = Sb * w4.hi + vv * k4.hi;
      const float sa = rowsum16(t.x + t.y);
      const f32x2 sv = {sa, sa};
      Sa = na + sv * b4.lo;
      Sb = nb + sv * b4.hi;
      const f32x2 yy = Sa * r4.lo + Sb * r4.hi;
      const float y = rowsum16(yy.x + yy.y);
      ykeep = (jq == s) ? y : ykeep;
      w4 = w4n; r4 = r4n; k4 = k4n; a4 = a4n; b4 = b4n; v = vn;
    }
    if (!dry) *yo = ykeep;
    if (more) sstore((c + 1) & 1);
    __syncthreads();
  }
  float* so = isP ? p.out + O_WKVP + ((size_t)((l * 2 + b) * 8 + h) * 64 + i) * 64 + jq * 4
                  : p.out + O_WKVS + ((size_t)((l * 32 + b) * 8 + h) * 64 + i) * 64 + jq * 4;
  if (!dry) *(float4*)so = make_float4(Sa.x, Sa.y, Sb.x, Sb.y);
  __builtin_amdgcn_s_setprio(0);
}

DI void mem_task(const Params& p, int l, int tok0, char* smem, const bool dry) {
  bf16_t* st = (bf16_t*)smem;
  const int tid = otid(), lane = tid & 63, wave = tid >> 6;
  const int g4 = lane >> 4, cl = lane & 15;
  const TokInfo ti = tokinfo(tok0);
  const float* Kb = ti.isP ? p.out + O_MKP + (size_t)(l * 2 + ti.b) * 256 * 512
                           : p.cache_mem_k + (size_t)(l * 32 + ti.b) * 256 * 512;
  const bf16_t* Vb = ti.isP ? p.pmvT + (size_t)(l * 2 + ti.b) * 4 * 128 * 256
                            : p.cmvT + (size_t)(l * 32 + ti.b) * 4 * 128 * 256;
  const int q0 = tok0 + wave * 16;
  for (int h = 0; h < 4; h++) {
    bf16x8 qf[4];
#pragma unroll
    for (int ks = 0; ks < 4; ks++) qf[ks] = *(const bf16x8*)(p.qm + (size_t)(q0 + cl) * 512 + h * 128 + ks * 32 + g4 * 8);
    __syncthreads();
    {
      const float* kp = Kb + (size_t)(tid >> 5) * 512 + h * 128 + (tid & 31) * 4;
      bf16_t* sp = st + (tid >> 5) * 136 + (tid & 31) * 4;
#pragma unroll 1
      for (int hb2 = 0; hb2 < 4; hb2++) {
        float4 kv[8];
#pragma unroll
        for (int u = 0; u < 8; u++) kv[u] = *(const float4*)(kp + (size_t)u * 8 * 512);
#pragma unroll
        for (int u = 0; u < 8; u++) {
          uint2 w;
          w.x = pack2(kv[u].x, kv[u].y);
          w.y = pack2(kv[u].z, kv[u].w);
          *(uint2*)(sp + u * 8 * 136) = w;
        }
        kp += 64 * 512;
        sp += 64 * 136;
      }
    }
    __syncthreads();
    f32x4 S[16];
#pragma unroll
    for (int mt = 0; mt < 16; mt++) {
      f32x4 a = (f32x4){0.f, 0.f, 0.f, 0.f};
      const bf16_t* kr = st + (mt * 16 + cl) * 136 + g4 * 8;
#pragma unroll
      for (int ks = 0; ks < 4; ks++) a = mfma16(*(const bf16x8*)(kr + ks * 32), qf[ks], a);
      S[mt] = a;
      if ((mt & 1) == 1) __builtin_amdgcn_sched_barrier(0);
    }
    float m = -1e30f;
#pragma unroll
    for (int mt = 0; mt < 16; mt++)
#pragma unroll
      for (int r = 0; r < 4; r++) m = fmaxf(m, S[mt][r]);
    m = fmaxf(m, __shfl_xor(m, 16));
    m = fmaxf(m, __shfl_xor(m, 32));
    float sum = 0.f;
#pragma unroll
    for (int mt = 0; mt < 16; mt++)
#pragma unroll
      for (int r = 0; r < 4; r++) {
        const float e = __expf(S[mt][r] - m);
        S[mt][r] = e;
        sum += e;
      }
    sum += __shfl_xor(sum, 16);
    sum += __shfl_xor(sum, 32);
    const float inv = __builtin_amdgcn_rcpf(sum);
    __syncthreads();
    {
      const bf16_t* vp = Vb + (size_t)h * 128 * 256 + (size_t)(tid >> 5) * 256 + (tid & 31) * 8;
      bf16_t* sp = st + (tid >> 5) * 264 + (tid & 31) * 8;
#pragma unroll 1
      for (int hb2 = 0; hb2 < 2; hb2++) {
        uint4 vv[8];
#pragma unroll
        for (int u = 0; u < 8; u++) vv[u] = *(const uint4*)(vp + (size_t)u * 8 * 256);
#pragma unroll
        for (int u = 0; u < 8; u++) *(uint4*)(sp + u * 8 * 264) = vv[u];
        vp += 64 * 256;
        sp += 64 * 264;
      }
    }
    __syncthreads();
    f32x4 o[8];
#pragma unroll
    for (int dt = 0; dt < 8; dt++) o[dt] = (f32x4){0.f, 0.f, 0.f, 0.f};
#pragma unroll
    for (int kk = 0; kk < 8; kk++) {
      union { bf16x8 v; unsigned u[4]; } pf;
      pf.u[0] = pack2(S[2 * kk][0], S[2 * kk][1]);
      pf.u[1] = pack2(S[2 * kk][2], S[2 * kk][3]);
      pf.u[2] = pack2(S[2 * kk + 1][0], S[2 * kk + 1][1]);
      pf.u[3] = pack2(S[2 * kk + 1][2], S[2 * kk + 1][3]);
#pragma unroll
      for (int dt = 0; dt < 8; dt++) {
        const bf16_t* vr = st + (dt * 16 + cl) * 264 + (2 * kk) * 16 + g4 * 4;
        union { bf16x8 v; uint2 u[2]; } vf;
        vf.u[0] = *(const uint2*)vr;
        vf.u[1] = *(const uint2*)(vr + 16);
        o[dt] = mfma16(vf.v, pf.v, o[dt]);
      }
      __builtin_amdgcn_sched_barrier(0);
    }
#pragma unroll
    for (int dt = 0; dt < 8; dt++) {
      uint2 stv;
      stv.x = pack2(o[dt][0] * inv, o[dt][1] * inv);
      stv.y = pack2(o[dt][2] * inv, o[dt][3] * inv);
      if (!dry) *(uint2*)(p.qm + (size_t)(q0 + cl) * 512 + h * 128 + dt * 16 + g4 * 4) = stv;
    }
  }
}

DI unsigned mono_key(float f) {
  const int u = __float_as_int(f + 0.0f);
  return (unsigned)u ^ ((unsigned)(u >> 31) | 0x80000000u);
}
DI float relu_(float x) { return __builtin_amdgcn_fmed3f(x, 0.f, __builtin_inff()); }

DI void dsa_task(const Params& p, int l, int isP, int b, int tq, char* smem, const bool dry) {
  unsigned* hist = (unsigned*)smem;
  unsigned short* idxl = (unsigned short*)(smem + 16384);
  unsigned short* tiel = (unsigned short*)smem;
  bf16_t* kst = (bf16_t*)(smem + 24576);
  float* pl = (float*)(smem + 24576);
  float* op = (float*)(smem + 32768);
  float* ml = (float*)(smem + 40960);
  unsigned* cnt = (unsigned*)(smem + 61440);
  unsigned* res = (unsigned*)(smem + 61504);
  unsigned* ccnt = (unsigned*)(smem + 61632);
  unsigned* ovf = (unsigned*)(smem + 61696);
  unsigned* ckey = (unsigned*)(smem + 61952);
  unsigned* cidx = (unsigned*)(smem + 66048);
  const int tid = otid(), lane = tid & 63, wave = tid >> 6;
  const int g4 = lane >> 4, cl = lane & 15;
  const int tokq0 = (isP ? b * 8192 : TP + b * 64) + tq;
  const int S = isP ? ((tq >> 6) + 1) * 64 : 2112;
  const size_t seqbase = isP ? (size_t)b * 8192 : (size_t)16384 + (size_t)b * 2112;
  const bf16_t* KIs = p.KIB + seqbase * 64;
  const bf16_t* Ks = p.KB + seqbase * 128;
  const bf16_t* Vs = p.VB + seqbase * 128;
  const int nsel = S < 256 ? S : 256;
  __syncthreads();
  if (S <= 256) {
    for (int e = tid; e < 16 * 256; e += 256) idxl[e] = (unsigned short)(e & 255);
  } else {
    const int qloc = wave * 4 + g4;
    bf16x8 aq0, aq1;
    {
      const bf16_t* qp = p.qi + ((size_t)(tokq0 + wave * 4) * 4 + cl) * 64 + g4 * 8;
      aq0 = *(const bf16x8*)qp;
      aq1 = *(const bf16x8*)(qp + 32);
    }
    const float4 wq = *(const float4*)(p.wi + (size_t)(tokq0 + qloc) * 4);
    unsigned prefix = 0u, need = 256u;
    const int nchunks = (S + 255) >> 8;
    const int skey = tid >> 3, sc8 = (tid & 7) * 8;
    for (int pass = 0; pass < 6; pass++) {
      const int kind = (pass == 2) ? 1 : (pass == 5) ? 2 : 0;
      const int shift = pass == 0 ? 24 : pass == 1 ? 16 : pass == 3 ? 8 : 0;
      if (kind == 0) {
        for (int e = tid; e < 1024; e += 256) ((uint4*)hist)[e] = make_uint4(0, 0, 0, 0);
      } else {
        if (tid < 16) { cnt[tid] = 0u; ccnt[tid] = 0u; }
        if (tid == 16) *ovf = 0u;
      }
      unsigned tiecnt = 0u;
      const unsigned G = 256u - need;
      uint4 rg0, rg1, rg2, rg3, rg4, rg5, rg6, rg7;
#define KLOAD(KC)                                                                            \
  {                                                                                          \
    const bf16_t* src = KIs + (size_t)((KC) * 256 + skey) * 64 + sc8;                        \
    const int kb0 = (KC) * 256 + skey;                                                       \
    if (kb0 < S) rg0 = *(const uint4*)(src);                                                 \
    if (kb0 + 32 < S) rg1 = *(const uint4*)(src + 32 * 64);                                  \
    if (kb0 + 64 < S) rg2 = *(const uint4*)(src + 64 * 64);                                  \
    if (kb0 + 96 < S) rg3 = *(const uint4*)(src + 96 * 64);                                  \
    if (kb0 + 128 < S) rg4 = *(const uint4*)(src + 128 * 64);                                \
    if (kb0 + 160 < S) rg5 = *(const uint4*)(src + 160 * 64);                                \
    if (kb0 + 192 < S) rg6 = *(const uint4*)(src + 192 * 64);                                \
    if (kb0 + 224 < S) rg7 = *(const uint4*)(src + 224 * 64);                                \
  }
      rg0 = rg1 = rg2 = rg3 = rg4 = rg5 = rg6 = rg7 = make_uint4(0, 0, 0, 0);
      KLOAD(0)
      for (int kc = 0; kc < nchunks; kc++) {
        __syncthreads();
        {
          bf16_t* d = kst + skey * 72 + sc8;
          *(uint4*)(d) = rg0;
          *(uint4*)(d + 32 * 72) = rg1;
          *(uint4*)(d + 64 * 72) = rg2;
          *(uint4*)(d + 96 * 72) = rg3;
          *(uint4*)(d + 128 * 72) = rg4;
          *(uint4*)(d + 160 * 72) = rg5;
          *(uint4*)(d + 192 * 72) = rg6;
          *(uint4*)(d + 224 * 72) = rg7;
        }
        __syncthreads();
        if (kc + 1 < nchunks) KLOAD(kc + 1)
        const int ngrp = (S - kc * 256) >= 256 ? 4 : ((S - kc * 256) >> 6);
        for (int tg = 0; tg < ngrp; tg++) {
          unsigned keys[4];
#pragma unroll
          for (int tt = 0; tt < 4; tt++) {
            const bf16_t* br = kst + ((tg * 4 + tt) * 16 + cl) * 72 + g4 * 8;
            const bf16x8 b0 = *(const bf16x8*)br;
            const bf16x8 b1 = *(const bf16x8*)(br + 32);
            f32x4 a = (f32x4){0.f, 0.f, 0.f, 0.f};
            a = mfma16(aq0, b0, a);
            a = mfma16(aq1, b1, a);
            const float score = wq.x * relu_(a[0]) + wq.y * relu_(a[1]) + wq.z * relu_(a[2]) + wq.w * relu_(a[3]);
            keys[tt] = mono_key(score);
          }
#pragma unroll
          for (int tt = 0; tt < 4; tt++) {
            const unsigned key = keys[tt];
            const int kidx = kc * 256 + (tg * 4 + tt) * 16 + cl;
            if (kind == 0) {
              const bool match = (pass == 0) || ((key >> (shift + 8)) == prefix);
              if (match) atomicAdd(&hist[qloc * 256 + ((key >> shift) & 255u)], 1u);
            } else if (kind == 1) {
              const unsigned hk = key >> 16;
              const bool tz = (hk == prefix) && ((key & 0xFFFFu) == 0u);
              if (hk > prefix) {
                const unsigned slot = atomicAdd(&cnt[qloc], 1u);
                if (slot < 256u) idxl[qloc * 256 + slot] = (unsigned short)kidx;
              } else if (hk == prefix && !tz) {
                const unsigned c = atomicAdd(&ccnt[qloc], 1u);
                if (c < 64u) { ckey[qloc * 64 + c] = key; cidx[qloc * 64 + c] = (unsigned)kidx; }
              }
              const unsigned long long bm = __ballot(tz);
              if (bm != 0ull) {
                const unsigned mg = (unsigned)(bm >> (g4 * 16)) & 0xFFFFu;
                const unsigned rank = tiecnt + __popc(mg & ((1u << cl) - 1u));
                if (tz && rank < need) tiel[qloc * 256 + rank] = (unsigned short)kidx;
                tiecnt += __popc(mg);
              }
            } else {
              if (key > prefix) {
                const unsigned slot = atomicAdd(&cnt[qloc], 1u);
                if (slot < 256u) idxl[qloc * 256 + slot] = (unsigned short)kidx;
              }
              const bool eq = (key == prefix);
              const unsigned long long bm = __ballot(eq);
              if (bm != 0ull) {
                const unsigned mg = (unsigned)(bm >> (g4 * 16)) & 0xFFFFu;
                const unsigned rank = tiecnt + __popc(mg & ((1u << cl) - 1u));
                if (eq && rank < need) idxl[qloc * 256 + G + rank] = (unsigned short)kidx;
                tiecnt += __popc(mg);
              }
            }
          }
        }
      }
#undef KLOAD
      __syncthreads();
      if (kind == 0) {
        const unsigned* hq = hist + qloc * 256;
        const int top = 255 - 16 * cl;
        unsigned sum = 0u;
#pragma unroll
        for (int u = 0; u < 16; u++) sum += hq[top - u];
        unsigned incl = sum;
#pragma unroll
        for (int d = 1; d < 16; d <<= 1) {
          const unsigned t = __shfl_up(incl, d, 16);
          if (cl >= d) incl += t;
        }
        const unsigned excl = incl - sum;
        if (excl < need && incl >= need) {
          unsigned cum = excl;
          int bsel = top - 15;
          unsigned above = excl;
          bool found = false;
#pragma unroll
          for (int u = 0; u < 16; u++) {
            const unsigned c = hq[top - u];
            if (!found && cum + c >= need) { bsel = top - u; above = cum; found = true; }
            cum += c;
          }
          res[qloc * 2] = (unsigned)bsel;
          res[qloc * 2 + 1] = above;
        }
        __syncthreads();
        const unsigned bstar = res[qloc * 2], above = res[qloc * 2 + 1];
        need -= above;
        prefix = (prefix << 8) | bstar;
      } else if (kind == 1) {
        const unsigned c = ccnt[qloc];
        if (c > 64u) {
          if (cl == 0) *ovf = 1u;
        } else {
          for (unsigned i = cl; i < c; i += 16) {
            const unsigned ki = ckey[qloc * 64 + i], ii = cidx[qloc * 64 + i];
            unsigned rank = 0u;
            for (unsigned j = 0; j < c; j++) {
              const unsigned kj = ckey[qloc * 64 + j], ij = cidx[qloc * 64 + j];
              rank += (kj > ki || (kj == ki && ij < ii)) ? 1u : 0u;
            }
            if (rank < need) idxl[qloc * 256 + G + rank] = (unsigned short)ii;
          }
          const unsigned nso = c < need ? c : need;
          for (unsigned t = cl; t < need - nso; t += 16) idxl[qloc * 256 + G + nso + t] = tiel[qloc * 256 + t];
        }
        __syncthreads();
        if (*ovf == 0u) break;
      }
    }
  }
  __syncthreads();
  float* opq = (float*)smem;
  float* mlq = (float*)(smem + 61952);
  char* vst = smem + 24576 + wave * 9216;
  const bool active = wave * 64 < nsel;
  uint4 vq0, vq1, vq2, vq3, vq4, vq5, vq6, vq7, vq8, vq9, vq10, vq11, vq12, vq13, vq14, vq15;
  bf16x8 kf[2][4][2];
  if (active) {
    vq0 = *(const uint4*)(Vs + (size_t)idxl[wave * 64 + 0 + g4] * 128 + cl * 8);
    vq1 = *(const uint4*)(Vs + (size_t)idxl[wave * 64 + 4 + g4] * 128 + cl * 8);
    vq2 = *(const uint4*)(Vs + (size_t)idxl[wave * 64 + 8 + g4] * 128 + cl * 8);
    vq3 = *(const uint4*)(Vs + (size_t)idxl[wave * 64 + 12 + g4] * 128 + cl * 8);
    vq4 = *(const uint4*)(Vs + (size_t)idxl[wave * 64 + 16 + g4] * 128 + cl * 8);
    vq5 = *(const uint4*)(Vs + (size_t)idxl[wave * 64 + 20 + g4] * 128 + cl * 8);
    vq6 = *(const uint4*)(Vs + (size_t)idxl[wave * 64 + 24 + g4] * 128 + cl * 8);
    vq7 = *(const uint4*)(Vs + (size_t)idxl[wave * 64 + 28 + g4] * 128 + cl * 8);
    vq8 = *(const uint4*)(Vs + (size_t)idxl[wave * 64 + 32 + g4] * 128 + cl * 8);
    vq9 = *(const uint4*)(Vs + (size_t)idxl[wave * 64 + 36 + g4] * 128 + cl * 8);
    vq10 = *(const uint4*)(Vs + (size_t)idxl[wave * 64 + 40 + g4] * 128 + cl * 8);
    vq11 = *(const uint4*)(Vs + (size_t)idxl[wave * 64 + 44 + g4] * 128 + cl * 8);
    vq12 = *(const uint4*)(Vs + (size_t)idxl[wave * 64 + 48 + g4] * 128 + cl * 8);
    vq13 = *(const uint4*)(Vs + (size_t)idxl[wave * 64 + 52 + g4] * 128 + cl * 8);
    vq14 = *(const uint4*)(Vs + (size_t)idxl[wave * 64 + 56 + g4] * 128 + cl * 8);
    vq15 = *(const uint4*)(Vs + (size_t)idxl[wave * 64 + 60 + g4] * 128 + cl * 8);
#pragma unroll
    for (int tt = 0; tt < 4; tt++) {
      const int pos = idxl[wave * 64 + tt * 16 + cl];
#pragma unroll
      for (int j = 0; j < 2; j++) {
        const bf16_t* kr = Ks + (size_t)pos * 128 + j * 64 + g4 * 8;
        kf[j][tt][0] = *(const bf16x8*)kr;
        kf[j][tt][1] = *(const bf16x8*)(kr + 32);
      }
    }
  }
  for (int qq = 0; qq < 16; qq++) {
    const int tok = tokq0 + qq;
    const int qn = qq < 15 ? qq + 1 : 15;
    float* opb = opq + (qq & 1) * 2048;
    float* mlb = mlq + (qq & 1) * 64;
    if (active) {
      union PB { bf16x8 v; unsigned u[4]; };
      PB pb[2][2];
#pragma unroll
      for (int j = 0; j < 2; j++) {
        const bf16_t* qp = p.qa + (size_t)tok * 512 + (j * 4 + (cl & 3)) * 64 + g4 * 8;
        const bf16x8 bq0 = *(const bf16x8*)qp;
        const bf16x8 bq1 = *(const bf16x8*)(qp + 32);
        f32x4 lg[4];
#pragma unroll
        for (int tt = 0; tt < 4; tt++) {
          f32x4 a = (f32x4){0.f, 0.f, 0.f, 0.f};
          a = mfma16(kf[j][tt][0], bq0, a);
          a = mfma16(kf[j][tt][1], bq1, a);
          lg[tt] = a;
        }
        float m = -1e30f;
#pragma unroll
        for (int tt = 0; tt < 4; tt++)
#pragma unroll
          for (int r = 0; r < 4; r++) m = fmaxf(m, lg[tt][r]);
        m = fmaxf(m, __shfl_xor(m, 16));
        m = fmaxf(m, __shfl_xor(m, 32));
        float sum = 0.f;
#pragma unroll
        for (int tt = 0; tt < 4; tt++)
#pragma unroll
          for (int r = 0; r < 4; r++) {
            const float e = __expf(lg[tt][r] - m);
            lg[tt][r] = e;
            sum += e;
          }
        sum += __shfl_xor(sum, 16);
        sum += __shfl_xor(sum, 32);
#pragma unroll
        for (int sI = 0; sI < 2; sI++) {
          pb[j][sI].u[0] = pack2(lg[2 * sI][0], lg[2 * sI][1]);
          pb[j][sI].u[1] = pack2(lg[2 * sI][2], lg[2 * sI][3]);
          pb[j][sI].u[2] = pack2(lg[2 * sI + 1][0], lg[2 * sI + 1][1]);
          pb[j][sI].u[3] = pack2(lg[2 * sI + 1][2], lg[2 * sI + 1][3]);
        }
        if (cl < 4 && g4 == 0) {
          mlb[(wave * 8 + j * 4 + cl) * 2] = m;
          mlb[(wave * 8 + j * 4 + cl) * 2 + 1] = sum;
        }
      }
#pragma unroll
      for (int tt = 0; tt < 4; tt++) {
        const int pos = idxl[qn * 256 + wave * 64 + tt * 16 + cl];
#pragma unroll
        for (int j = 0; j < 2; j++) {
          const bf16_t* kr = Ks + (size_t)pos * 128 + j * 64 + g4 * 8;
          kf[j][tt][0] = *(const bf16x8*)kr;
          kf[j][tt][1] = *(const bf16x8*)(kr + 32);
        }
      }
      f32x4 o[2][4];
#pragma unroll
      for (int j = 0; j < 2; j++)
#pragma unroll
        for (int dt = 0; dt < 4; dt++) o[j][dt] = (f32x4){0.f, 0.f, 0.f, 0.f};
      const lds_cptr vb = (lds_cptr)(vst + (g4 * 4 + (cl >> 2)) * 288 + (cl & 3) * 8);
      {
        *(uint4*)(vst + (0 + g4) * 288 + cl * 16) = vq0;
        *(uint4*)(vst + (4 + g4) * 288 + cl * 16) = vq1;
        *(uint4*)(vst + (8 + g4) * 288 + cl * 16) = vq2;
        *(uint4*)(vst + (12 + g4) * 288 + cl * 16) = vq3;
        *(uint4*)(vst + (16 + g4) * 288 + cl * 16) = vq4;
        *(uint4*)(vst + (20 + g4) * 288 + cl * 16) = vq5;
        *(uint4*)(vst + (24 + g4) * 288 + cl * 16) = vq6;
        *(uint4*)(vst + (28 + g4) * 288 + cl * 16) = vq7;
        __builtin_amdgcn_wave_barrier();
#pragma unroll
        for (int j = 0; j < 2; j++)
#pragma unroll
          for (int dt = 0; dt < 4; dt++) {
            const s16x4 alo = vtr(vb + (j * 64 + dt * 16) * 2);
            const s16x4 ahi = vtr(vb + (j * 64 + dt * 16) * 2 + 16 * 288);
            const bf16x8 af = __builtin_shufflevector(alo, ahi, 0, 1, 2, 3, 4, 5, 6, 7);
            o[j][dt] = mfma16(af, pb[j][0].v, o[j][dt]);
          }
        __builtin_amdgcn_wave_barrier();
      }
      {
        *(uint4*)(vst + (0 + g4) * 288 + cl * 16) = vq8;
        *(uint4*)(vst + (4 + g4) * 288 + cl * 16) = vq9;
        *(uint4*)(vst + (8 + g4) * 288 + cl * 16) = vq10;
        *(uint4*)(vst + (12 + g4) * 288 + cl * 16) = vq11;
        *(uint4*)(vst + (16 + g4) * 288 + cl * 16) = vq12;
        *(uint4*)(vst + (20 + g4) * 288 + cl * 16) = vq13;
        *(uint4*)(vst + (24 + g4) * 288 + cl * 16) = vq14;
        *(uint4*)(vst + (28 + g4) * 288 + cl * 16) = vq15;
        __builtin_amdgcn_wave_barrier();
#pragma unroll
        for (int j = 0; j < 2; j++)
#pragma unroll
          for (int dt = 0; dt < 4; dt++) {
            const s16x4 alo = vtr(vb + (j * 64 + dt * 16) * 2);
            const s16x4 ahi = vtr(vb + (j * 64 + dt * 16) * 2 + 16 * 288);
            const bf16x8 af = __builtin_shufflevector(alo, ahi, 0, 1, 2, 3, 4, 5, 6, 7);
            o[j][dt] = mfma16(af, pb[j][1].v, o[j][dt]);
          }
        __builtin_amdgcn_wave_barrier();
      }
      vq0 = *(const uint4*)(Vs + (size_t)idxl[qn * 256 + wave * 64 + 0 + g4] * 128 + cl * 8);
      vq1 = *(const uint4*)(Vs + (size_t)idxl[qn * 256 + wave * 64 + 4 + g4] * 128 + cl * 8);
      vq2 = *(const uint4*)(Vs + (size_t)idxl[qn * 256 + wave * 64 + 8 + g4] * 128 + cl * 8);
      vq3 = *(const uint4*)(Vs + (size_t)idxl[qn * 256 + wave * 64 + 12 + g4] * 128 + cl * 8);
      vq4 = *(const uint4*)(Vs + (size_t)idxl[qn * 256 + wave * 64 + 16 + g4] * 128 + cl * 8);
      vq5 = *(const uint4*)(Vs + (size_t)idxl[qn * 256 + wave * 64 + 20 + g4] * 128 + cl * 8);
      vq6 = *(const uint4*)(Vs + (size_t)idxl[qn * 256 + wave * 64 + 24 + g4] * 128 + cl * 8);
      vq7 = *(const uint4*)(Vs + (size_t)idxl[qn * 256 + wave * 64 + 28 + g4] * 128 + cl * 8);
      vq8 = *(const uint4*)(Vs + (size_t)idxl[qn * 256 + wave * 64 + 32 + g4] * 128 + cl * 8);
      vq9 = *(const uint4*)(Vs + (size_t)idxl[qn * 256 + wave * 64 + 36 + g4] * 128 + cl * 8);
      vq10 = *(const uint4*)(Vs + (size_t)idxl[qn * 256 + wave * 64 + 40 + g4] * 128 + cl * 8);
      vq11 = *(const uint4*)(Vs + (size_t)idxl[qn * 256 + wave * 64 + 44 + g4] * 128 + cl * 8);
      vq12 = *(const uint4*)(Vs + (size_t)idxl[qn * 256 + wave * 64 + 48 + g4] * 128 + cl * 8);
      vq13 = *(const uint4*)(Vs + (size_t)idxl[qn * 256 + wave * 64 + 52 + g4] * 128 + cl * 8);
      vq14 = *(const uint4*)(Vs + (size_t)idxl[qn * 256 + wave * 64 + 56 + g4] * 128 + cl * 8);
      vq15 = *(const uint4*)(Vs + (size_t)idxl[qn * 256 + wave * 64 + 60 + g4] * 128 + cl * 8);
      if (cl < 4) {
#pragma unroll
        for (int j = 0; j < 2; j++)
#pragma unroll
          for (int dt = 0; dt < 4; dt++) *(f32x4*)(opb + (wave * 8 + j * 4 + cl) * 64 + dt * 16 + g4 * 4) = o[j][dt];
      }
    } else {
      if (lane < 8) {
        mlb[(wave * 8 + lane) * 2] = -1e30f;
        mlb[(wave * 8 + lane) * 2 + 1] = 0.f;
      }
      *(f32x4*)(opb + wave * 512 + lane * 8) = (f32x4){0.f, 0.f, 0.f, 0.f};
      *(f32x4*)(opb + wave * 512 + lane * 8 + 4) = (f32x4){0.f, 0.f, 0.f, 0.f};
    }
    __syncthreads();
    {
      const int e = tid * 2, head = e >> 6, d = e & 63;
      float M = -1e30f;
#pragma unroll
      for (int w = 0; w < 4; w++) M = fmaxf(M, mlb[(w * 8 + head) * 2]);
      float den = 0.f, n0 = 0.f, n1 = 0.f;
#pragma unroll
      for (int w = 0; w < 4; w++) {
        const float f = __expf(mlb[(w * 8 + head) * 2] - M);
        den += mlb[(w * 8 + head) * 2 + 1] * f;
        const float2 o2 = *(const float2*)(opb + (w * 8 + head) * 64 + d);
        n0 += o2.x * f;
        n1 += o2.y * f;
      }
      const float inv = __builtin_amdgcn_rcpf(den);
      if (!dry) *(unsigned*)(p.qa + (size_t)tok * 512 + e) = pack2(n0 * inv, n1 * inv);
    }
  }
  __syncthreads();
}

DI void mixer_phase(const Params& p, int l, char* smem, const bool dry = false, const int ci = 0) {
  const int tid = otid();
  const int NTASK = 64 + 1024 + 1024 + 128 + 288;
  const int NEXTRA = (l == 0 && !dry) ? 456 : 0;
  bool first = true;
  for (;;) {
    int id;
    if (first && blockIdx.x < 64) {
      id = blockIdx.x;
    } else {
      __syncthreads();
      if (tid == 0) *(int*)(smem + SLOT) = 64 + (int)atomicAdd(&p.ctr[l + ci], 1u);
      __syncthreads();
      id = *(const int*)(smem + SLOT);
    }
    first = false;
    if (id >= NTASK + NEXTRA) break;
    if (id >= NTASK) {
      for (int q = 0; q < 8; q++) {
        const int d = (id - NTASK) * 8 + q;
        const int t = d < 1984 ? 2880 + d : d < 2624 ? 2880 + 2240 + (d - 1984) : 5760 + 1024 + (d - 2624);
        transpose_job(p, t, (float*)smem);
      }
      continue;
    }
    const int d = id - 64;
    if (id < 64 || d >= 1440) {
      int isP, b, h, rg;
      if (id < 64) { isP = 1; b = id >> 5; h = (id >> 2) & 7; rg = id & 3; }
      else { const int s = d - 1440; isP = 0; b = s >> 5; h = (s >> 2) & 7; rg = s & 3; }
      if (!(dry && (PROBE_SKIP & 2))) scan_task(p, l, isP, b, h, rg, smem, dry);
    } else if (d < 896 || d >= 1184) {
      int isP, b, tq;
      if (d < 768) { isP = 1; b = d & 1; tq = (511 - (d >> 1)) * 16; }
      else if (d < 896) { const int s = d - 768; isP = 0; b = s >> 2; tq = (s & 3) * 16; }
      else { const int s = d - 1184; isP = 1; b = s & 1; tq = (127 - (s >> 1)) * 16; }
      if (!(dry && (PROBE_SKIP & 1))) dsa_task(p, l, isP, b, tq, smem, dry);
    } else {
      if (!(dry && (PROBE_SKIP & 4))) mem_task(p, l, (d - 896) * 64, smem, dry);
    }
  }
}

DI void post_phase(const Params& p, int l) {
  const int tid = otid(), lane = tid & 63, wave = tid >> 6;
  for (int tok = blockIdx.x * 4 + wave; tok < TOK; tok += gridDim.x * 4) {
    float y[8], lw[8], lb[8], vv[8], bo[8];
    const bf16_t* vb = (const bf16_t*)(p.R + (size_t)tok * RS + 512) + 1024;
#pragma unroll
    for (int h = 0; h < 8; h++) {
      const int c = h * 64 + lane;
      y[h] = p.yscan[(size_t)tok * 512 + c];
      lw[h] = p.ln_w[l * 512 + c];
      lb[h] = p.ln_b[l * 512 + c];
      vv[h] = bf2f(vb[c]);
      bo[h] = p.bonus[(size_t)tok * 8 + h];
    }
#pragma unroll
    for (int h = 0; h < 8; h++) {
      const float mean = wave_sum(y[h]) * (1.f / 64.f);
      const float dv = y[h] - mean;
      const float var = wave_sum(dv * dv) * (1.f / 64.f);
      const float yn = dv * rsqrtf(var + 64e-5f) * lw[h] + lb[h];
      y[h] = yn + bo[h] * vv[h];
    }
#pragma unroll
    for (int h = 0; h < 8; h++) p.o_r[(size_t)tok * 512 + h * 64 + lane] = f2bf(y[h]);
  }
}

DI void gemm2_phase(const Params& p, int l, char* smem, const bool dry = false) {
  bf16_t* sm = (bf16_t*)smem;
  const int tid = otid(), lane = tid & 63, wave = tid >> 6;
  const int wm = wave >> 1, wn = wave & 1, g4 = lane >> 4, cl = lane & 15;
  const int slots = gridDim.x >> 3, slot = blockIdx.x >> 3;
  for (int e = slot;; e += slots) {
    int mt, nt;
    if (!xcd_tile(e, 36, mt, nt)) break;
    f32x4 acc[4][4];
    zero_acc(acc);
    gemm_kloop(p.hb + (size_t)mt * 128 * DM, DM, p.Wt2 + ((size_t)l * N2 + nt * 128) * DM, DM, DM, sm, acc);
    const int nb = nt * 128 + wn * 64;
    if (dry) {
      if (acc[0][0][0] == 1.2345e30f) p.wi[0] = acc[1][1][1] + acc[2][2][2] + acc[3][3][3];
    } else if (nb < 1536) {
      bf16_t* base = (nb < 512 ? p.qa : nb < 1024 ? p.o_r : p.qm) + (nb & 511) + cl;
      bf16_t old[4][4][4];
#pragma unroll
      for (int i = 0; i < 4; i++)
#pragma unroll
        for (int r = 0; r < 4; r++) {
          const int tok = mt * 128 + wm * 64 + i * 16 + g4 * 4 + r;
#pragma unroll
          for (int jn = 0; jn < 4; jn++) old[i][r][jn] = base[(size_t)tok * 512 + jn * 16];
        }
#pragma unroll
      for (int i = 0; i < 4; i++)
#pragma unroll
        for (int r = 0; r < 4; r++) {
          const int tok = mt * 128 + wm * 64 + i * 16 + g4 * 4 + r;
#pragma unroll
          for (int jn = 0; jn < 4; jn++) base[(size_t)tok * 512 + jn * 16] = f2bf(bf2f(old[i][r][jn]) * siluf_(acc[i][jn][r]));
        }
    } else {
#pragma unroll
      for (int i = 0; i < 4; i++)
#pragma unroll
        for (int r = 0; r < 4; r++) {
          const int tok = mt * 128 + wm * 64 + i * 16 + g4 * 4 + r;
#pragma unroll
          for (int jn = 0; jn < 4; jn++)
            p.G[(size_t)tok * 3072 + nb - 1536 + jn * 16 + cl] = f2bf(sigmoidf_(acc[i][jn][r]));
        }
    }
  }
}

DI void merge_phase(const Params& p, int l, char* smem) {
  bf16_t* sm = (bf16_t*)smem;
  const int tid = otid(), lane = tid & 63, wave = tid >> 6;
  const int g4 = lane >> 4, cl = lane & 15;
  const int slots = gridDim.x >> 3, slot = blockIdx.x >> 3;
  for (int e = slot;; e += slots) {
    int mt, nt;
    if (!xcd_tile(e, 16, mt, nt)) break;
    f32x4 tot[2][4];
#pragma unroll
    for (int i = 0; i < 2; i++)
#pragma unroll
      for (int j = 0; j < 4; j++) tot[i][j] = (f32x4){0.f, 0.f, 0.f, 0.f};
#pragma unroll 1
    for (int br = 0; br < 3; br++) {
      f32x4 acc[2][4];
#pragma unroll
      for (int i = 0; i < 2; i++)
#pragma unroll
        for (int j = 0; j < 4; j++) acc[i][j] = (f32x4){0.f, 0.f, 0.f, 0.f};
      const bf16_t* A = (br == 0 ? p.qa : br == 1 ? p.o_r : p.qm) + (size_t)mt * 128 * 512;
      gemm_kloop64(A, 512, p.Wbr + ((size_t)(l * 3 + br) * DM + nt * 64) * 512, 512, 512, sm, acc);
#pragma unroll
      for (int i = 0; i < 2; i++)
#pragma unroll
        for (int r = 0; r < 4; r++) {
          const int tok = mt * 128 + wave * 32 + i * 16 + g4 * 4 + r;
#pragma unroll
          for (int jn = 0; jn < 4; jn++) {
            const int n = nt * 64 + jn * 16 + cl;
            const float g = bf2f(p.G[(size_t)tok * 3072 + br * 1024 + n]);
            tot[i][jn][r] += g * acc[i][jn][r];
          }
        }
    }
#pragma unroll
    for (int i = 0; i < 2; i++)
#pragma unroll
      for (int r = 0; r < 4; r++) {
        const int tok = mt * 128 + wave * 32 + i * 16 + g4 * 4 + r;
#pragma unroll
        for (int jn = 0; jn < 4; jn++) {
          const int n = nt * 64 + jn * 16 + cl;
          p.merged[(size_t)tok * DM + n] = f2bf(tot[i][jn][r]);
        }
      }
  }
}

DI void out_phase(const Params& p, int l, char* smem, const bool dry = false) {
  bf16_t* sm = (bf16_t*)smem;
  const int tid = otid(), lane = tid & 63, wave = tid >> 6;
  const int wm = wave >> 1, wn = wave & 1, g4 = lane >> 4, cl = lane & 15;
  const int slots = gridDim.x >> 3, slot = blockIdx.x >> 3;
  for (int e = slot;; e += slots) {
    int mt, nt;
    if (!xcd_tile(e, 8, mt, nt)) break;
    f32x4 acc[4][4];
    zero_acc(acc);
    gemm_kloop(p.merged + (size_t)mt * 128 * DM, DM, p.Wout + ((size_t)l * DM + nt * 128) * DM, DM, DM, sm, acc);
    if (dry) {
      if (acc[0][0][0] == 1.2345e30f) p.wi[0] = acc[1][1][1] + acc[2][2][2] + acc[3][3][3];
      continue;
    }
    float xo[4][4][4];
#pragma unroll
    for (int i = 0; i < 4; i++)
#pragma unroll
      for (int r = 0; r < 4; r++) {
        const int tok = mt * 128 + wm * 64 + i * 16 + g4 * 4 + r;
        const float* xr = xrow_ptr(p, l, tok);
#pragma unroll
        for (int jn = 0; jn < 4; jn++) xo[i][r][jn] = xr[nt * 128 + wn * 64 + jn * 16 + cl];
      }
#pragma unroll
    for (int i = 0; i < 4; i++)
#pragma unroll
      for (int r = 0; r < 4; r++) {
        const int tok = mt * 128 + wm * 64 + i * 16 + g4 * 4 + r;
#pragma unroll
        for (int jn = 0; jn < 4; jn++) {
          const int n = nt * 128 + wn * 64 + jn * 16 + cl;
          p.out[(size_t)tok * DM + n] = xo[i][r][jn] + acc[i][jn][r];
        }
      }
  }
}

DI void norm_phase(const Params& p, int l) {
  const int wave = otid() >> 6;
  for (int tok = blockIdx.x * 4 + wave; tok < TOK; tok += gridDim.x * 4)
    norm_row_bf16(xrow_ptr(p, l, tok), p.norm_g + l * DM, p.hb + (size_t)tok * DM);
}
DI void final_phase(const Params& p) {
  const int lane = otid() & 63, wave = otid() >> 6;
  for (int tok = blockIdx.x * 4 + wave; tok < TOK; tok += gridDim.x * 4) {
    float* x = p.out + (size_t)tok * DM;
    float4 v[4];
    float ss = 0.f;
#pragma unroll
    for (int i = 0; i < 4; i++) {
      v[i] = *(const float4*)(x + i * 256 + lane * 4);
      ss += v[i].x * v[i].x + v[i].y * v[i].y + v[i].z * v[i].z + v[i].w * v[i].w;
    }
    ss = wave_sum(ss);
    const float rstd = rsqrtf(ss * (1.f / 1024.f) + 1e-6f);
#pragma unroll
    for (int i = 0; i < 4; i++) {
      const float4 g = *(const float4*)(p.final_g + i * 256 + lane * 4);
      *(float4*)(x + i * 256 + lane * 4) = make_float4(v[i].x * rstd * g.x, v[i].y * rstd * g.y, v[i].z * rstd * g.z, v[i].w * rstd * g.w);
    }
  }
}

__global__ void __launch_bounds__(256, 2) mega(Params pk) {
  const Params& p = *(const Params*)__builtin_amdgcn_kernarg_segment_ptr();
  cg::grid_group grid = cg::this_grid();
  __shared__ __attribute__((aligned(16))) char smem[SMEM];
  phase0(p, smem);
  grid.sync();
  GBar gb;
  gbar_init(gb, p.ctr);
#ifndef PROBE_DUP
#define PROBE_DUP 0
#endif
  const bool dryv = PROBE_DUP ? (*(volatile unsigned*)&p.ctr[7] == 0u) : false;
  if (PROBE_DUP & 1) { phase0(p, smem); gbar(gb); }
  for (int l = 0; l < 2; l++) {
    if (l == 1) { norm_phase(p, 1); convert_caches(p, 1); gbar(gb); }
    if (PROBE_DUP & 2) { gemm1_phase(p, l, smem); gbar(gb); }
    gemm1_phase(p, l, smem);
    gbar(gb);
    if (PROBE_DUP & 4) { prep_phase(p, l, smem, dryv); gbar(gb); }
    prep_phase(p, l, smem);
    gbar(gb);
    if (PROBE_DUP & 8) { mixer_phase(p, l, smem, dryv, 2); gbar(gb); }
    mixer_phase(p, l, smem);
    gbar(gb);
    if (PROBE_DUP & 16) { post_phase(p, l); gbar(gb); }
    post_phase(p, l);
    gbar(gb);
    if (PROBE_DUP & 32) { gemm2_phase(p, l, smem, dryv); gbar(gb); }
    gemm2_phase(p, l, smem);
    gbar(gb);
    if (PROBE_DUP & 64) { merge_phase(p, l, smem); gbar(gb); }
    merge_phase(p, l, smem);
    gbar(gb);
    if (PROBE_DUP & 128) { out_phase(p, l, smem, dryv); gbar(gb); }
    out_phase(p, l, smem);
    gbar(gb);
  }
  final_phase(p);
}

extern "C" void kernel_launch(void* const* d_in, const int* in_sizes, int n_in, void* d_out, int out_size, void* d_ws,
                              size_t ws_size, hipStream_t stream) {
  Params p;
  ::memset((void*)&p, 0, sizeof(p));
  const float** f = (const float**)&p;
  for (int i = 0; i < 29; i++) f[i] = (const float*)d_in[i];
  p.out = (float*)d_out;
  char* w = (char*)d_ws;
  size_t off = 0;
  auto take = [&](size_t bytes) { char* r = w + off; off += (bytes + 255) & ~(size_t)255; return r; };
  p.Wt1 = (bf16_t*)take((size_t)2 * N1 * DM * 2);
  p.Wt2 = (bf16_t*)take((size_t)2 * N2 * DM * 2);
  p.Wmem = (bf16_t*)take((size_t)2 * DM * DM * 2);
  p.Wbr = (bf16_t*)take((size_t)2 * 3 * DM * 512 * 2);
  p.Wout = (bf16_t*)take((size_t)2 * DM * DM * 2);
  p.cmvT = (bf16_t*)take((size_t)2 * 32 * 4 * 128 * 256 * 2);
  p.pmvT = (bf16_t*)take((size_t)2 * 2 * 4 * 128 * 256 * 2);
  p.memn = (bf16_t*)take((size_t)2 * 512 * DM * 2);
  p.rope = (float*)take((size_t)8192 * 32 * 2 * 4);
  p.hb = (bf16_t*)take((size_t)TOK * DM * 2);
  p.qa = (bf16_t*)take((size_t)TOK * 512 * 2);
  p.qi = (bf16_t*)take((size_t)TOK * 256 * 2);
  p.qm = (bf16_t*)take((size_t)TOK * 512 * 2);
  p.o_r = (bf16_t*)take((size_t)TOK * 512 * 2);
  p.wi = (float*)take((size_t)TOK * 4 * 4);
  p.R = (float*)take((size_t)TOK * RS * 4);
  p.G = (bf16_t*)p.R;
  p.yscan = (float*)take((size_t)TOK * 512 * 4);
  p.merged = (bf16_t*)p.yscan;
  p.bnd = (float*)take((size_t)(TOK / 16) * DSH * 4);
  p.bonus = (float*)take((size_t)TOK * 8 * 4);
  p.ctr = (unsigned*)take(16384);
  p.KB = (bf16_t*)take((size_t)NROWS * 128 * 2);
  p.VB = (bf16_t*)take((size_t)NROWS * 128 * 2);
  p.KIB = (bf16_t*)take((size_t)NROWS * 64 * 2);
  if (off > ws_size) {
    fprintf(stderr, "workspace too small: need %zu have %zu\n", off, ws_size);
    return;
  }
  static int grid_blocks = 0;
  if (!grid_blocks) {
    int dev = 0, cus = 0, per_cu = 0;
    (void)hipGetDevice(&dev);
    (void)hipDeviceGetAttribute(&cus, hipDeviceAttributeMultiprocessorCount, dev);
    (void)hipOccupancyMaxActiveBlocksPerMultiprocessor(&per_cu, mega, 256, 0);
    if (per_cu > 2) per_cu = 2;
    if (per_cu < 1) per_cu = 1;
    grid_blocks = (cus * per_cu) & ~7;
  }
  (void)hipMemsetAsync(p.ctr, 0, 16384, stream);
  void* args[] = {&p};
  hipError_t e = hipLaunchCooperativeKernel((void*)mega, dim3(grid_blocks), dim3(256), args, 0, stream);
  if (e != hipSuccess) fprintf(stderr, "cooperative launch failed: %s (grid %d)\n", hipGetErrorString(e), grid_blocks);
}
```

```cpp
#include <hip/hip_runtime.h>
#include <hip/hip_cooperative_groups.h>
#include <stdint.h>
#include <stdio.h>
#include <string.h>
namespace cg = cooperative_groups;

#define DI __device__ __forceinline__
#define PROBE_SKIP 2
typedef unsigned short bf16_t;
typedef __attribute__((ext_vector_type(8))) short bf16x8;
typedef __attribute__((ext_vector_type(4))) float f32x4;
typedef __attribute__((ext_vector_type(2))) float f32x2;

constexpr int DM = 1024;
constexpr int TP = 16384;
constexpr int TOK = 18432;
constexpr int DIN = 7876;
constexpr int N1 = 3328;
constexpr int N2 = 4608;
constexpr int RS = 1792;
constexpr int DSH = 1664;
constexpr int SMEM = 73728;
constexpr int SLOT = SMEM - 16;
constexpr int NROWS = 16384 + 32 * 2112;

constexpr size_t O_Y = 0;
constexpr size_t O_KP = 18874368;
constexpr size_t O_VP = O_KP + 4194304;
constexpr size_t O_KIP = O_VP + 4194304;
constexpr size_t O_WKVP = O_KIP + 2097152;
constexpr size_t O_SHP = O_WKVP + 131072;
constexpr size_t O_MKP = O_SHP + 6656;
constexpr size_t O_MVP = O_MKP + 524288;
constexpr size_t O_KS = O_MVP + 524288;
constexpr size_t O_VS = O_KS + 524288;
constexpr size_t O_KIS = O_VS + 524288;
constexpr size_t O_WKVS = O_KIS + 262144;
constexpr size_t O_SHS = O_WKVS + 2097152;

struct Params {
  const float *x_prompt, *x_sample, *mem_prompt, *cache_k, *cache_v, *cache_kidx, *state_wkv, *state_shift,
      *cache_mem_k, *cache_mem_v, *norm_g, *w_in, *mu_shift, *w0, *w2, *a0, *a2, *k_k, *k_a, *r_k, *ln_w, *ln_b,
      *mem_norm_g, *w_mem_kv, *w_br_a, *w_br_r, *w_br_m, *w_out, *final_g;
  float* out;
  bf16_t *Wt1, *Wt2, *Wmem, *Wbr, *Wout, *cmvT, *pmvT, *memn, *hb, *qa, *qi, *qm, *o_r, *merged, *G, *KB, *VB, *KIB;
  float *rope, *wi, *R, *yscan, *bnd, *bonus;
  unsigned* ctr;
};

DI int otid() { int t = __builtin_amdgcn_workitem_id_x(); asm volatile("" : "+v"(t)); return t; }
typedef __bf16 bf16x2_t __attribute__((ext_vector_type(2)));
DI unsigned pack2(float a, float b) {
  const f32x2 v = {a, b};
  const bf16x2_t r = __builtin_convertvector(v, bf16x2_t);
  return __builtin_bit_cast(unsigned, r);
}
DI bf16_t f2bf(float f) { return (bf16_t)(pack2(f, f) & 0xFFFFu); }
DI float bf2f(bf16_t b) { return __uint_as_float(((unsigned)b) << 16); }
DI bf16x8 cvt8(const float* p) {
  float4 x = *(const float4*)p, y = *(const float4*)(p + 4);
  union { bf16x8 v; unsigned u[4]; } r;
  r.u[0] = pack2(x.x, x.y); r.u[1] = pack2(x.z, x.w); r.u[2] = pack2(y.x, y.y); r.u[3] = pack2(y.z, y.w);
  return r.v;
}
template <int CTRL> DI float dpp_add(float x) {
  int y = __builtin_amdgcn_update_dpp(0, __float_as_int(x), CTRL, 0xF, 0xF, false);
  return x + __int_as_float(y);
}
DI float rowsum16(float x) {
  x = dpp_add<0xB1>(x);
  x = dpp_add<0x4E>(x);
  x = dpp_add<0x141>(x);
  x = dpp_add<0x140>(x);
  return x;
}
DI float wave_sum(float v) {
  v = rowsum16(v);
  const float a = __int_as_float(__builtin_amdgcn_readlane(__float_as_int(v), 0));
  const float b = __int_as_float(__builtin_amdgcn_readlane(__float_as_int(v), 16));
  const float c = __int_as_float(__builtin_amdgcn_readlane(__float_as_int(v), 32));
  const float d = __int_as_float(__builtin_amdgcn_readlane(__float_as_int(v), 48));
  return (a + b) + (c + d);
}
typedef __attribute__((address_space(3))) const char* lds_cptr;
typedef short v4i16_t __attribute__((ext_vector_type(4)));
typedef __attribute__((ext_vector_type(4))) short s16x4;
DI s16x4 vtr(lds_cptr p) { return __builtin_bit_cast(s16x4, __builtin_amdgcn_ds_read_tr16_b64_v4i16((__attribute__((address_space(3))) v4i16_t*)p)); }
DI float sigmoidf_(float x) { return __builtin_amdgcn_rcpf(1.f + __expf(-x)); }
DI float siluf_(float x) { return x * __builtin_amdgcn_rcpf(1.f + __expf(-x)); }
DI f32x4 mfma16(bf16x8 a, bf16x8 b, f32x4 c) { return __builtin_amdgcn_mfma_f32_16x16x32_bf16(a, b, c, 0, 0, 0); }

DI const float* xrow_ptr(const Params& p, int l, int tok) {
  if (l == 0) return tok < TP ? p.x_prompt + (size_t)tok * DM : p.x_sample + (size_t)(tok - TP) * DM;
  return p.out + (size_t)tok * DM;
}


DI unsigned xcc_id() { return (unsigned)__builtin_amdgcn_s_getreg((3 << 11) | 20) & 0xFu; }
struct GBar { unsigned* w; unsigned xcc, mycen, nx, k; };
DI void gbar_init(GBar& g, unsigned* w) {
  g.w = w; g.xcc = (unsigned)__builtin_amdgcn_readfirstlane((int)xcc_id()); g.k = 0;
  unsigned nx = 0, mycen = 0;
  for (unsigned x = 0; x < 16; x++) {
    const unsigned c = __hip_atomic_load(&w[64 + 64 * x], __ATOMIC_RELAXED, __HIP_MEMORY_SCOPE_AGENT);
    if (c) nx++;
    if (x == g.xcc) mycen = c;
  }
  g.nx = (unsigned)__builtin_amdgcn_readfirstlane((int)nx);
  g.mycen = (unsigned)__builtin_amdgcn_readfirstlane((int)mycen);
}
DI void gbar(GBar& g) {
  g.k++;
  asm volatile("s_waitcnt vmcnt(0) lgkmcnt(0)" ::: "memory");
  __syncthreads();
  if (otid() == 0) {
    const unsigned a = __hip_atomic_fetch_add(&g.w[1152 + 64 * g.xcc], 1u, __ATOMIC_RELAXED, __HIP_MEMORY_SCOPE_AGENT) + 1u;
    if (a == g.k * g.mycen) {
      __builtin_amdgcn_fence(__ATOMIC_RELEASE, "agent");
      asm volatile("s_waitcnt vmcnt(0)" ::: "memory");
      __hip_atomic_fetch_add(&g.w[2240], 1u, __ATOMIC_RELAXED, __HIP_MEMORY_SCOPE_AGENT);
    }
    while (__hip_atomic_load(&g.w[2240], __ATOMIC_RELAXED, __HIP_MEMORY_SCOPE_AGENT) < g.k * g.nx) __builtin_amdgcn_s_sleep(1);
    __builtin_amdgcn_fence(__ATOMIC_ACQUIRE, "agent");
    asm volatile("s_waitcnt vmcnt(0)" ::: "memory");
  }
  __syncthreads();
}

DI int colmap(int kind, int n) {
  if (kind == 1) {
    if (n < 1092) return n;
    if (n < 1152) return -1;
    if (n < 2816) return 1604 + (n - 1152);
    return 3780 + (n - 2816);
  } else if (kind == 2) {
    if (n < 512) return 1092 + n;
    if (n < 1024) return 3268 + (n - 512);
    if (n < 1536) return 4292 + (n - 1024);
    return 4804 + (n - 1536);
  }
  return n;
}
DI void transpose_tile(const float* __restrict__ src, int ldsrc, int kind, int k0, int n0, bf16_t* __restrict__ dst,
                       int lddst, float* tile) {
  const int tid = otid();
  float v[16];
#pragma unroll
  for (int r = 0; r < 16; r++) {
    const int kk = r * 4 + (tid >> 6), nn = tid & 63;
    const int sc = colmap(kind, n0 + nn);
    v[r] = sc >= 0 ? src[(size_t)(k0 + kk) * ldsrc + sc] : 0.f;
  }
  __syncthreads();
#pragma unroll
  for (int r = 0; r < 16; r++) tile[(r * 4 + (tid >> 6)) * 65 + (tid & 63)] = v[r];
  __syncthreads();
#pragma unroll
  for (int r = 0; r < 8; r++) {
    const int nn = r * 8 + (tid >> 5), kk = (tid & 31) * 2;
    *(unsigned*)(dst + (size_t)(n0 + nn) * lddst + k0 + kk) = pack2(tile[kk * 65 + nn], tile[(kk + 1) * 65 + nn]);
  }
}
DI void norm_row_bf16(const float* __restrict__ x, const float* __restrict__ g, bf16_t* __restrict__ dst) {
  const int lane = otid() & 63;
  float4 v[4];
  float ss = 0.f;
#pragma unroll
  for (int i = 0; i < 4; i++) {
    v[i] = *(const float4*)(x + i * 256 + lane * 4);
    ss += v[i].x * v[i].x + v[i].y * v[i].y + v[i].z * v[i].z + v[i].w * v[i].w;
  }
  ss = wave_sum(ss);
  float rstd = rsqrtf(ss * (1.f / 1024.f) + 1e-6f);
#pragma unroll
  for (int i = 0; i < 4; i++) {
    float4 gg = *(const float4*)(g + i * 256 + lane * 4);
    uint2 o;
    o.x = pack2(v[i].x * rstd * gg.x, v[i].y * rstd * gg.y);
    o.y = pack2(v[i].z * rstd * gg.z, v[i].w * rstd * gg.w);
    *(uint2*)(dst + i * 256 + lane * 4) = o;
  }
}


DI void convert_caches(const Params& p, int l) {
  const int tid = otid();
  const long total = (long)32 * 2048 * 40;
  for (long e = (long)blockIdx.x * 256 + tid; e < total; e += (long)gridDim.x * 256) {
    const int row = (int)(e / 40), c = (int)(e - (long)row * 40);
    const int b = row >> 11, pos = row & 2047;
    const size_t drow = (size_t)16384 + (size_t)b * 2112 + pos;
    const size_t srow = (size_t)(l * 32 + b) * 2048 + pos;
    if (c < 16) *(bf16x8*)(p.KB + drow * 128 + c * 8) = cvt8(p.cache_k + srow * 128 + c * 8);
    else if (c < 32) *(bf16x8*)(p.VB + drow * 128 + (c - 16) * 8) = cvt8(p.cache_v + srow * 128 + (c - 16) * 8);
    else *(bf16x8*)(p.KIB + drow * 64 + (c - 32) * 8) = cvt8(p.cache_kidx + srow * 64 + (c - 32) * 8);
  }
}

DI void transpose_job(const Params& p, int t, float* tile) {
  const int NTW = 2880;
  if (t < 2 * NTW) {
    int l = t / NTW, r = t - l * NTW;
    if (r < 832) {
      int nt = r >> 4, kt = r & 15;
      transpose_tile(p.w_in + (size_t)l * DM * DIN, DIN, 1, kt * 64, nt * 64, p.Wt1 + (size_t)l * N1 * DM, DM, tile);
    } else if (r < 832 + 1152) {
      r -= 832;
      int nt = r >> 4, kt = r & 15;
      transpose_tile(p.w_in + (size_t)l * DM * DIN, DIN, 2, kt * 64, nt * 64, p.Wt2 + (size_t)l * N2 * DM, DM, tile);
    } else if (r < 832 + 1152 + 256) {
      r -= 1984;
      int nt = r >> 4, kt = r & 15;
      transpose_tile(p.w_mem_kv + (size_t)l * DM * DM, DM, 0, kt * 64, nt * 64, p.Wmem + (size_t)l * DM * DM, DM, tile);
    } else if (r < 2240 + 384) {
      r -= 2240;
      int br = r >> 7; r &= 127;
      int nt = r >> 3, kt = r & 7;
      const float* src = (br == 0 ? p.w_br_a : br == 1 ? p.w_br_r : p.w_br_m) + (size_t)l * 512 * DM;
      transpose_tile(src, DM, 0, kt * 64, nt * 64, p.Wbr + (size_t)(l * 3 + br) * DM * 512, 512, tile);
    } else {
      r -= 2624;
      int nt = r >> 4, kt = r & 15;
      transpose_tile(p.w_out + (size_t)l * DM * DM, DM, 0, kt * 64, nt * 64, p.Wout + (size_t)l * DM * DM, DM, tile);
    }
  } else {
    int r = t - 2 * NTW;
    int job = r >> 3, sub = r & 7;
    int lb = job >> 2, h = job & 3;
    int nt = sub >> 2, kt = sub & 3;
    transpose_tile(p.cache_mem_v + (size_t)lb * 256 * 512 + h * 128, 512, 0, kt * 64, nt * 64,
                   p.cmvT + (size_t)(lb * 4 + h) * 128 * 256, 256, tile);
  }
}

DI void phase0(const Params& p, char* smem) {
  const int tid = otid();
  float* tile = (float*)smem;
  if (tid == 0) __hip_atomic_fetch_add(&p.ctr[64 + 64 * xcc_id()], 1u, __ATOMIC_RELAXED, __HIP_MEMORY_SCOPE_AGENT);
  for (int t = blockIdx.x; t < 2 * 2880 + 2048; t += gridDim.x) {
    const bool deferred = (t >= 2880 && t < 5760 && !(t - 2880 >= 1984 && t - 2880 < 2240)) || (t >= 5760 + 1024);
    if (!deferred) transpose_job(p, t, tile);
  }
  convert_caches(p, 0);
  for (int e = blockIdx.x * 256 + tid; e < 8192 * 32; e += gridDim.x * 256) {
    int pos = e >> 5, i = e & 31;
    float inv = powf(10000.f, -(float)(2 * i) / 64.f);
    float ang = (float)pos * inv;
    float s, c;
    sincosf(ang, &s, &c);
    p.rope[2 * e] = c;
    p.rope[2 * e + 1] = s;
  }
  const int wave = tid >> 6;
  for (int r = blockIdx.x * 4 + wave; r < 1024 + TOK; r += gridDim.x * 4) {
    if (r < 1024) {
      int l = r >> 9, row = r & 511;
      norm_row_bf16(p.mem_prompt + (size_t)row * DM, p.mem_norm_g + l * DM, p.memn + (size_t)r * DM);
    } else {
      int tok = r - 1024;
      norm_row_bf16(xrow_ptr(p, 0, tok), p.norm_g, p.hb + (size_t)tok * DM);
    }
  }
}

constexpr int LDT = 72;
constexpr int TILE_E = 128 * LDT;
DI void gemm_kloop(const bf16_t* __restrict__ A, int lda, const bf16_t* __restrict__ B, int ldb, int K, bf16_t* sm,
                   f32x4 (&acc)[4][4]) {
  const int tid = otid(), lane = tid & 63, wave = tid >> 6;
  const int wm = wave >> 1, wn = wave & 1;
  const int lrow = tid >> 3, lkc = (tid & 7) * 8;
  const unsigned toa = (unsigned)(lrow * lda + lkc), tob = (unsigned)(lrow * ldb + lkc);
  uint4 ra0_0, ra0_1, ra0_2, ra0_3, rb0_0, rb0_1, rb0_2, rb0_3, ra1_0, ra1_1, ra1_2, ra1_3, rb1_0, rb1_1, rb1_2, rb1_3;
  const int fr = lane & 15, fk = (lane >> 4) * 8;
  const int nk = K >> 6;
#define GLOAD(RA, RB, K0)                                                   \
  {                                                                         \
    RA##_0 = *(const uint4*)((A + (size_t)(K0)) + toa);                     \
    RA##_1 = *(const uint4*)((A + (size_t)(32 * lda + (K0))) + toa);        \
    RA##_2 = *(const uint4*)((A + (size_t)(64 * lda + (K0))) + toa);        \
    RA##_3 = *(const uint4*)((A + (size_t)(96 * lda + (K0))) + toa);        \
    RB##_0 = *(const uint4*)((B + (size_t)(K0)) + tob);                     \
    RB##_1 = *(const uint4*)((B + (size_t)(32 * ldb + (K0))) + tob);        \
    RB##_2 = *(const uint4*)((B + (size_t)(64 * ldb + (K0))) + tob);        \
    RB##_3 = *(const uint4*)((B + (size_t)(96 * ldb + (K0))) + tob);        \
  }
#define SSTORE(RA, RB, BUF)                                                 \
  {                                                                         \
    bf16_t* sd = sm + (BUF) * (2 * TILE_E) + lrow * LDT + lkc;              \
    *(uint4*)(sd) = RA##_0;                                                 \
    *(uint4*)(sd + 32 * LDT) = RA##_1;                                      \
    *(uint4*)(sd + 64 * LDT) = RA##_2;                                      \
    *(uint4*)(sd + 96 * LDT) = RA##_3;                                      \
    *(uint4*)(sd + TILE_E) = RB##_0;                                        \
    *(uint4*)(sd + TILE_E + 32 * LDT) = RB##_1;                             \
    *(uint4*)(sd + TILE_E + 64 * LDT) = RB##_2;                             \
    *(uint4*)(sd + TILE_E + 96 * LDT) = RB##_3;                             \
  }
#define COMPUTE(BUF)                                                        \
  {                                                                         \
    const bf16_t* sa = sm + (BUF) * (2 * TILE_E) + (wm * 64 + fr) * LDT + fk;           \
    const bf16_t* sb = sm + (BUF) * (2 * TILE_E) + TILE_E + (wn * 64 + fr) * LDT + fk;  \
    _Pragma("unroll") for (int s = 0; s < 2; s++) {                         \
      bf16x8 af[4], bfr[4];                                                 \
      _Pragma("unroll") for (int i = 0; i < 4; i++) {                       \
        af[i] = *(const bf16x8*)(sa + i * 16 * LDT + s * 32);               \
        bfr[i] = *(const bf16x8*)(sb + i * 16 * LDT + s * 32);              \
      }                                                                     \
      _Pragma("unroll") for (int i = 0; i < 4; i++)                         \
        _Pragma("unroll") for (int j = 0; j < 4; j++) acc[i][j] = mfma16(af[i], bfr[j], acc[i][j]);  \
    }                                                                       \
  }
  __syncthreads();
  GLOAD(ra0, rb0, 0)
  GLOAD(ra1, rb1, 64)
  SSTORE(ra0, rb0, 0)
  __syncthreads();
  for (int kt = 0; kt < nk - 2; kt += 2) {
    GLOAD(ra0, rb0, (kt + 2) << 6)
    COMPUTE(0)
    SSTORE(ra1, rb1, 1)
    __syncthreads();
    GLOAD(ra1, rb1, (kt + 3) << 6)
    COMPUTE(1)
    SSTORE(ra0, rb0, 0)
    __syncthreads();
  }
  COMPUTE(0)
  SSTORE(ra1, rb1, 1)
  __syncthreads();
  COMPUTE(1)
  __syncthreads();
#undef GLOAD
#undef SSTORE
#undef COMPUTE
}
DI void zero_acc(f32x4 (&acc)[4][4]) {
#pragma unroll
  for (int i = 0; i < 4; i++)
#pragma unroll
    for (int j = 0; j < 4; j++) acc[i][j] = (f32x4){0.f, 0.f, 0.f, 0.f};
}


DI void gemm_kloop64(const bf16_t* __restrict__ A, int lda, const bf16_t* __restrict__ B, int ldb, int K, bf16_t* sm,
                     f32x4 (&acc)[2][4]) {
  const int tid = otid(), lane = tid & 63, wave = tid >> 6;
  const int lrow = tid >> 3, lkc = (tid & 7) * 8;
  const unsigned toa = (unsigned)(lrow * lda + lkc), tob = (unsigned)(lrow * ldb + lkc);
  uint4 ra0_0, ra0_1, ra0_2, ra0_3, rb0_0, rb0_1, ra1_0, ra1_1, ra1_2, ra1_3, rb1_0, rb1_1;
  const int fr = lane & 15, fk = (lane >> 4) * 8;
  const int nk = K >> 6;
#define GLOAD(RA, RB, K0)                                                   \
  {                                                                         \
    RA##_0 = *(const uint4*)((A + (size_t)(K0)) + toa);                     \
    RA##_1 = *(const uint4*)((A + (size_t)(32 * lda + (K0))) + toa);        \
    RA##_2 = *(const uint4*)((A + (size_t)(64 * lda + (K0))) + toa);        \
    RA##_3 = *(const uint4*)((A + (size_t)(96 * lda + (K0))) + toa);        \
    RB##_0 = *(const uint4*)((B + (size_t)(K0)) + tob);                     \
    RB##_1 = *(const uint4*)((B + (size_t)(32 * ldb + (K0))) + tob);        \
  }
#define SSTORE(RA, RB, BUF)                                                 \
  {                                                                         \
    bf16_t* sd = sm + (BUF) * (2 * TILE_E) + lrow * LDT + lkc;              \
    *(uint4*)(sd) = RA##_0;                                                 \
    *(uint4*)(sd + 32 * LDT) = RA##_1;                                      \
    *(uint4*)(sd + 64 * LDT) = RA##_2;                                      \
    *(uint4*)(sd + 96 * LDT) = RA##_3;                                      \
    *(uint4*)(sd + TILE_E) = RB##_0;                                        \
    *(uint4*)(sd + TILE_E + 32 * LDT) = RB##_1;                             \
  }
#define COMPUTE(BUF)                                                                            \
  {                                                                                             \
    const bf16_t* sa = sm + (BUF) * (2 * TILE_E) + (wave * 32 + fr) * LDT + fk;                 \
    const bf16_t* sb = sm + (BUF) * (2 * TILE_E) + TILE_E + fr * LDT + fk;                      \
    _Pragma("unroll") for (int s = 0; s < 2; s++) {                                             \
      bf16x8 af[2], bfr[4];                                                                     \
      _Pragma("unroll") for (int i = 0; i < 2; i++) af[i] = *(const bf16x8*)(sa + i * 16 * LDT + s * 32);   \
      _Pragma("unroll") for (int j = 0; j < 4; j++) bfr[j] = *(const bf16x8*)(sb + j * 16 * LDT + s * 32);  \
      _Pragma("unroll") for (int i = 0; i < 2; i++)                                             \
        _Pragma("unroll") for (int j = 0; j < 4; j++) acc[i][j] = mfma16(af[i], bfr[j], acc[i][j]);         \
    }                                                                                           \
  }
  __syncthreads();
  GLOAD(ra0, rb0, 0)
  GLOAD(ra1, rb1, 64)
  SSTORE(ra0, rb0, 0)
  __syncthreads();
  for (int kt = 0; kt < nk - 2; kt += 2) {
    GLOAD(ra0, rb0, (kt + 2) << 6)
    COMPUTE(0)
    SSTORE(ra1, rb1, 1)
    __syncthreads();
    GLOAD(ra1, rb1, (kt + 3) << 6)
    COMPUTE(1)
    SSTORE(ra0, rb0, 0)
    __syncthreads();
  }
  COMPUTE(0)
  SSTORE(ra1, rb1, 1)
  __syncthreads();
  COMPUTE(1)
  __syncthreads();
#undef GLOAD
#undef SSTORE
#undef COMPUTE
}

DI bool xcd_tile(int e, int NNT, int& mt, int& nt) {
  const int xcd = blockIdx.x & 7;
  const int per_mb = 9 * NNT;
  if (e >= 2 * per_mb) return false;
  const int mb = e >= per_mb ? 1 : 0;
  int r = e - mb * per_mb;
  const int full = NNT >> 3, rem = NNT & 7;
  int nb = r / 72;
  int w = 8;
  if (nb >= full) { nb = full; w = rem; }
  r -= nb * 72;
  const int mi = r / w, ni = r - mi * w;
  mt = xcd * 18 + mb * 9 + mi;
  nt = nb * 8 + ni;
  return true;
}

struct TokInfo { int isP, b, t, pos; };
DI TokInfo tokinfo(int tok) {
  TokInfo ti;
  if (tok < TP) { ti.isP = 1; ti.b = tok >> 13; ti.t = tok & 8191; ti.pos = ti.t; }
  else { int s = tok - TP; ti.isP = 0; ti.b = s >> 6; ti.t = s & 63; ti.pos = 2048 + ti.t; }
  return ti;
}

DI void gemm1_phase(const Params& p, int l, char* smem) {
  bf16_t* sm = (bf16_t*)smem;
  const int tid = otid(), lane = tid & 63, wave = tid >> 6;
  const int wm = wave >> 1, wn = wave & 1, g4 = lane >> 4, cl = lane & 15;
  const int NT1 = 144 * 26;
  const int slots = gridDim.x >> 3, slot = blockIdx.x >> 3;
  const int nmain = 18 * 26;
  const int nextra = (l == 0 ? 8 : 0);
  for (int e = slot; e < nmain + nextra; e += slots) {
    f32x4 acc[4][4];
    zero_acc(acc);
    int mt = 0, nt = 0;
    const bool is_main = xcd_tile(e, 26, mt, nt);
    const int t = is_main ? 0 : NT1 + (e - nmain) * 8 + (blockIdx.x & 7);
    if (is_main) {
      gemm_kloop(p.hb + (size_t)mt * 128 * DM, DM, p.Wt1 + ((size_t)l * N1 + nt * 128) * DM, DM, DM, sm, acc);
      const int nb = nt * 128 + wn * 64;
#pragma unroll
      for (int i = 0; i < 4; i++) {
        float2 csv[4][2];
        if (nb < 1088 && !(nb >= 640 && nb < 768)) {
#pragma unroll
          for (int r = 0; r < 4; r++) {
            const TokInfo tj = tokinfo(mt * 128 + wm * 64 + i * 16 + g4 * 4 + r);
#pragma unroll
            for (int jn = 0; jn < 2; jn++) csv[r][jn] = *(const float2*)(p.rope + (size_t)(tj.pos * 32 + jn * 16 + cl) * 2);
          }
        }
#pragma unroll
        for (int r = 0; r < 4; r++) {
          const int tok = mt * 128 + wm * 64 + i * 16 + g4 * 4 + r;
          const TokInfo ti = tokinfo(tok);
          if (nb < 1088) {
            if (nb >= 640 && nb < 768) {
              float* dst = ti.isP ? p.out + O_VP + ((size_t)(l * 2 + ti.b) * 8192 + ti.t) * 128
                                  : p.out + O_VS + ((size_t)(l * 32 + ti.b) * 64 + ti.t) * 128;
              bf16_t* dvb = p.VB + (size_t)(ti.isP ? ti.b * 8192 + ti.t : 16384 + ti.b * 2112 + 2048 + ti.t) * 128;
#pragma unroll
              for (int jn = 0; jn < 4; jn++) {
                dst[nb - 640 + jn * 16 + cl] = acc[i][jn][r];
                dvb[nb - 640 + jn * 16 + cl] = f2bf(acc[i][jn][r]);
              }
            } else {
#pragma unroll
              for (int jn = 0; jn < 2; jn++) {
                const int d = jn * 16 + cl;
                const float2 cs = csv[r][jn];
                const float x1 = acc[i][jn][r], x2 = acc[i][jn + 2][r];
                const float y1 = x1 * cs.x - x2 * cs.y, y2 = x1 * cs.y + x2 * cs.x;
                const int c1 = nb + d, c2 = nb + d + 32;
                if (nb < 512) {
                  p.qa[(size_t)tok * 512 + c1] = f2bf(y1 * 0.125f);
                  p.qa[(size_t)tok * 512 + c2] = f2bf(y2 * 0.125f);
                } else if (nb < 640) {
                  float* dst = ti.isP ? p.out + O_KP + ((size_t)(l * 2 + ti.b) * 8192 + ti.t) * 128
                                      : p.out + O_KS + ((size_t)(l * 32 + ti.b) * 64 + ti.t) * 128;
                  dst[c1 - 512] = y1;
                  dst[c2 - 512] = y2;
                  bf16_t* dkb = p.KB + (size_t)(ti.isP ? ti.b * 8192 + ti.t : 16384 + ti.b * 2112 + 2048 + ti.t) * 128;
                  dkb[c1 - 512] = f2bf(y1);
                  dkb[c2 - 512] = f2bf(y2);
                } else if (nb < 1024) {
                  p.qi[(size_t)tok * 256 + c1 - 768] = f2bf(y1 * 0.125f);
                  p.qi[(size_t)tok * 256 + c2 - 768] = f2bf(y2 * 0.125f);
                } else {
                  float* dst = ti.isP ? p.out + O_KIP + ((size_t)(l * 2 + ti.b) * 8192 + ti.t) * 64
                                      : p.out + O_KIS + ((size_t)(l * 32 + ti.b) * 64 + ti.t) * 64;
                  dst[c1 - 1024] = y1;
                  dst[c2 - 1024] = y2;
                  bf16_t* dib = p.KIB + (size_t)(ti.isP ? ti.b * 8192 + ti.t : 16384 + ti.b * 2112 + 2048 + ti.t) * 64;
                  dib[c1 - 1024] = f2bf(y1);
                  dib[c2 - 1024] = f2bf(y2);
                }
              }
            }
          } else if (nb == 1088) {
            if (cl < 4) p.wi[(size_t)tok * 4 + cl] = acc[i][0][r] * 0.5f;
          } else if (nb < 2816) {
            const int T = ti.isP ? 8192 : 64;
#pragma unroll
            for (int jn = 0; jn < 4; jn++) {
              const int c = nb - 1152 + jn * 16 + cl;
              const float v = acc[i][jn][r];
              p.R[(size_t)tok * RS + c] = v;
              if (ti.t == T - 1) {
                float* dst = ti.isP ? p.out + O_SHP + (size_t)(l * 2 + ti.b) * DSH : p.out + O_SHS + (size_t)(l * 32 + ti.b) * DSH;
                dst[c] = v;
              }
              if ((tok & 15) == 15) p.bnd[(size_t)(tok >> 4) * DSH + c] = v;
            }
          } else {
#pragma unroll
            for (int jn = 0; jn < 4; jn++)
              p.qm[(size_t)tok * 512 + nb - 2816 + jn * 16 + cl] = f2bf(acc[i][jn][r] * 0.08838834764831845f);
          }
        }
      }
    } else {
      const int u = t - NT1;
      const int lm = u >> 5, mt = (u >> 3) & 3, nt = u & 7;
      gemm_kloop(p.memn + ((size_t)lm * 512 + mt * 128) * DM, DM, p.Wmem + ((size_t)lm * DM + nt * 128) * DM, DM, DM, sm, acc);
#pragma unroll
      for (int i = 0; i < 4; i++)
#pragma unroll
        for (int r = 0; r < 4; r++) {
          const int row = mt * 128 + wm * 64 + i * 16 + g4 * 4 + r;
          const int bm = row >> 8, m = row & 255;
#pragma unroll
          for (int jn = 0; jn < 4; jn++) {
            const int n = nt * 128 + wn * 64 + jn * 16 + cl;
            const float v = acc[i][jn][r];
            if (n < 512) {
              p.out[O_MKP + ((size_t)(lm * 2 + bm) * 256 + m) * 512 + n] = v;
            } else {
              const int n2 = n - 512;
              p.out[O_MVP + ((size_t)(lm * 2 + bm) * 256 + m) * 512 + n2] = v;
              p.pmvT[((size_t)((lm * 2 + bm) * 4 + (n2 >> 7)) * 128 + (n2 & 127)) * 256 + m] = f2bf(v);
            }
          }
        }
    }
  }
}

DI void prep_phase(const Params& p, int l, char* smem, const bool dry = false) {
  float* rows = (float*)smem;
  float* tw = rows + 9 * DSH;
  float* ta = tw + 512;
  const int tid = otid(), lane = tid & 63, wave = tid >> 6;
  const float* mu = p.mu_shift + l * DSH;
  const float* w2 = p.w2 + (size_t)l * 64 * 512;
  const float* a2 = p.a2 + (size_t)l * 64 * 512;
  for (int task = blockIdx.x; task < TOK / 16; task += gridDim.x) {
    const int tok0 = task * 16;
    const TokInfo t0 = tokinfo(tok0);
    __syncthreads();
    for (int c = tid; c < DSH; c += 256) {
      float pv;
      if (t0.t == 0) pv = t0.isP ? 0.f : p.state_shift[(size_t)(l * 32 + t0.b) * DSH + c];
      else pv = p.bnd[(size_t)(task - 1) * DSH + c];
      rows[c] = pv;
    }
    for (int batch = 0; batch < 2; batch++) {
      const int tb = tok0 + batch * 8;
      __syncthreads();
      for (int f = tid; f < 8 * 416; f += 256) {
        int tk = f / 416, c4 = f - tk * 416;
        *(float4*)(rows + (tk + 1) * DSH + c4 * 4) = *(const float4*)(p.R + (size_t)(tb + tk) * RS + c4 * 4);
      }
      __syncthreads();
      for (int idx = tid; idx < 1024; idx += 256) {
        int tk = idx >> 7, ii = idx & 127;
        int col = 1536 + ii;
        float cur = rows[(tk + 1) * DSH + col], prv = rows[tk * DSH + col];
        float m = cur + (prv - cur) * mu[col];
        if (ii < 64) tw[tk * 64 + ii] = 1.f - 2.f * __builtin_amdgcn_rcpf(1.f + __expf(2.f * m));
        else ta[tk * 64 + ii - 64] = m;
      }
      __syncthreads();
      float accw[2][8], acca[2][8];
#pragma unroll
      for (int ch = 0; ch < 2; ch++) {
        const int c = tid + 256 * ch;
        const float bw = p.w0[l * 512 + c], ba = p.a0[l * 512 + c];
#pragma unroll
        for (int tk = 0; tk < 8; tk++) { accw[ch][tk] = bw; acca[ch][tk] = ba; }
      }
      for (int i4 = 0; i4 < 16; i4++) {
        float4 twv[8], tav[8];
#pragma unroll
        for (int tk = 0; tk < 8; tk++) {
          twv[tk] = *(const float4*)(tw + tk * 64 + i4 * 4);
          tav[tk] = *(const float4*)(ta + tk * 64 + i4 * 4);
        }
#pragma unroll
        for (int ii = 0; ii < 4; ii++) {
          const int i = i4 * 4 + ii;
#pragma unroll
          for (int ch = 0; ch < 2; ch++) {
            const int c = tid + 256 * ch;
            const float wv = w2[i * 512 + c], av = a2[i * 512 + c];
#pragma unroll
            for (int tk = 0; tk < 8; tk++) {
              const float x = ii == 0 ? twv[tk].x : ii == 1 ? twv[tk].y : ii == 2 ? twv[tk].z : twv[tk].w;
              const float y = ii == 0 ? tav[tk].x : ii == 1 ? tav[tk].y : ii == 2 ? tav[tk].z : tav[tk].w;
              accw[ch][tk] += x * wv;
              acca[ch][tk] += y * av;
            }
          }
        }
      }
#pragma unroll
      for (int ch = 0; ch < 2; ch++) {
        const int c = tid + 256 * ch;
        const int head = wave + 4 * ch;
        const float muR = mu[c], muK = mu[512 + c], muV = mu[1024 + c];
        const float kkc = p.k_k[l * 512 + c], kac = p.k_a[l * 512 + c], rkc = p.r_k[l * 512 + c];
#pragma unroll
        for (int tk = 0; tk < 8; tk++) {
          const float* rc = rows + (tk + 1) * DSH;
          const float* rp = rows + tk * DSH;
          const float r = rc[c] + (rp[c] - rc[c]) * muR;
          const float k = rc[512 + c] + (rp[512 + c] - rc[512 + c]) * muK;
          const float v = rc[1024 + c] + (rp[1024 + c] - rc[1024 + c]) * muV;
          const float xw = -accw[ch][tk];
          const float sp = fmaxf(xw, 0.f) + __logf(1.f + __expf(-fabsf(xw)));
          const float w = -sp - 0.5f;
          const float decay = __expf(-__expf(w));
          const float ag = __builtin_amdgcn_rcpf(1.f + __expf(-acca[ch][tk]));
          const float kkr = k * kkc;
          const float ss = wave_sum(kkr * kkr);
          const float kk = kkr * fminf(__builtin_amdgcn_rsqf(ss), 1e12f);
          const float kp = k * (1.f + (ag - 1.f) * kac);
          const float bon = wave_sum(r * kp * rkc);
          float* Rrow = p.R + (size_t)(tb + tk) * RS;
          bf16_t* Rb = (bf16_t*)(Rrow + 512);
          if (!dry) {
            Rrow[c] = decay;
            Rb[c] = f2bf(r);
            Rb[512 + c] = f2bf(kp);
            Rb[1024 + c] = f2bf(v);
            Rb[1536 + c] = f2bf(-kk);
            Rb[2048 + c] = f2bf(kk * ag);
            if (lane == 0) p.bonus[(size_t)(tb + tk) * 8 + head] = bon;
          } else if (decay + r + kp + v + kk + bon == 1.2345e30f) p.wi[0] = 1.f;
        }
      }
      __syncthreads();
      for (int c = tid; c < DSH; c += 256) rows[c] = rows[8 * DSH + c];
    }
  }
}

DI void scan_task(const Params& p, int l, int isP, int b, int h, int rg, char* smem, const bool dry) {
  constexpr int BUFB = 24576 + 8192 + 2048;
  const int tid = otid(), lane = tid & 63, wave = tid >> 6;
  const int g4 = lane >> 4, jq = lane & 15;
  const int T = isP ? 8192 : 64;
  const int tokbase = isP ? b * 8192 : TP + b * 64;
  const int i = rg * 16 + wave * 4 + g4;
  f32x2 Sa = {0.f, 0.f}, Sb = {0.f, 0.f};
  if (!isP) {
    const float4 s = *(const float4*)(p.state_wkv + ((size_t)((l * 32 + b) * 8 + h) * 64 + i) * 64 + jq * 4);
    Sa = (f32x2){s.x, s.y}; Sb = (f32x2){s.z, s.w};
  }
  __builtin_amdgcn_s_setprio(3);
  const int ds = tid >> 4, dj = tid & 15;
  const int lst = (tid >> 3) & 31, lch = tid & 7;
  float4 rd0, rd1;
  uint4 qr, qk, qa, qb, rv;
  const int nch = T >> 5;
  auto gload = [&](int c) {
    const int tk = tokbase + c * 32;
    rd0 = *(const float4*)(p.R + (size_t)(tk + ds) * RS + h * 64 + dj * 4);
    rd1 = *(const float4*)(p.R + (size_t)(tk + 16 + ds) * RS + h * 64 + dj * 4);
    const bf16_t* rb = (const bf16_t*)(p.R + (size_t)(tk + lst) * RS + 512) + h * 64 + lch * 8;
    qr = *(const uint4*)(rb);
    qk = *(const uint4*)(rb + 512);
    qa = *(const uint4*)(rb + 1536);
    qb = *(const uint4*)(rb + 2048);
    if (tid < 64) {
      const int s = tid >> 1, half = tid & 1;
      rv = *(const uint4*)((const bf16_t*)(p.R + (size_t)(tk + s) * RS + 512) + 1024 + h * 64 + rg * 16 + half * 8);
    }
  };
#define CVT8(Q, LO, HI)                                                                            \
  float4 LO, HI;                                                                                   \
  LO.x = __uint_as_float((Q).x << 16); LO.y = __uint_as_float((Q).x & 0xFFFF0000u);                \
  LO.z = __uint_as_float((Q).y << 16); LO.w = __uint_as_float((Q).y & 0xFFFF0000u);                \
  HI.x = __uint_as_float((Q).z << 16); HI.y = __uint_as_float((Q).z & 0xFFFF0000u);                \
  HI.z = __uint_as_float((Q).w << 16); HI.w = __uint_as_float((Q).w & 0xFFFF0000u);
  auto sstore = [&](int bi) {
    char* bb = smem + bi * BUFB;
    *(float4*)(bb + (ds * 64 + dj * 4) * 4) = rd0;
    *(float4*)(bb + ((16 + ds) * 64 + dj * 4) * 4) = rd1;
    {
      CVT8(qa, alo, ahi)
      float* d = (float*)(bb + 8192) + lst * 64 + lch * 8;
      *(float4*)d = alo; *(float4*)(d + 4) = ahi;
    }
    {
      CVT8(qb, blo, bhi)
      float* d = (float*)(bb + 16384) + lst * 64 + lch * 8;
      *(float4*)d = blo; *(float4*)(d + 4) = bhi;
    }
    *(uint4*)(bb + 24576 + (lst * 64 + lch * 8) * 2) = qr;
    *(uint4*)(bb + 28672 + (lst * 64 + lch * 8) * 2) = qk;
    if (tid < 64) {
      const int s = tid >> 1, half = tid & 1;
      CVT8(rv, vlo, vhi)
      float* d = (float*)(bb + 32768) + s * 16 + half * 8;
      *(float4*)d = vlo; *(float4*)(d + 4) = vhi;
    }
  };
#undef CVT8
  __syncthreads();
  gload(0);
  sstore(0);
  __syncthreads();
  for (int c = 0; c < nch; c++) {
    const bool more = c + 1 < nch;
    if (more) gload(c + 1);
    const char* bb = smem + (c & 1) * BUFB;
    const float* fw = (const float*)bb + jq * 4;
    const float* fa = (const float*)(bb + 8192) + jq * 4;
    const float* fb = (const float*)(bb + 16384) + jq * 4;
    const char* pr = bb + 24576 + jq * 8;
    const char* pk = bb + 28672 + jq * 8;
    const float* vb = (const float*)(bb + 32768) + wave * 4 + g4;
    float* yo = p.yscan + (size_t)(tokbase + c * 32 + jq) * 512 + h * 64 + i;
    float ykeep0 = 0.f, ykeep1 = 0.f;
    f32x4 w4 = *(const f32x4*)fw, a4 = *(const f32x4*)fa, b4 = *(const f32x4*)fb;
    uint2 ur = *(const uint2*)pr, uk = *(const uint2*)pk;
    float v = vb[0];
#pragma unroll
    for (int s = 0; s < 32; s++) {
      f32x4 w4n = w4, a4n = a4, b4n = b4;
      uint2 urn = ur, ukn = uk;
      float vn = v;
      if (s < 31) {
        w4n = *(const f32x4*)(fw + (s + 1) * 64);
        a4n = *(const f32x4*)(fa + (s + 1) * 64);
        b4n = *(const f32x4*)(fb + (s + 1) * 64);
        urn = *(const uint2*)(pr + (s + 1) * 128);
        ukn = *(const uint2*)(pk + (s + 1) * 128);
        vn = vb[(s + 1) * 16];
      }
      __builtin_amdgcn_sched_barrier(0);
      const f32x2 klo = {__uint_as_float(uk.x << 16), __uint_as_float(uk.x & 0xFFFF0000u)};
      const f32x2 khi = {__uint_as_float(uk.y << 16), __uint_as_float(uk.y & 0xFFFF0000u)};
      const f32x2 rlo = {__uint_as_float(ur.x << 16), __uint_as_float(ur.x & 0xFFFF0000u)};
      const f32x2 rhi = {__uint_as_float(ur.y << 16), __uint_as_float(ur.y & 0xFFFF0000u)};
      const f32x2 vv = {v, v};
      const f32x2 t = Sa * a4.lo + Sb * a4.hi;
      const f32x2 na = Sa * w4.lo + vv * klo;
      const f32x2 nb = Sb * w4.hi + vv * khi;
      const float sa = rowsum16(t.x + t.y);
      const f32x2 sv = {sa, sa};
      Sa = na + sv * b4.lo;
      Sb = nb + sv * b4.hi;
      const f32x2 yy = Sa * rlo + Sb * rhi;
      const float y = rowsum16(yy.x + yy.y);
      if (s < 16) ykeep0 = (jq == s) ? y : ykeep0;
      else ykeep1 = (jq == s - 16) ? y : ykeep1;
      w4 = w4n; a4 = a4n; b4 = b4n; ur = urn; uk = ukn; v = vn;
    }
    if (!dry) { yo[0] = ykeep0; yo[(size_t)16 * 512] = ykeep1; }
    if (more) sstore((c + 1) & 1);
    __syncthreads();
  }
  float* so = isP ? p.out + O_WKVP + ((size_t)((l * 2 + b) * 8 + h) * 64 + i) * 64 + jq * 4
                  : p.out + O_WKVS + ((size_t)((l * 32 + b) * 8 + h) * 64 + i) * 64 + jq * 4;
  if (!dry) *(float4*)so = make_float4(Sa.x, Sa.y, Sb.x, Sb.y);
  __builtin_amdgcn_s_setprio(0);
}

DI void mem_task(const Params& p, int l, int tok0, char* smem, const bool dry) {
  bf16_t* st = (bf16_t*)smem;
  const int tid = otid(), lane = tid & 63, wave = tid >> 6;
  const int g4 = lane >> 4, cl = lane & 15;
  const TokInfo ti = tokinfo(tok0);
  const float* Kb = ti.isP ? p.out + O_MKP + (size_t)(l * 2 + ti.b) * 256 * 512
                           : p.cache_mem_k + (size_t)(l * 32 + ti.b) * 256 * 512;
  const bf16_t* Vb = ti.isP ? p.pmvT + (size_t)(l * 2 + ti.b) * 4 * 128 * 256
                            : p.cmvT + (size_t)(l * 32 + ti.b) * 4 * 128 * 256;
  const int q0 = tok0 + wave * 16;
  for (int h = 0; h < 4; h++) {
    bf16x8 qf[4];
#pragma unroll
    for (int ks = 0; ks < 4; ks++) qf[ks] = *(const bf16x8*)(p.qm + (size_t)(q0 + cl) * 512 + h * 128 + ks * 32 + g4 * 8);
    __syncthreads();
    {
      const float* kp = Kb + (size_t)(tid >> 5) * 512 + h * 128 + (tid & 31) * 4;
      bf16_t* sp = st + (tid >> 5) * 136 + (tid & 31) * 4;
#pragma unroll 1
      for (int hb2 = 0; hb2 < 4; hb2++) {
        float4 kv[8];
#pragma unroll
        for (int u = 0; u < 8; u++) kv[u] = *(const float4*)(kp + (size_t)u * 8 * 512);
#pragma unroll
        for (int u = 0; u < 8; u++) {
          uint2 w;
          w.x = pack2(kv[u].x, kv[u].y);
          w.y = pack2(kv[u].z, kv[u].w);
          *(uint2*)(sp + u * 8 * 136) = w;
        }
        kp += 64 * 512;
        sp += 64 * 136;
      }
    }
    __syncthreads();
    f32x4 S[16];
#pragma unroll
    for (int mt = 0; mt < 16; mt++) {
      f32x4 a = (f32x4){0.f, 0.f, 0.f, 0.f};
      const bf16_t* kr = st + (mt * 16 + cl) * 136 + g4 * 8;
#pragma unroll
      for (int ks = 0; ks < 4; ks++) a = mfma16(*(const bf16x8*)(kr + ks * 32), qf[ks], a);
      S[mt] = a;
      if ((mt & 1) == 1) __builtin_amdgcn_sched_barrier(0);
    }
    float m = -1e30f;
#pragma unroll
    for (int mt = 0; mt < 16; mt++)
#pragma unroll
      for (int r = 0; r < 4; r++) m = fmaxf(m, S[mt][r]);
    m = fmaxf(m, __shfl_xor(m, 16));
    m = fmaxf(m, __shfl_xor(m, 32));
    float sum = 0.f;
#pragma unroll
    for (int mt = 0; mt < 16; mt++)
#pragma unroll
      for (int r = 0; r < 4; r++) {
        const float e = __expf(S[mt][r] - m);
        S[mt][r] = e;
        sum += e;
      }
    sum += __shfl_xor(sum, 16);
    sum += __shfl_xor(sum, 32);
    const float inv = __builtin_amdgcn_rcpf(sum);
    __syncthreads();
    {
      const bf16_t* vp = Vb + (size_t)h * 128 * 256 + (size_t)(tid >> 5) * 256 + (tid & 31) * 8;
      bf16_t* sp = st + (tid >> 5) * 264 + (tid & 31) * 8;
#pragma unroll 1
      for (int hb2 = 0; hb2 < 2; hb2++) {
        uint4 vv[8];
#pragma unroll
        for (int u = 0; u < 8; u++) vv[u] = *(const uint4*)(vp + (size_t)u * 8 * 256);
#pragma unroll
        for (int u = 0; u < 8; u++) *(uint4*)(sp + u * 8 * 264) = vv[u];
        vp += 64 * 256;
        sp += 64 * 264;
      }
    }
    __syncthreads();
    f32x4 o[8];
#pragma unroll
    for (int dt = 0; dt < 8; dt++) o[dt] = (f32x4){0.f, 0.f, 0.f, 0.f};
#pragma unroll
    for (int kk = 0; kk < 8; kk++) {
      union { bf16x8 v; unsigned u[4]; } pf;
      pf.u[0] = pack2(S[2 * kk][0], S[2 * kk][1]);
      pf.u[1] = pack2(S[2 * kk][2], S[2 * kk][3]);
      pf.u[2] = pack2(S[2 * kk + 1][0], S[2 * kk + 1][1]);
      pf.u[3] = pack2(S[2 * kk + 1][2], S[2 * kk + 1][3]);
#pragma unroll
      for (int dt = 0; dt < 8; dt++) {
        const bf16_t* vr = st + (dt * 16 + cl) * 264 + (2 * kk) * 16 + g4 * 4;
        union { bf16x8 v; uint2 u[2]; } vf;
        vf.u[0] = *(const uint2*)vr;
        vf.u[1] = *(const uint2*)(vr + 16);
        o[dt] = mfma16(vf.v, pf.v, o[dt]);
      }
      __builtin_amdgcn_sched_barrier(0);
    }
#pragma unroll
    for (int dt = 0; dt < 8; dt++) {
      uint2 stv;
      stv.x = pack2(o[dt][0] * inv, o[dt][1] * inv);
      stv.y = pack2(o[dt][2] * inv, o[dt][3] * inv);
      if (!dry) *(uint2*)(p.qm + (size_t)(q0 + cl) * 512 + h * 128 + dt * 16 + g4 * 4) = stv;
    }
  }
}

DI unsigned mono_key(float f) {
  const int u = __float_as_int(f + 0.0f);
  return (unsigned)u ^ ((unsigned)(u >> 31) | 0x80000000u);
}
DI float relu_(float x) { return __builtin_amdgcn_fmed3f(x, 0.f, __builtin_inff()); }

DI void dsa_task(const Params& p, int l, int isP, int b, int tq, char* smem, const bool dry) {
  unsigned* hist = (unsigned*)smem;
  unsigned short* idxl = (unsigned short*)(smem + 16384);
  unsigned short* tiel = (unsigned short*)smem;
  bf16_t* kst = (bf16_t*)(smem + 24576);
  float* pl = (float*)(smem + 24576);
  float* op = (float*)(smem + 32768);
  float* ml = (float*)(smem + 40960);
  unsigned* cnt = (unsigned*)(smem + 61440);
  unsigned* res = (unsigned*)(smem + 61504);
  unsigned* ccnt = (unsigned*)(smem + 61632);
  unsigned* ovf = (unsigned*)(smem + 61696);
  unsigned* ckey = (unsigned*)(smem + 61952);
  unsigned* cidx = (unsigned*)(smem + 66048);
  const int tid = otid(), lane = tid & 63, wave = tid >> 6;
  const int g4 = lane >> 4, cl = lane & 15;
  const int tokq0 = (isP ? b * 8192 : TP + b * 64) + tq;
  const int S = isP ? ((tq >> 6) + 1) * 64 : 2112;
  const size_t seqbase = isP ? (size_t)b * 8192 : (size_t)16384 + (size_t)b * 2112;
  const bf16_t* KIs = p.KIB + seqbase * 64;
  const bf16_t* Ks = p.KB + seqbase * 128;
  const bf16_t* Vs = p.VB + seqbase * 128;
  const int nsel = S < 256 ? S : 256;
  __syncthreads();
  if (S <= 256) {
    for (int e = tid; e < 16 * 256; e += 256) idxl[e] = (unsigned short)(e & 255);
  } else {
    const int qloc = wave * 4 + g4;
    bf16x8 aq0, aq1;
    {
      const bf16_t* qp = p.qi + ((size_t)(tokq0 + wave * 4) * 4 + cl) * 64 + g4 * 8;
      aq0 = *(const bf16x8*)qp;
      aq1 = *(const bf16x8*)(qp + 32);
    }
    const float4 wq = *(const float4*)(p.wi + (size_t)(tokq0 + qloc) * 4);
    unsigned prefix = 0u, need = 256u;
    const int nchunks = (S + 255) >> 8;
    const int skey = tid >> 3, sc8 = (tid & 7) * 8;
    for (int pass = 0; pass < 6; pass++) {
      const int kind = (pass == 2) ? 1 : (pass == 5) ? 2 : 0;
      const int shift = pass == 0 ? 24 : pass == 1 ? 16 : pass == 3 ? 8 : 0;
      if (kind == 0) {
        for (int e = tid; e < 1024; e += 256) ((uint4*)hist)[e] = make_uint4(0, 0, 0, 0);
      } else {
        if (tid < 16) { cnt[tid] = 0u; ccnt[tid] = 0u; }
        if (tid == 16) *ovf = 0u;
      }
      unsigned tiecnt = 0u;
      const unsigned G = 256u - need;
      uint4 rg0, rg1, rg2, rg3, rg4, rg5, rg6, rg7;
#define KLOAD(KC)                                                                            \
  {                                                                                          \
    const bf16_t* src = KIs + (size_t)((KC) * 256 + skey) * 64 + sc8;                        \
    const int kb0 = (KC) * 256 + skey;                                                       \
    if (kb0 < S) rg0 = *(const uint4*)(src);                                                 \
    if (kb0 + 32 < S) rg1 = *(const uint4*)(src + 32 * 64);                                  \
    if (kb0 + 64 < S) rg2 = *(const uint4*)(src + 64 * 64);                                  \
    if (kb0 + 96 < S) rg3 = *(const uint4*)(src + 96 * 64);                                  \
    if (kb0 + 128 < S) rg4 = *(const uint4*)(src + 128 * 64);                                \
    if (kb0 + 160 < S) rg5 = *(const uint4*)(src + 160 * 64);                                \
    if (kb0 + 192 < S) rg6 = *(const uint4*)(src + 192 * 64);                                \
    if (kb0 + 224 < S) rg7 = *(const uint4*)(src + 224 * 64);                                \
  }
      rg0 = rg1 = rg2 = rg3 = rg4 = rg5 = rg6 = rg7 = make_uint4(0, 0, 0, 0);
      KLOAD(0)
      for (int kc = 0; kc < nchunks; kc++) {
        __syncthreads();
        {
          bf16_t* d = kst + skey * 72 + sc8;
          *(uint4*)(d) = rg0;
          *(uint4*)(d + 32 * 72) = rg1;
          *(uint4*)(d + 64 * 72) = rg2;
          *(uint4*)(d + 96 * 72) = rg3;
          *(uint4*)(d + 128 * 72) = rg4;
          *(uint4*)(d + 160 * 72) = rg5;
          *(uint4*)(d + 192 * 72) = rg6;
          *(uint4*)(d + 224 * 72) = rg7;
        }
        __syncthreads();
        if (kc + 1 < nchunks) KLOAD(kc + 1)
        const int ngrp = (S - kc * 256) >= 256 ? 4 : ((S - kc * 256) >> 6);
        for (int tg = 0; tg < ngrp; tg++) {
          unsigned keys[4];
#pragma unroll
          for (int tt = 0; tt < 4; tt++) {
            const bf16_t* br = kst + ((tg * 4 + tt) * 16 + cl) * 72 + g4 * 8;
            const bf16x8 b0 = *(const bf16x8*)br;
            const bf16x8 b1 = *(const bf16x8*)(br + 32);
            f32x4 a = (f32x4){0.f, 0.f, 0.f, 0.f};
            a = mfma16(aq0, b0, a);
            a = mfma16(aq1, b1, a);
            const float score = wq.x * relu_(a[0]) + wq.y * relu_(a[1]) + wq.z * relu_(a[2]) + wq.w * relu_(a[3]);
            keys[tt] = mono_key(score);
          }
#pragma unroll
          for (int tt = 0; tt < 4; tt++) {
            const unsigned key = keys[tt];
            const int kidx = kc * 256 + (tg * 4 + tt) * 16 + cl;
            if (kind == 0) {
              const bool match = (pass == 0) || ((key >> (shift + 8)) == prefix);
              if (match) atomicAdd(&hist[qloc * 256 + ((key >> shift) & 255u)], 1u);
            } else if (kind == 1) {
              const unsigned hk = key >> 16;
              const bool tz = (hk == prefix) && ((key & 0xFFFFu) == 0u);
              if (hk > prefix) {
                const unsigned slot = atomicAdd(&cnt[qloc], 1u);
                if (slot < 256u) idxl[qloc * 256 + slot] = (unsigned short)kidx;
              } else if (hk == prefix && !tz) {
                const unsigned c = atomicAdd(&ccnt[qloc], 1u);
                if (c < 64u) { ckey[qloc * 64 + c] = key; cidx[qloc * 64 + c] = (unsigned)kidx; }
              }
              const unsigned long long bm = __ballot(tz);
              if (bm != 0ull) {
                const unsigned mg = (unsigned)(bm >> (g4 * 16)) & 0xFFFFu;
                const unsigned rank = tiecnt + __popc(mg & ((1u << cl) - 1u));
                if (tz && rank < need) tiel[qloc * 256 + rank] = (unsigned short)kidx;
                tiecnt += __popc(mg);
              }
            } else {
              if (key > prefix) {
                const unsigned slot = atomicAdd(&cnt[qloc], 1u);
                if (slot < 256u) idxl[qloc * 256 + slot] = (unsigned short)kidx;
              }
              const bool eq = (key == prefix);
              const unsigned long long bm = __ballot(eq);
              if (bm != 0ull) {
                const unsigned mg = (unsigned)(bm >> (g4 * 16)) & 0xFFFFu;
                const unsigned rank = tiecnt + __popc(mg & ((1u << cl) - 1u));
                if (eq && rank < need) idxl[qloc * 256 + G + rank] = (unsigned short)kidx;
                tiecnt += __popc(mg);
              }
            }
          }
        }
      }
#undef KLOAD
      __syncthreads();
      if (kind == 0) {
        const unsigned* hq = hist + qloc * 256;
        const int top = 255 - 16 * cl;
        unsigned sum = 0u;
#pragma unroll
        for (int u = 0; u < 16; u++) sum += hq[top - u];
        unsigned incl = sum;
#pragma unroll
        for (int d = 1; d < 16; d <<= 1) {
          const unsigned t = __shfl_up(incl, d, 16);
          if (cl >= d) incl += t;
        }
        const unsigned excl = incl - sum;
        if (excl < need && incl >= need) {
          unsigned cum = excl;
          int bsel = top - 15;
          unsigned above = excl;
          bool found = false;
#pragma unroll
          for (int u = 0; u < 16; u++) {
            const unsigned c = hq[top - u];
            if (!found && cum + c >= need) { bsel = top - u; above = cum; found = true; }
            cum += c;
          }
          res[qloc * 2] = (unsigned)bsel;
          res[qloc * 2 + 1] = above;
        }
        __syncthreads();
        const unsigned bstar = res[qloc * 2], above = res[qloc * 2 + 1];
        need -= above;
        prefix = (prefix << 8) | bstar;
      } else if (kind == 1) {
        const unsigned c = ccnt[qloc];
        if (c > 64u) {
          if (cl == 0) *ovf = 1u;
        } else {
          for (unsigned i = cl; i < c; i += 16) {
            const unsigned ki = ckey[qloc * 64 + i], ii = cidx[qloc * 64 + i];
            unsigned rank = 0u;
            for (unsigned j = 0; j < c; j++) {
              const unsigned kj = ckey[qloc * 64 + j], ij = cidx[qloc * 64 + j];
              rank += (kj > ki || (kj == ki && ij < ii)) ? 1u : 0u;
            }
            if (rank < need) idxl[qloc * 256 + G + rank] = (unsigned short)ii;
          }
          const unsigned nso = c < need ? c : need;
          for (unsigned t = cl; t < need - nso; t += 16) idxl[qloc * 256 + G + nso + t] = tiel[qloc * 256 + t];
        }
        __syncthreads();
        if (*ovf == 0u) break;
      }
    }
  }
  __syncthreads();
  float* opq = (float*)smem;
  float* mlq = (float*)(smem + 61952);
  char* vst = smem + 24576 + wave * 9216;
  const bool active = wave * 64 < nsel;
  uint4 vq0, vq1, vq2, vq3, vq4, vq5, vq6, vq7, vq8, vq9, vq10, vq11, vq12, vq13, vq14, vq15;
  bf16x8 kf[2][4][2];
  if (active) {
    vq0 = *(const uint4*)(Vs + (size_t)idxl[wave * 64 + 0 + g4] * 128 + cl * 8);
    vq1 = *(const uint4*)(Vs + (size_t)idxl[wave * 64 + 4 + g4] * 128 + cl * 8);
    vq2 = *(const uint4*)(Vs + (size_t)idxl[wave * 64 + 8 + g4] * 128 + cl * 8);
    vq3 = *(const uint4*)(Vs + (size_t)idxl[wave * 64 + 12 + g4] * 128 + cl * 8);
    vq4 = *(const uint4*)(Vs + (size_t)idxl[wave * 64 + 16 + g4] * 128 + cl * 8);
    vq5 = *(const uint4*)(Vs + (size_t)idxl[wave * 64 + 20 + g4] * 128 + cl * 8);
    vq6 = *(const uint4*)(Vs + (size_t)idxl[wave * 64 + 24 + g4] * 128 + cl * 8);
    vq7 = *(const uint4*)(Vs + (size_t)idxl[wave * 64 + 28 + g4] * 128 + cl * 8);
    vq8 = *(const uint4*)(Vs + (size_t)idxl[wave * 64 + 32 + g4] * 128 + cl * 8);
    vq9 = *(const uint4*)(Vs + (size_t)idxl[wave * 64 + 36 + g4] * 128 + cl * 8);
    vq10 = *(const uint4*)(Vs + (size_t)idxl[wave * 64 + 40 + g4] * 128 + cl * 8);
    vq11 = *(const uint4*)(Vs + (size_t)idxl[wave * 64 + 44 + g4] * 128 + cl * 8);
    vq12 = *(const uint4*)(Vs + (size_t)idxl[wave * 64 + 48 + g4] * 128 + cl * 8);
    vq13 = *(const uint4*)(Vs + (size_t)idxl[wave * 64 + 52 + g4] * 128 + cl * 8);
    vq14 = *(const uint4*)(Vs + (size_t)idxl[wave * 64 + 56 + g4] * 128 + cl * 8);
    vq15 = *(const uint4*)(Vs + (size_t)idxl[wave * 64 + 60 + g4] * 128 + cl * 8);
#pragma unroll
    for (int tt = 0; tt < 4; tt++) {
      const int pos = idxl[wave * 64 + tt * 16 + cl];
#pragma unroll
      for (int j = 0; j < 2; j++) {
        const bf16_t* kr = Ks + (size_t)pos * 128 + j * 64 + g4 * 8;
        kf[j][tt][0] = *(const bf16x8*)kr;
        kf[j][tt][1] = *(const bf16x8*)(kr + 32);
      }
    }
  }
  for (int qq = 0; qq < 16; qq++) {
    const int tok = tokq0 + qq;
    const int qn = qq < 15 ? qq + 1 : 15;
    float* opb = opq + (qq & 1) * 2048;
    float* mlb = mlq + (qq & 1) * 64;
    if (active) {
      union PB { bf16x8 v; unsigned u[4]; };
      PB pb[2][2];
#pragma unroll
      for (int j = 0; j < 2; j++) {
        const bf16_t* qp = p.qa + (size_t)tok * 512 + (j * 4 + (cl & 3)) * 64 + g4 * 8;
        const bf16x8 bq0 = *(const bf16x8*)qp;
        const bf16x8 bq1 = *(const bf16x8*)(qp + 32);
        f32x4 lg[4];
#pragma unroll
        for (int tt = 0; tt < 4; tt++) {
          f32x4 a = (f32x4){0.f, 0.f, 0.f, 0.f};
          a = mfma16(kf[j][tt][0], bq0, a);
          a = mfma16(kf[j][tt][1], bq1, a);
          lg[tt] = a;
        }
        float m = -1e30f;
#pragma unroll
        for (int tt = 0; tt < 4; tt++)
#pragma unroll
          for (int r = 0; r < 4; r++) m = fmaxf(m, lg[tt][r]);
        m = fmaxf(m, __shfl_xor(m, 16));
        m = fmaxf(m, __shfl_xor(m, 32));
        float sum = 0.f;
#pragma unroll
        for (int tt = 0; tt < 4; tt++)
#pragma unroll
          for (int r = 0; r < 4; r++) {
            const float e = __expf(lg[tt][r] - m);
            lg[tt][r] = e;
            sum += e;
          }
        sum += __shfl_xor(sum, 16);
        sum += __shfl_xor(sum, 32);
#pragma unroll
        for (int sI = 0; sI < 2; sI++) {
          pb[j][sI].u[0] = pack2(lg[2 * sI][0], lg[2 * sI][1]);
          pb[j][sI].u[1] = pack2(lg[2 * sI][2], lg[2 * sI][3]);
          pb[j][sI].u[2] = pack2(lg[2 * sI + 1][0], lg[2 * sI + 1][1]);
          pb[j][sI].u[3] = pack2(lg[2 * sI + 1][2], lg[2 * sI + 1][3]);
        }
        if (cl < 4 && g4 == 0) {
          mlb[(wave * 8 + j * 4 + cl) * 2] = m;
          mlb[(wave * 8 + j * 4 + cl) * 2 + 1] = sum;
        }
      }
#pragma unroll
      for (int tt = 0; tt < 4; tt++) {
        const int pos = idxl[qn * 256 + wave * 64 + tt * 16 + cl];
#pragma unroll
        for (int j = 0; j < 2; j++) {
          const bf16_t* kr = Ks + (size_t)pos * 128 + j * 64 + g4 * 8;
          kf[j][tt][0] = *(const bf16x8*)kr;
          kf[j][tt][1] = *(const bf16x8*)(kr + 32);
        }
      }
      f32x4 o[2][4];
#pragma unroll
      for (int j = 0; j < 2; j++)
#pragma unroll
        for (int dt = 0; dt < 4; dt++) o[j][dt] = (f32x4){0.f, 0.f, 0.f, 0.f};
      const lds_cptr vb = (lds_cptr)(vst + (g4 * 4 + (cl >> 2)) * 288 + (cl & 3) * 8);
      {
        *(uint4*)(vst + (0 + g4) * 288 + cl * 16) = vq0;
        *(uint4*)(vst + (4 + g4) * 288 + cl * 16) = vq1;
        *(uint4*)(vst + (8 + g4) * 288 + cl * 16) = vq2;
        *(uint4*)(vst + (12 + g4) * 288 + cl * 16) = vq3;
        *(uint4*)(vst + (16 + g4) * 288 + cl * 16) = vq4;
        *(uint4*)(vst + (20 + g4) * 288 + cl * 16) = vq5;
        *(uint4*)(vst + (24 + g4) * 288 + cl * 16) = vq6;
        *(uint4*)(vst + (28 + g4) * 288 + cl * 16) = vq7;
        __builtin_amdgcn_wave_barrier();
#pragma unroll
        for (int j = 0; j < 2; j++)
#pragma unroll
          for (int dt = 0; dt < 4; dt++) {
            const s16x4 alo = vtr(vb + (j * 64 + dt * 16) * 2);
            const s16x4 ahi = vtr(vb + (j * 64 + dt * 16) * 2 + 16 * 288);
            const bf16x8 af = __builtin_shufflevector(alo, ahi, 0, 1, 2, 3, 4, 5, 6, 7);
            o[j][dt] = mfma16(af, pb[j][0].v, o[j][dt]);
          }
        __builtin_amdgcn_wave_barrier();
      }
      {
        *(uint4*)(vst + (0 + g4) * 288 + cl * 16) = vq8;
        *(uint4*)(vst + (4 + g4) * 288 + cl * 16) = vq9;
        *(uint4*)(vst + (8 + g4) * 288 + cl * 16) = vq10;
        *(uint4*)(vst + (12 + g4) * 288 + cl * 16) = vq11;
        *(uint4*)(vst + (16 + g4) * 288 + cl * 16) = vq12;
        *(uint4*)(vst + (20 + g4) * 288 + cl * 16) = vq13;
        *(uint4*)(vst + (24 + g4) * 288 + cl * 16) = vq14;
        *(uint4*)(vst + (28 + g4) * 288 + cl * 16) = vq15;
        __builtin_amdgcn_wave_barrier();
#pragma unroll
        for (int j = 0; j < 2; j++)
#pragma unroll
          for (int dt = 0; dt < 4; dt++) {
            const s16x4 alo = vtr(vb + (j * 64 + dt * 16) * 2);
            const s16x4 ahi = vtr(vb + (j * 64 + dt * 16) * 2 + 16 * 288);
            const bf16x8 af = __builtin_shufflevector(alo, ahi, 0, 1, 2, 3, 4, 5, 6, 7);
            o[j][dt] = mfma16(af, pb[j][1].v, o[j][dt]);
          }
        __builtin_amdgcn_wave_barrier();
      }
      vq0 = *(const uint4*)(Vs + (size_t)idxl[qn * 256 + wave * 64 + 0 + g4] * 128 + cl * 8);
      vq1 = *(const uint4*)(Vs + (size_t)idxl[qn * 256 + wave * 64 + 4 + g4] * 128 + cl * 8);
      vq2 = *(const uint4*)(Vs + (size_t)idxl[qn * 256 + wave * 64 + 8 + g4] * 128 + cl * 8);
      vq3 = *(const uint4*)(Vs + (size_t)idxl[qn * 256 + wave * 64 + 12 + g4] * 128 + cl * 8);
      vq4 = *(const uint4*)(Vs + (size_t)idxl[qn * 256 + wave * 64 + 16 + g4] * 128 + cl * 8);
      vq5 = *(const uint4*)(Vs + (size_t)idxl[qn * 256 + wave * 64 + 20 + g4] * 128 + cl * 8);
      vq6 = *(const uint4*)(Vs + (size_t)idxl[qn * 256 + wave * 64 + 24 + g4] * 128 + cl * 8);
      vq7 = *(const uint4*)(Vs + (size_t)idxl[qn * 256 + wave * 64 + 28 + g4] * 128 + cl * 8);
      vq8 = *(const uint4*)(Vs + (size_t)idxl[qn * 256 + wave * 64 + 32 + g4] * 128 + cl * 8);
      vq9 = *(const uint4*)(Vs + (size_t)idxl[qn * 256 + wave * 64 + 36 + g4] * 128 + cl * 8);
      vq10 = *(const uint4*)(Vs + (size_t)idxl[qn * 256 + wave * 64 + 40 + g4] * 128 + cl * 8);
      vq11 = *(const uint4*)(Vs + (size_t)idxl[qn * 256 + wave * 64 + 44 + g4] * 128 + cl * 8);
      vq12 = *(const uint4*)(Vs + (size_t)idxl[qn * 256 + wave * 64 + 48 + g4] * 128 + cl * 8);
      vq13 = *(const uint4*)(Vs + (size_t)idxl[qn * 256 + wave * 64 + 52 + g4] * 128 + cl * 8);
      vq14 = *(const uint4*)(Vs + (size_t)idxl[qn * 256 + wave * 64 + 56 + g4] * 128 + cl * 8);
      vq15 = *(const uint4*)(Vs + (size_t)idxl[qn * 256 + wave * 64 + 60 + g4] * 128 + cl * 8);
      if (cl < 4) {
#pragma unroll
        for (int j = 0; j < 2; j++)
#pragma unroll
          for (int dt = 0; dt < 4; dt++) *(f32x4*)(opb + (wave * 8 + j * 4 + cl) * 64 + dt * 16 + g4 * 4) = o[j][dt];
      }
    } else {
      if (lane < 8) {
        mlb[(wave * 8 + lane) * 2] = -1e30f;
        mlb[(wave * 8 + lane) * 2 + 1] = 0.f;
      }
      *(f32x4*)(opb + wave * 512 + lane * 8) = (f32x4){0.f, 0.f, 0.f, 0.f};
      *(f32x4*)(opb + wave * 512 + lane * 8 + 4) = (f32x4){0.f, 0.f, 0.f, 0.f};
    }
    __syncthreads();
    {
      const int e = tid * 2, head = e >> 6, d = e & 63;
      float M = -1e30f;
#pragma unroll
      for (int w = 0; w < 4; w++) M = fmaxf(M, mlb[(w * 8 + head) * 2]);
      float den = 0.f, n0 = 0.f, n1 = 0.f;
#pragma unroll
      for (int w = 0; w < 4; w++) {
        const float f = __expf(mlb[(w * 8 + head) * 2] - M);
        den += mlb[(w * 8 + head) * 2 + 1] * f;
        const float2 o2 = *(const float2*)(opb + (w * 8 + head) * 64 + d);
        n0 += o2.x * f;
        n1 += o2.y * f;
      }
      const float inv = __builtin_amdgcn_rcpf(den);
      if (!dry) *(unsigned*)(p.qa + (size_t)tok * 512 + e) = pack2(n0 * inv, n1 * inv);
    }
  }
  __syncthreads();
}

DI void mixer_phase(const Params& p, int l, char* smem, const bool dry = false, const int ci = 0) {
  const int tid = otid();
  const int NTASK = 64 + 1024 + 1024 + 128 + 288;
  const int NEXTRA = (l == 0 && !dry) ? 456 : 0;
  bool first = true;
  for (;;) {
    int id;
    if (first && blockIdx.x < 64) {
      id = blockIdx.x;
    } else {
      __syncthreads();
      if (tid == 0) *(int*)(smem + SLOT) = 64 + (int)atomicAdd(&p.ctr[l + ci], 1u);
      __syncthreads();
      id = *(const int*)(smem + SLOT);
    }
    first = false;
    if (id >= NTASK + NEXTRA) break;
    if (id >= NTASK) {
      for (int q = 0; q < 8; q++) {
        const int d = (id - NTASK) * 8 + q;
        const int t = d < 1984 ? 2880 + d : d < 2624 ? 2880 + 2240 + (d - 1984) : 5760 + 1024 + (d - 2624);
        transpose_job(p, t, (float*)smem);
      }
      continue;
    }
    const int d = id - 64;
    if (id < 64 || d >= 1440) {
      int isP, b, h, rg;
      if (id < 64) { isP = 1; b = id >> 5; h = (id >> 2) & 7; rg = id & 3; }
      else { const int s = d - 1440; isP = 0; b = s >> 5; h = (s >> 2) & 7; rg = s & 3; }
      if (!(dry && (PROBE_SKIP & 2))) scan_task(p, l, isP, b, h, rg, smem, dry);
    } else if (d < 896 || d >= 1184) {
      int isP, b, tq;
      if (d < 768) { isP = 1; b = d & 1; tq = (511 - (d >> 1)) * 16; }
      else if (d < 896) { const int s = d - 768; isP = 0; b = s >> 2; tq = (s & 3) * 16; }
      else { const int s = d - 1184; isP = 1; b = s & 1; tq = (127 - (s >> 1)) * 16; }
      if (!(dry && (PROBE_SKIP & 1))) dsa_task(p, l, isP, b, tq, smem, dry);
    } else {
      if (!(dry && (PROBE_SKIP & 4))) mem_task(p, l, (d - 896) * 64, smem, dry);
    }
  }
}

DI void post_phase(const Params& p, int l) {
  const int tid = otid(), lane = tid & 63, wave = tid >> 6;
  for (int tok = blockIdx.x * 4 + wave; tok < TOK; tok += gridDim.x * 4) {
    float y[8], lw[8], lb[8], vv[8], bo[8];
    const bf16_t* vb = (const bf16_t*)(p.R + (size_t)tok * RS + 512) + 1024;
#pragma unroll
    for (int h = 0; h < 8; h++) {
      const int c = h * 64 + lane;
      y[h] = p.yscan[(size_t)tok * 512 + c];
      lw[h] = p.ln_w[l * 512 + c];
      lb[h] = p.ln_b[l * 512 + c];
      vv[h] = bf2f(vb[c]);
      bo[h] = p.bonus[(size_t)tok * 8 + h];
    }
#pragma unroll
    for (int h = 0; h < 8; h++) {
      const float mean = wave_sum(y[h]) * (1.f / 64.f);
      const float dv = y[h] - mean;
      const float var = wave_sum(dv * dv) * (1.f / 64.f);
      const float yn = dv * rsqrtf(var + 64e-5f) * lw[h] + lb[h];
      y[h] = yn + bo[h] * vv[h];
    }
#pragma unroll
    for (int h = 0; h < 8; h++) p.o_r[(size_t)tok * 512 + h * 64 + lane] = f2bf(y[h]);
  }
}

DI void gemm2_phase(const Params& p, int l, char* smem, const bool dry = false) {
  bf16_t* sm = (bf16_t*)smem;
  const int tid = otid(), lane = tid & 63, wave = tid >> 6;
  const int wm = wave >> 1, wn = wave & 1, g4 = lane >> 4, cl = lane & 15;
  const int slots = gridDim.x >> 3, slot = blockIdx.x >> 3;
  for (int e = slot;; e += slots) {
    int mt, nt;
    if (!xcd_tile(e, 36, mt, nt)) break;
    f32x4 acc[4][4];
    zero_acc(acc);
    gemm_kloop(p.hb + (size_t)mt * 128 * DM, DM, p.Wt2 + ((size_t)l * N2 + nt * 128) * DM, DM, DM, sm, acc);
    const int nb = nt * 128 + wn * 64;
    if (dry) {
      if (acc[0][0][0] == 1.2345e30f) p.wi[0] = acc[1][1][1] + acc[2][2][2] + acc[3][3][3];
    } else if (nb < 1536) {
      bf16_t* base = (nb < 512 ? p.qa : nb < 1024 ? p.o_r : p.qm) + (nb & 511) + cl;
      bf16_t old[4][4][4];
#pragma unroll
      for (int i = 0; i < 4; i++)
#pragma unroll
        for (int r = 0; r < 4; r++) {
          const int tok = mt * 128 + wm * 64 + i * 16 + g4 * 4 + r;
#pragma unroll
          for (int jn = 0; jn < 4; jn++) old[i][r][jn] = base[(size_t)tok * 512 + jn * 16];
        }
#pragma unroll
      for (int i = 0; i < 4; i++)
#pragma unroll
        for (int r = 0; r < 4; r++) {
          const int tok = mt * 128 + wm * 64 + i * 16 + g4 * 4 + r;
#pragma unroll
          for (int jn = 0; jn < 4; jn++) base[(size_t)tok * 512 + jn * 16] = f2bf(bf2f(old[i][r][jn]) * siluf_(acc[i][jn][r]));
        }
    } else {
#pragma unroll
      for (int i = 0; i < 4; i++)
#pragma unroll
        for (int r = 0; r < 4; r++) {
          const int tok = mt * 128 + wm * 64 + i * 16 + g4 * 4 + r;
#pragma unroll
          for (int jn = 0; jn < 4; jn++)
            p.G[(size_t)tok * 3072 + nb - 1536 + jn * 16 + cl] = f2bf(sigmoidf_(acc[i][jn][r]));
        }
    }
  }
}

DI void merge_phase(const Params& p, int l, char* smem) {
  bf16_t* sm = (bf16_t*)smem;
  const int tid = otid(), lane = tid & 63, wave = tid >> 6;
  const int g4 = lane >> 4, cl = lane & 15;
  const int slots = gridDim.x >> 3, slot = blockIdx.x >> 3;
  for (int e = slot;; e += slots) {
    int mt, nt;
    if (!xcd_tile(e, 16, mt, nt)) break;
    f32x4 tot[2][4];
#pragma unroll
    for (int i = 0; i < 2; i++)
#pragma unroll
      for (int j = 0; j < 4; j++) tot[i][j] = (f32x4){0.f, 0.f, 0.f, 0.f};
#pragma unroll 1
    for (int br = 0; br < 3; br++) {
      f32x4 acc[2][4];
#pragma unroll
      for (int i = 0; i < 2; i++)
#pragma unroll
        for (int j = 0; j < 4; j++) acc[i][j] = (f32x4){0.f, 0.f, 0.f, 0.f};
      const bf16_t* A = (br == 0 ? p.qa : br == 1 ? p.o_r : p.qm) + (size_t)mt * 128 * 512;
      gemm_kloop64(A, 512, p.Wbr + ((size_t)(l * 3 + br) * DM + nt * 64) * 512, 512, 512, sm, acc);
#pragma unroll
      for (int i = 0; i < 2; i++)
#pragma unroll
        for (int r = 0; r < 4; r++) {
          const int tok = mt * 128 + wave * 32 + i * 16 + g4 * 4 + r;
#pragma unroll
          for (int jn = 0; jn < 4; jn++) {
            const int n = nt * 64 + jn * 16 + cl;
            const float g = bf2f(p.G[(size_t)tok * 3072 + br * 1024 + n]);
            tot[i][jn][r] += g * acc[i][jn][r];
          }
        }
    }
#pragma unroll
    for (int i = 0; i < 2; i++)
#pragma unroll
      for (int r = 0; r < 4; r++) {
        const int tok = mt * 128 + wave * 32 + i * 16 + g4 * 4 + r;
#pragma unroll
        for (int jn = 0; jn < 4; jn++) {
          const int n = nt * 64 + jn * 16 + cl;
          p.merged[(size_t)tok * DM + n] = f2bf(tot[i][jn][r]);
        }
      }
  }
}

DI void out_phase(const Params& p, int l, char* smem, const bool dry = false) {
  bf16_t* sm = (bf16_t*)smem;
  const int tid = otid(), lane = tid & 63, wave = tid >> 6;
  const int wm = wave >> 1, wn = wave & 1, g4 = lane >> 4, cl = lane & 15;
  const int slots = gridDim.x >> 3, slot = blockIdx.x >> 3;
  for (int e = slot;; e += slots) {
    int mt, nt;
    if (!xcd_tile(e, 8, mt, nt)) break;
    f32x4 acc[4][4];
    zero_acc(acc);
    gemm_kloop(p.merged + (size_t)mt * 128 * DM, DM, p.Wout + ((size_t)l * DM + nt * 128) * DM, DM, DM, sm, acc);
    if (dry) {
      if (acc[0][0][0] == 1.2345e30f) p.wi[0] = acc[1][1][1] + acc[2][2][2] + acc[3][3][3];
      continue;
    }
    float xo[4][4][4];
#pragma unroll
    for (int i = 0; i < 4; i++)
#pragma unroll
      for (int r = 0; r < 4; r++) {
        const int tok = mt * 128 + wm * 64 + i * 16 + g4 * 4 + r;
        const float* xr = xrow_ptr(p, l, tok);
#pragma unroll
        for (int jn = 0; jn < 4; jn++) xo[i][r][jn] = xr[nt * 128 + wn * 64 + jn * 16 + cl];
      }
#pragma unroll
    for (int i = 0; i < 4; i++)
#pragma unroll
      for (int r = 0; r < 4; r++) {
        const int tok = mt * 128 + wm * 64 + i * 16 + g4 * 4 + r;
#pragma unroll
        for (int jn = 0; jn < 4; jn++) {
          const int n = nt * 128 + wn * 64 + jn * 16 + cl;
          p.out[(size_t)tok * DM + n] = xo[i][r][jn] + acc[i][jn][r];
        }
      }
  }
}

DI void norm_phase(const Params& p, int l) {
  const int wave = otid() >> 6;
  for (int tok = blockIdx.x * 4 + wave; tok < TOK; tok += gridDim.x * 4)
    norm_row_bf16(xrow_ptr(p, l, tok), p.norm_g + l * DM, p.hb + (size_t)tok * DM);
}
DI void final_phase(const Params& p) {
  const int lane = otid() & 63, wave = otid() >> 6;
  for (int tok = blockIdx.x * 4 + wave; tok < TOK; tok += gridDim.x * 4) {
    float* x = p.out + (size_t)tok * DM;
    float4 v[4];
    float ss = 0.f;
#pragma unroll
    for (int i = 0; i < 4; i++) {
      v[i] = *(const float4*)(x + i * 256 + lane * 4);
      ss += v[i].x * v[i].x + v[i].y * v[i].y + v[i].z * v[i].z + v[i].w * v[i].w;
    }
    ss = wave_sum(ss);
    const float rstd = rsqrtf(ss * (1.f / 1024.f) + 1e-6f);
#pragma unroll
    for (int i = 0; i < 4; i++) {
      const float4 g = *(const float4*)(p.final_g + i * 256 + lane * 4);
      *(float4*)(x + i * 256 + lane * 4) = make_float4(v[i].x * rstd * g.x, v[i].y * rstd * g.y, v[i].z * rstd * g.z, v[i].w * rstd * g.w);
    }
  }
}

__global__ void __launch_bounds__(256, 2) mega(Params pk) {
  const Params& p = *(const Params*)__builtin_amdgcn_kernarg_segment_ptr();
  cg::grid_group grid = cg::this_grid();
  __shared__ __attribute__((aligned(16))) char smem[SMEM];
  phase0(p, smem);
  grid.sync();
  GBar gb;
  gbar_init(gb, p.ctr);
#ifndef PROBE_DUP
#define PROBE_DUP 0
#endif
  const bool dryv = PROBE_DUP ? (*(volatile unsigned*)&p.ctr[7] == 0u) : false;
  if (PROBE_DUP & 1) { phase0(p, smem); gbar(gb); }
  for (int l = 0; l < 2; l++) {
    if (l == 1) { norm_phase(p, 1); convert_caches(p, 1); gbar(gb); }
    if (PROBE_DUP & 2) { gemm1_phase(p, l, smem); gbar(gb); }
    gemm1_phase(p, l, smem);
    gbar(gb);
    if (PROBE_DUP & 4) { prep_phase(p, l, smem, dryv); gbar(gb); }
    prep_phase(p, l, smem);
    gbar(gb);
    if (PROBE_DUP & 8) { mixer_phase(p, l, smem, dryv, 2); gbar(gb); }
    mixer_phase(p, l, smem);
    gbar(gb);
    if (PROBE_DUP & 16) { post_phase(p, l); gbar(gb); }
    post_phase(p, l);
    gbar(gb);
    if (PROBE_DUP & 32) { gemm2_phase(p, l, smem, dryv); gbar(gb); }
    gemm2_phase(p, l, smem);
    gbar(gb);
    if (PROBE_DUP & 64) { merge_phase(p, l, smem); gbar(gb); }
    merge_phase(p, l, smem);
    gbar(gb);
    if (PROBE_DUP & 128) { out_phase(p, l, smem, dryv); gbar(gb); }
    out_phase(p, l, smem);
    gbar(gb);
  }
  final_phase(p);
}

extern "C" void kernel_launch(void* const* d_in, const int* in_sizes, int n_in, void* d_out, int out_size, void* d_ws,
                              size_t ws_size, hipStream_t stream) {
  Params p;
  ::memset((void*)&p, 0, sizeof(p));
  const float** f = (const float**)&p;
  for (int i = 0; i < 29; i++) f[i] = (const float*)d_in[i];
  p.out = (float*)d_out;
  char* w = (char*)d_ws;
  size_t off = 0;
  auto take = [&](size_t bytes) { char* r = w + off; off += (bytes + 255) & ~(size_t)255; return r; };
  p.Wt1 = (bf16_t*)take((size_t)2 * N1 * DM * 2);
  p.Wt2 = (bf16_t*)take((size_t)2 * N2 * DM * 2);
  p.Wmem = (bf16_t*)take((size_t)2 * DM * DM * 2);
  p.Wbr = (bf16_t*)take((size_t)2 * 3 * DM * 512 * 2);
  p.Wout = (bf16_t*)take((size_t)2 * DM * DM * 2);
  p.cmvT = (bf16_t*)take((size_t)2 * 32 * 4 * 128 * 256 * 2);
  p.pmvT = (bf16_t*)take((size_t)2 * 2 * 4 * 128 * 256 * 2);
  p.memn = (bf16_t*)take((size_t)2 * 512 * DM * 2);
  p.rope = (float*)take((size_t)8192 * 32 * 2 * 4);
  p.hb = (bf16_t*)take((size_t)TOK * DM * 2);
  p.qa = (bf16_t*)take((size_t)TOK * 512 * 2);
  p.qi = (bf16_t*)take((size_t)TOK * 256 * 2);
  p.qm = (bf16_t*)take((size_t)TOK * 512 * 2);
  p.o_r = (bf16_t*)take((size_t)TOK * 512 * 2);
  p.wi = (float*)take((size_t)TOK * 4 * 4);
  p.R = (float*)take((size_t)TOK * RS * 4);
  p.G = (bf16_t*)p.R;
  p.yscan = (float*)take((size_t)TOK * 512 * 4);
  p.merged = (bf16_t*)p.yscan;
  p.bnd = (float*)take((size_t)(TOK / 16) * DSH * 4);
  p.bonus = (float*)take((size_t)TOK * 8 * 4);
  p.ctr = (unsigned*)take(16384);
  p.KB = (bf16_t*)take((size_t)NROWS * 128 * 2);
  p.VB = (bf16_t*)take((size_t)NROWS * 128 * 2);
  p.KIB = (bf16_t*)take((size_t)NROWS * 64 * 2);
  if (off > ws_size) {
    fprintf(stderr, "workspace too small: need %zu have %zu\n", off, ws_size);
    return;
  }
  static int grid_blocks = 0;
  if (!grid_blocks) {
    int dev = 0, cus = 0, per_cu = 0;
    (void)hipGetDevice(&dev);
    (void)hipDeviceGetAttribute(&cus, hipDeviceAttributeMultiprocessorCount, dev);
    (void)hipOccupancyMaxActiveBlocksPerMultiprocessor(&per_cu, mega, 256, 0);
    if (per_cu > 2) per_cu = 2;
    if (per_cu < 1) per_cu = 1;
    grid_blocks = (cus * per_cu) & ~7;
  }
  (void)hipMemsetAsync(p.ctr, 0, 16384, stream);
  void* args[] = {&p};
  hipError_t e = hipLaunchCooperativeKernel((void*)mega, dim3(grid_blocks), dim3(256), args, 0, stream);
  if (e != hipSuccess) fprintf(stderr, "cooperative launch failed: %s (grid %d)\n", hipGetErrorString(e), grid_blocks);
}
```

```cpp
#include <hip/hip_runtime.h>
#include <hip/hip_cooperative_groups.h>
#include <stdint.h>
#include <stdio.h>
#include <string.h>
namespace cg = cooperative_groups;

#define DI __device__ __forceinline__
#define PROBE_SKIP 2
typedef unsigned short bf16_t;
typedef __attribute__((ext_vector_type(8))) short bf16x8;
typedef __attribute__((ext_vector_type(4))) float f32x4;
typedef __attribute__((ext_vector_type(2))) float f32x2;

constexpr int DM = 1024;
constexpr int TP = 16384;
constexpr int TOK = 18432;
constexpr int DIN = 7876;
constexpr int N1 = 3328;
constexpr int N2 = 4608;
constexpr int RS = 1792;
constexpr int DSH = 1664;
constexpr int SMEM = 73728;
constexpr int SLOT = SMEM - 16;
constexpr int NROWS = 16384 + 32 * 2112;

constexpr size_t O_Y = 0;
constexpr size_t O_KP = 18874368;
constexpr size_t O_VP = O_KP + 4194304;
constexpr size_t O_KIP = O_VP + 4194304;
constexpr size_t O_WKVP = O_KIP + 2097152;
constexpr size_t O_SHP = O_WKVP + 131072;
constexpr size_t O_MKP = O_SHP + 6656;
constexpr size_t O_MVP = O_MKP + 524288;
constexpr size_t O_KS = O_MVP + 524288;
constexpr size_t O_VS = O_KS + 524288;
constexpr size_t O_KIS = O_VS + 524288;
constexpr size_t O_WKVS = O_KIS + 262144;
constexpr size_t O_SHS = O_WKVS + 2097152;

struct Params {
  const float *x_prompt, *x_sample, *mem_prompt, *cache_k, *cache_v, *cache_kidx, *state_wkv, *state_shift,
      *cache_mem_k, *cache_mem_v, *norm_g, *w_in, *mu_shift, *w0, *w2, *a0, *a2, *k_k, *k_a, *r_k, *ln_w, *ln_b,
      *mem_norm_g, *w_mem_kv, *w_br_a, *w_br_r, *w_br_m, *w_out, *final_g;
  float* out;
  bf16_t *Wt1, *Wt2, *Wmem, *Wbr, *Wout, *cmvT, *pmvT, *memn, *hb, *qa, *qi, *qm, *o_r, *merged, *G, *KB, *VB, *KIB;
  float *rope, *wi, *R, *yscan, *bnd, *bonus;
  unsigned* ctr;
};

DI int otid() { int t = __builtin_amdgcn_workitem_id_x(); asm volatile("" : "+v"(t)); return t; }
typedef __bf16 bf16x2_t __attribute__((ext_vector_type(2)));
DI unsigned pack2(float a, float b) {
  const f32x2 v = {a, b};
  const bf16x2_t r = __builtin_convertvector(v, bf16x2_t);
  return __builtin_bit_cast(unsigned, r);
}
DI bf16_t f2bf(float f) { return (bf16_t)(pack2(f, f) & 0xFFFFu); }
DI float bf2f(bf16_t b) { return __uint_as_float(((unsigned)b) << 16); }
DI bf16x8 cvt8(const float* p) {
  float4 x = *(const float4*)p, y = *(const float4*)(p + 4);
  union { bf16x8 v; unsigned u[4]; } r;
  r.u[0] = pack2(x.x, x.y); r.u[1] = pack2(x.z, x.w); r.u[2] = pack2(y.x, y.y); r.u[3] = pack2(y.z, y.w);
  return r.v;
}
template <int CTRL> DI float dpp_add(float x) {
  int y = __builtin_amdgcn_update_dpp(0, __float_as_int(x), CTRL, 0xF, 0xF, false);
  return x + __int_as_float(y);
}
DI float rowsum16(float x) {
  x = dpp_add<0xB1>(x);
  x = dpp_add<0x4E>(x);
  x = dpp_add<0x141>(x);
  x = dpp_add<0x140>(x);
  return x;
}
DI float wave_sum(float v) {
  v = rowsum16(v);
  const float a = __int_as_float(__builtin_amdgcn_readlane(__float_as_int(v), 0));
  const float b = __int_as_float(__builtin_amdgcn_readlane(__float_as_int(v), 16));
  const float c = __int_as_float(__builtin_amdgcn_readlane(__float_as_int(v), 32));
  const float d = __int_as_float(__builtin_amdgcn_readlane(__float_as_int(v), 48));
  return (a + b) + (c + d);
}
typedef __attribute__((address_space(3))) const char* lds_cptr;
typedef short v4i16_t __attribute__((ext_vector_type(4)));
typedef __attribute__((ext_vector_type(4))) short s16x4;
DI s16x4 vtr(lds_cptr p) { return __builtin_bit_cast(s16x4, __builtin_amdgcn_ds_read_tr16_b64_v4i16((__attribute__((address_space(3))) v4i16_t*)p)); }
DI void rowsum16x2(float& x, float& z) {
  x = dpp_add<0xB1>(x);  z = dpp_add<0xB1>(z);
  x = dpp_add<0x4E>(x);  z = dpp_add<0x4E>(z);
  x = dpp_add<0x141>(x); z = dpp_add<0x141>(z);
  x = dpp_add<0x140>(x); z = dpp_add<0x140>(z);
}
DI float sigmoidf_(float x) { return __builtin_amdgcn_rcpf(1.f + __expf(-x)); }
DI float siluf_(float x) { return x * __builtin_amdgcn_rcpf(1.f + __expf(-x)); }
DI f32x4 mfma16(bf16x8 a, bf16x8 b, f32x4 c) { return __builtin_amdgcn_mfma_f32_16x16x32_bf16(a, b, c, 0, 0, 0); }

DI const float* xrow_ptr(const Params& p, int l, int tok) {
  if (l == 0) return tok < TP ? p.x_prompt + (size_t)tok * DM : p.x_sample + (size_t)(tok - TP) * DM;
  return p.out + (size_t)tok * DM;
}


DI unsigned xcc_id() { return (unsigned)__builtin_amdgcn_s_getreg((3 << 11) | 20) & 0xFu; }
struct GBar { unsigned* w; unsigned xcc, mycen, nx, k; };
DI void gbar_init(GBar& g, unsigned* w) {
  g.w = w; g.xcc = (unsigned)__builtin_amdgcn_readfirstlane((int)xcc_id()); g.k = 0;
  unsigned nx = 0, mycen = 0;
  for (unsigned x = 0; x < 16; x++) {
    const unsigned c = __hip_atomic_load(&w[64 + 64 * x], __ATOMIC_RELAXED, __HIP_MEMORY_SCOPE_AGENT);
    if (c) nx++;
    if (x == g.xcc) mycen = c;
  }
  g.nx = (unsigned)__builtin_amdgcn_readfirstlane((int)nx);
  g.mycen = (unsigned)__builtin_amdgcn_readfirstlane((int)mycen);
}
DI void gbar(GBar& g) {
  g.k++;
  asm volatile("s_waitcnt vmcnt(0) lgkmcnt(0)" ::: "memory");
  __syncthreads();
  if (otid() == 0) {
    const unsigned a = __hip_atomic_fetch_add(&g.w[1152 + 64 * g.xcc], 1u, __ATOMIC_RELAXED, __HIP_MEMORY_SCOPE_AGENT) + 1u;
    if (a == g.k * g.mycen) {
      __builtin_amdgcn_fence(__ATOMIC_RELEASE, "agent");
      asm volatile("s_waitcnt vmcnt(0)" ::: "memory");
      __hip_atomic_fetch_add(&g.w[2240], 1u, __ATOMIC_RELAXED, __HIP_MEMORY_SCOPE_AGENT);
    }
    while (__hip_atomic_load(&g.w[2240], __ATOMIC_RELAXED, __HIP_MEMORY_SCOPE_AGENT) < g.k * g.nx) __builtin_amdgcn_s_sleep(1);
    __builtin_amdgcn_fence(__ATOMIC_ACQUIRE, "agent");
    asm volatile("s_waitcnt vmcnt(0)" ::: "memory");
  }
  __syncthreads();
}

DI int colmap(int kind, int n) {
  if (kind == 1) {
    if (n < 1092) return n;
    if (n < 1152) return -1;
    if (n < 2816) return 1604 + (n - 1152);
    return 3780 + (n - 2816);
  } else if (kind == 2) {
    if (n < 512) return 1092 + n;
    if (n < 1024) return 3268 + (n - 512);
    if (n < 1536) return 4292 + (n - 1024);
    return 4804 + (n - 1536);
  }
  return n;
}
DI void transpose_tile(const float* __restrict__ src, int ldsrc, int kind, int k0, int n0, bf16_t* __restrict__ dst,
                       int lddst, float* tile) {
  const int tid = otid();
  float v[16];
#pragma unroll
  for (int r = 0; r < 16; r++) {
    const int kk = r * 4 + (tid >> 6), nn = tid & 63;
    const int sc = colmap(kind, n0 + nn);
    v[r] = sc >= 0 ? src[(size_t)(k0 + kk) * ldsrc + sc] : 0.f;
  }
  __syncthreads();
#pragma unroll
  for (int r = 0; r < 16; r++) tile[(r * 4 + (tid >> 6)) * 65 + (tid & 63)] = v[r];
  __syncthreads();
#pragma unroll
  for (int r = 0; r < 8; r++) {
    const int nn = r * 8 + (tid >> 5), kk = (tid & 31) * 2;
    *(unsigned*)(dst + (size_t)(n0 + nn) * lddst + k0 + kk) = pack2(tile[kk * 65 + nn], tile[(kk + 1) * 65 + nn]);
  }
}
DI void norm_row_bf16(const float* __restrict__ x, const float* __restrict__ g, bf16_t* __restrict__ dst) {
  const int lane = otid() & 63;
  float4 v[4];
  float ss = 0.f;
#pragma unroll
  for (int i = 0; i < 4; i++) {
    v[i] = *(const float4*)(x + i * 256 + lane * 4);
    ss += v[i].x * v[i].x + v[i].y * v[i].y + v[i].z * v[i].z + v[i].w * v[i].w;
  }
  ss = wave_sum(ss);
  float rstd = rsqrtf(ss * (1.f / 1024.f) + 1e-6f);
#pragma unroll
  for (int i = 0; i < 4; i++) {
    float4 gg = *(const float4*)(g + i * 256 + lane * 4);
    uint2 o;
    o.x = pack2(v[i].x * rstd * gg.x, v[i].y * rstd * gg.y);
    o.y = pack2(v[i].z * rstd * gg.z, v[i].w * rstd * gg.w);
    *(uint2*)(dst + i * 256 + lane * 4) = o;
  }
}


DI void convert_caches(const Params& p, int l) {
  const int tid = otid();
  const long total = (long)32 * 2048 * 40;
  for (long e = (long)blockIdx.x * 256 + tid; e < total; e += (long)gridDim.x * 256) {
    const int row = (int)(e / 40), c = (int)(e - (long)row * 40);
    const int b = row >> 11, pos = row & 2047;
    const size_t drow = (size_t)16384 + (size_t)b * 2112 + pos;
    const size_t srow = (size_t)(l * 32 + b) * 2048 + pos;
    if (c < 16) *(bf16x8*)(p.KB + drow * 128 + c * 8) = cvt8(p.cache_k + srow * 128 + c * 8);
    else if (c < 32) *(bf16x8*)(p.VB + drow * 128 + (c - 16) * 8) = cvt8(p.cache_v + srow * 128 + (c - 16) * 8);
    else *(bf16x8*)(p.KIB + drow * 64 + (c - 32) * 8) = cvt8(p.cache_kidx + srow * 64 + (c - 32) * 8);
  }
}

DI void transpose_job(const Params& p, int t, float* tile) {
  const int NTW = 2880;
  if (t < 2 * NTW) {
    int l = t / NTW, r = t - l * NTW;
    if (r < 832) {
      int nt = r >> 4, kt = r & 15;
      transpose_tile(p.w_in + (size_t)l * DM * DIN, DIN, 1, kt * 64, nt * 64, p.Wt1 + (size_t)l * N1 * DM, DM, tile);
    } else if (r < 832 + 1152) {
      r -= 832;
      int nt = r >> 4, kt = r & 15;
      transpose_tile(p.w_in + (size_t)l * DM * DIN, DIN, 2, kt * 64, nt * 64, p.Wt2 + (size_t)l * N2 * DM, DM, tile);
    } else if (r < 832 + 1152 + 256) {
      r -= 1984;
      int nt = r >> 4, kt = r & 15;
      transpose_tile(p.w_mem_kv + (size_t)l * DM * DM, DM, 0, kt * 64, nt * 64, p.Wmem + (size_t)l * DM * DM, DM, tile);
    } else if (r < 2240 + 384) {
      r -= 2240;
      int br = r >> 7; r &= 127;
      int nt = r >> 3, kt = r & 7;
      const float* src = (br == 0 ? p.w_br_a : br == 1 ? p.w_br_r : p.w_br_m) + (size_t)l * 512 * DM;
      transpose_tile(src, DM, 0, kt * 64, nt * 64, p.Wbr + (size_t)(l * 3 + br) * DM * 512, 512, tile);
    } else {
      r -= 2624;
      int nt = r >> 4, kt = r & 15;
      transpose_tile(p.w_out + (size_t)l * DM * DM, DM, 0, kt * 64, nt * 64, p.Wout + (size_t)l * DM * DM, DM, tile);
    }
  } else {
    int r = t - 2 * NTW;
    int job = r >> 3, sub = r & 7;
    int lb = job >> 2, h = job & 3;
    int nt = sub >> 2, kt = sub & 3;
    transpose_tile(p.cache_mem_v + (size_t)lb * 256 * 512 + h * 128, 512, 0, kt * 64, nt * 64,
                   p.cmvT + (size_t)(lb * 4 + h) * 128 * 256, 256, tile);
  }
}

DI void phase0(const Params& p, char* smem) {
  const int tid = otid();
  float* tile = (float*)smem;
  if (tid == 0) __hip_atomic_fetch_add(&p.ctr[64 + 64 * xcc_id()], 1u, __ATOMIC_RELAXED, __HIP_MEMORY_SCOPE_AGENT);
  for (int t = blockIdx.x; t < 2 * 2880 + 2048; t += gridDim.x) {
    const bool deferred = (t >= 2880 && t < 5760 && !(t - 2880 >= 1984 && t - 2880 < 2240)) || (t >= 5760 + 1024);
    if (!deferred) transpose_job(p, t, tile);
  }
  convert_caches(p, 0);
  for (int e = blockIdx.x * 256 + tid; e < 8192 * 32; e += gridDim.x * 256) {
    int pos = e >> 5, i = e & 31;
    float inv = powf(10000.f, -(float)(2 * i) / 64.f);
    float ang = (float)pos * inv;
    float s, c;
    sincosf(ang, &s, &c);
    p.rope[2 * e] = c;
    p.rope[2 * e + 1] = s;
  }
  const int wave = tid >> 6;
  for (int r = blockIdx.x * 4 + wave; r < 1024 + TOK; r += gridDim.x * 4) {
    if (r < 1024) {
      int l = r >> 9, row = r & 511;
      norm_row_bf16(p.mem_prompt + (size_t)row * DM, p.mem_norm_g + l * DM, p.memn + (size_t)r * DM);
    } else {
      int tok = r - 1024;
      norm_row_bf16(xrow_ptr(p, 0, tok), p.norm_g, p.hb + (size_t)tok * DM);
    }
  }
}

constexpr int LDT = 72;
constexpr int TILE_E = 128 * LDT;
DI void gemm_kloop(const bf16_t* __restrict__ A, int lda, const bf16_t* __restrict__ B, int ldb, int K, bf16_t* sm,
                   f32x4 (&acc)[4][4]) {
  const int tid = otid(), lane = tid & 63, wave = tid >> 6;
  const int wm = wave >> 1, wn = wave & 1;
  const int lrow = tid >> 3, lkc = (tid & 7) * 8;
  const unsigned toa = (unsigned)(lrow * lda + lkc), tob = (unsigned)(lrow * ldb + lkc);
  uint4 ra0_0, ra0_1, ra0_2, ra0_3, rb0_0, rb0_1, rb0_2, rb0_3, ra1_0, ra1_1, ra1_2, ra1_3, rb1_0, rb1_1, rb1_2, rb1_3;
  const int fr = lane & 15, fk = (lane >> 4) * 8;
  const int nk = K >> 6;
#define GLOAD(RA, RB, K0)                                                   \
  {                                                                         \
    RA##_0 = *(const uint4*)((A + (size_t)(K0)) + toa);                     \
    RA##_1 = *(const uint4*)((A + (size_t)(32 * lda + (K0))) + toa);        \
    RA##_2 = *(const uint4*)((A + (size_t)(64 * lda + (K0))) + toa);        \
    RA##_3 = *(const uint4*)((A + (size_t)(96 * lda + (K0))) + toa);        \
    RB##_0 = *(const uint4*)((B + (size_t)(K0)) + tob);                     \
    RB##_1 = *(const uint4*)((B + (size_t)(32 * ldb + (K0))) + tob);        \
    RB##_2 = *(const uint4*)((B + (size_t)(64 * ldb + (K0))) + tob);        \
    RB##_3 = *(const uint4*)((B + (size_t)(96 * ldb + (K0))) + tob);        \
  }
#define SSTORE(RA, RB, BUF)                                                 \
  {                                                                         \
    bf16_t* sd = sm + (BUF) * (2 * TILE_E) + lrow * LDT + lkc;              \
    *(uint4*)(sd) = RA##_0;                                                 \
    *(uint4*)(sd + 32 * LDT) = RA##_1;                                      \
    *(uint4*)(sd + 64 * LDT) = RA##_2;                                      \
    *(uint4*)(sd + 96 * LDT) = RA##_3;                                      \
    *(uint4*)(sd + TILE_E) = RB##_0;                                        \
    *(uint4*)(sd + TILE_E + 32 * LDT) = RB##_1;                             \
    *(uint4*)(sd + TILE_E + 64 * LDT) = RB##_2;                             \
    *(uint4*)(sd + TILE_E + 96 * LDT) = RB##_3;                             \
  }
#define COMPUTE(BUF)                                                        \
  {                                                                         \
    const bf16_t* sa = sm + (BUF) * (2 * TILE_E) + (wm * 64 + fr) * LDT + fk;           \
    const bf16_t* sb = sm + (BUF) * (2 * TILE_E) + TILE_E + (wn * 64 + fr) * LDT + fk;  \
    _Pragma("unroll") for (int s = 0; s < 2; s++) {                         \
      bf16x8 af[4], bfr[4];                                                 \
      _Pragma("unroll") for (int i = 0; i < 4; i++) {                       \
        af[i] = *(const bf16x8*)(sa + i * 16 * LDT + s * 32);               \
        bfr[i] = *(const bf16x8*)(sb + i * 16 * LDT + s * 32);              \
      }                                                                     \
      _Pragma("unroll") for (int i = 0; i < 4; i++)                         \
        _Pragma("unroll") for (int j = 0; j < 4; j++) acc[i][j] = mfma16(af[i], bfr[j], acc[i][j]);  \
    }                                                                       \
  }
  __syncthreads();
  GLOAD(ra0, rb0, 0)
  GLOAD(ra1, rb1, 64)
  SSTORE(ra0, rb0, 0)
  __syncthreads();
  for (int kt = 0; kt < nk - 2; kt += 2) {
    GLOAD(ra0, rb0, (kt + 2) << 6)
    COMPUTE(0)
    SSTORE(ra1, rb1, 1)
    __syncthreads();
    GLOAD(ra1, rb1, (kt + 3) << 6)
    COMPUTE(1)
    SSTORE(ra0, rb0, 0)
    __syncthreads();
  }
  COMPUTE(0)
  SSTORE(ra1, rb1, 1)
  __syncthreads();
  COMPUTE(1)
  __syncthreads();
#undef GLOAD
#undef SSTORE
#undef COMPUTE
}
DI void zero_acc(f32x4 (&acc)[4][4]) {
#pragma unroll
  for (int i = 0; i < 4; i++)
#pragma unroll
    for (int j = 0; j < 4; j++) acc[i][j] = (f32x4){0.f, 0.f, 0.f, 0.f};
}


DI void gemm_kloop64(const bf16_t* __restrict__ A, int lda, const bf16_t* __restrict__ B, int ldb, int K, bf16_t* sm,
                     f32x4 (&acc)[2][4]) {
  const int tid = otid(), lane = tid & 63, wave = tid >> 6;
  const int lrow = tid >> 3, lkc = (tid & 7) * 8;
  const unsigned toa = (unsigned)(lrow * lda + lkc), tob = (unsigned)(lrow * ldb + lkc);
  uint4 ra0_0, ra0_1, ra0_2, ra0_3, rb0_0, rb0_1, ra1_0, ra1_1, ra1_2, ra1_3, rb1_0, rb1_1;
  const int fr = lane & 15, fk = (lane >> 4) * 8;
  const int nk = K >> 6;
#define GLOAD(RA, RB, K0)                                                   \
  {                                                                         \
    RA##_0 = *(const uint4*)((A + (size_t)(K0)) + toa);                     \
    RA##_1 = *(const uint4*)((A + (size_t)(32 * lda + (K0))) + toa);        \
    RA##_2 = *(const uint4*)((A + (size_t)(64 * lda + (K0))) + toa);        \
    RA##_3 = *(const uint4*)((A + (size_t)(96 * lda + (K0))) + toa);        \
    RB##_0 = *(const uint4*)((B + (size_t)(K0)) + tob);                     \
    RB##_1 = *(const uint4*)((B + (size_t)(32 * ldb + (K0))) + tob);        \
  }
#define SSTORE(RA, RB, BUF)                                                 \
  {                                                                         \
    bf16_t* sd = sm + (BUF) * (2 * TILE_E) + lrow * LDT + lkc;              \
    *(uint4*)(sd) = RA##_0;                                                 \
    *(uint4*)(sd + 32 * LDT) = RA##_1;                                      \
    *(uint4*)(sd + 64 * LDT) = RA##_2;                                      \
    *(uint4*)(sd + 96 * LDT) = RA##_3;                                      \
    *(uint4*)(sd + TILE_E) = RB##_0;                                        \
    *(uint4*)(sd + TILE_E + 32 * LDT) = RB##_1;                             \
  }
#define COMPUTE(BUF)                                                                            \
  {                                                                                             \
    const bf16_t* sa = sm + (BUF) * (2 * TILE_E) + (wave * 32 + fr) * LDT + fk;                 \
    const bf16_t* sb = sm + (BUF) * (2 * TILE_E) + TILE_E + fr * LDT + fk;                      \
    _Pragma("unroll") for (int s = 0; s < 2; s++) {                                             \
      bf16x8 af[2], bfr[4];                                                                     \
      _Pragma("unroll") for (int i = 0; i < 2; i++) af[i] = *(const bf16x8*)(sa + i * 16 * LDT + s * 32);   \
      _Pragma("unroll") for (int j = 0; j < 4; j++) bfr[j] = *(const bf16x8*)(sb + j * 16 * LDT + s * 32);  \
      _Pragma("unroll") for (int i = 0; i < 2; i++)                                             \
        _Pragma("unroll") for (int j = 0; j < 4; j++) acc[i][j] = mfma16(af[i], bfr[j], acc[i][j]);         \
    }                                                                                           \
  }
  __syncthreads();
  GLOAD(ra0, rb0, 0)
  GLOAD(ra1, rb1, 64)
  SSTORE(ra0, rb0, 0)
  __syncthreads();
  for (int kt = 0; kt < nk - 2; kt += 2) {
    GLOAD(ra0, rb0, (kt + 2) << 6)
    COMPUTE(0)
    SSTORE(ra1, rb1, 1)
    __syncthreads();
    GLOAD(ra1, rb1, (kt + 3) << 6)
    COMPUTE(1)
    SSTORE(ra0, rb0, 0)
    __syncthreads();
  }
  COMPUTE(0)
  SSTORE(ra1, rb1, 1)
  __syncthreads();
  COMPUTE(1)
  __syncthreads();
#undef GLOAD
#undef SSTORE
#undef COMPUTE
}

DI bool xcd_tile(int e, int NNT, int& mt, int& nt) {
  const int xcd = blockIdx.x & 7;
  const int per_mb = 9 * NNT;
  if (e >= 2 * per_mb) return false;
  const int mb = e >= per_mb ? 1 : 0;
  int r = e - mb * per_mb;
  const int full = NNT >> 3, rem = NNT & 7;
  int nb = r / 72;
  int w = 8;
  if (nb >= full) { nb = full; w = rem; }
  r -= nb * 72;
  const int mi = r / w, ni = r - mi * w;
  mt = xcd * 18 + mb * 9 + mi;
  nt = nb * 8 + ni;
  return true;
}

struct TokInfo { int isP, b, t, pos; };
DI TokInfo tokinfo(int tok) {
  TokInfo ti;
  if (tok < TP) { ti.isP = 1; ti.b = tok >> 13; ti.t = tok & 8191; ti.pos = ti.t; }
  else { int s = tok - TP; ti.isP = 0; ti.b = s >> 6; ti.t = s & 63; ti.pos = 2048 + ti.t; }
  return ti;
}

DI void gemm1_phase(const Params& p, int l, char* smem) {
  bf16_t* sm = (bf16_t*)smem;
  const int tid = otid(), lane = tid & 63, wave = tid >> 6;
  const int wm = wave >> 1, wn = wave & 1, g4 = lane >> 4, cl = lane & 15;
  const int NT1 = 144 * 26;
  const int slots = gridDim.x >> 3, slot = blockIdx.x >> 3;
  const int nmain = 18 * 26;
  const int nextra = (l == 0 ? 8 : 0);
  for (int e = slot; e < nmain + nextra; e += slots) {
    f32x4 acc[4][4];
    zero_acc(acc);
    int mt = 0, nt = 0;
    const bool is_main = xcd_tile(e, 26, mt, nt);
    const int t = is_main ? 0 : NT1 + (e - nmain) * 8 + (blockIdx.x & 7);
    if (is_main) {
      gemm_kloop(p.hb + (size_t)mt * 128 * DM, DM, p.Wt1 + ((size_t)l * N1 + nt * 128) * DM, DM, DM, sm, acc);
      const int nb = nt * 128 + wn * 64;
#pragma unroll
      for (int i = 0; i < 4; i++) {
        float2 csv[4][2];
        if (nb < 1088 && !(nb >= 640 && nb < 768)) {
#pragma unroll
          for (int r = 0; r < 4; r++) {
            const TokInfo tj = tokinfo(mt * 128 + wm * 64 + i * 16 + g4 * 4 + r);
#pragma unroll
            for (int jn = 0; jn < 2; jn++) csv[r][jn] = *(const float2*)(p.rope + (size_t)(tj.pos * 32 + jn * 16 + cl) * 2);
          }
        }
#pragma unroll
        for (int r = 0; r < 4; r++) {
          const int tok = mt * 128 + wm * 64 + i * 16 + g4 * 4 + r;
          const TokInfo ti = tokinfo(tok);
          if (nb < 1088) {
            if (nb >= 640 && nb < 768) {
              float* dst = ti.isP ? p.out + O_VP + ((size_t)(l * 2 + ti.b) * 8192 + ti.t) * 128
                                  : p.out + O_VS + ((size_t)(l * 32 + ti.b) * 64 + ti.t) * 128;
              bf16_t* dvb = p.VB + (size_t)(ti.isP ? ti.b * 8192 + ti.t : 16384 + ti.b * 2112 + 2048 + ti.t) * 128;
#pragma unroll
              for (int jn = 0; jn < 4; jn++) {
                dst[nb - 640 + jn * 16 + cl] = acc[i][jn][r];
                dvb[nb - 640 + jn * 16 + cl] = f2bf(acc[i][jn][r]);
              }
            } else {
#pragma unroll
              for (int jn = 0; jn < 2; jn++) {
                const int d = jn * 16 + cl;
                const float2 cs = csv[r][jn];
                const float x1 = acc[i][jn][r], x2 = acc[i][jn + 2][r];
                const float y1 = x1 * cs.x - x2 * cs.y, y2 = x1 * cs.y + x2 * cs.x;
                const int c1 = nb + d, c2 = nb + d + 32;
                if (nb < 512) {
                  p.qa[(size_t)tok * 512 + c1] = f2bf(y1 * 0.125f);
                  p.qa[(size_t)tok * 512 + c2] = f2bf(y2 * 0.125f);
                } else if (nb < 640) {
                  float* dst = ti.isP ? p.out + O_KP + ((size_t)(l * 2 + ti.b) * 8192 + ti.t) * 128
                                      : p.out + O_KS + ((size_t)(l * 32 + ti.b) * 64 + ti.t) * 128;
                  dst[c1 - 512] = y1;
                  dst[c2 - 512] = y2;
                  bf16_t* dkb = p.KB + (size_t)(ti.isP ? ti.b * 8192 + ti.t : 16384 + ti.b * 2112 + 2048 + ti.t) * 128;
                  dkb[c1 - 512] = f2bf(y1);
                  dkb[c2 - 512] = f2bf(y2);
                } else if (nb < 1024) {
                  p.qi[(size_t)tok * 256 + c1 - 768] = f2bf(y1 * 0.125f);
                  p.qi[(size_t)tok * 256 + c2 - 768] = f2bf(y2 * 0.125f);
                } else {
                  float* dst = ti.isP ? p.out + O_KIP + ((size_t)(l * 2 + ti.b) * 8192 + ti.t) * 64
                                      : p.out + O_KIS + ((size_t)(l * 32 + ti.b) * 64 + ti.t) * 64;
                  dst[c1 - 1024] = y1;
                  dst[c2 - 1024] = y2;
                  bf16_t* dib = p.KIB + (size_t)(ti.isP ? ti.b * 8192 + ti.t : 16384 + ti.b * 2112 + 2048 + ti.t) * 64;
                  dib[c1 - 1024] = f2bf(y1);
                  dib[c2 - 1024] = f2bf(y2);
                }
              }
            }
          } else if (nb == 1088) {
            if (cl < 4) p.wi[(size_t)tok * 4 + cl] = acc[i][0][r] * 0.5f;
          } else if (nb < 2816) {
            const int T = ti.isP ? 8192 : 64;
#pragma unroll
            for (int jn = 0; jn < 4; jn++) {
              const int c = nb - 1152 + jn * 16 + cl;
              const float v = acc[i][jn][r];
              p.R[(size_t)tok * RS + c] = v;
              if (ti.t == T - 1) {
                float* dst = ti.isP ? p.out + O_SHP + (size_t)(l * 2 + ti.b) * DSH : p.out + O_SHS + (size_t)(l * 32 + ti.b) * DSH;
                dst[c] = v;
              }
              if ((tok & 15) == 15) p.bnd[(size_t)(tok >> 4) * DSH + c] = v;
            }
          } else {
#pragma unroll
            for (int jn = 0; jn < 4; jn++)
              p.qm[(size_t)tok * 512 + nb - 2816 + jn * 16 + cl] = f2bf(acc[i][jn][r] * 0.08838834764831845f);
          }
        }
      }
    } else {
      const int u = t - NT1;
      const int lm = u >> 5, mt = (u >> 3) & 3, nt = u & 7;
      gemm_kloop(p.memn + ((size_t)lm * 512 + mt * 128) * DM, DM, p.Wmem + ((size_t)lm * DM + nt * 128) * DM, DM, DM, sm, acc);
#pragma unroll
      for (int i = 0; i < 4; i++)
#pragma unroll
        for (int r = 0; r < 4; r++) {
          const int row = mt * 128 + wm * 64 + i * 16 + g4 * 4 + r;
          const int bm = row >> 8, m = row & 255;
#pragma unroll
          for (int jn = 0; jn < 4; jn++) {
            const int n = nt * 128 + wn * 64 + jn * 16 + cl;
            const float v = acc[i][jn][r];
            if (n < 512) {
              p.out[O_MKP + ((size_t)(lm * 2 + bm) * 256 + m) * 512 + n] = v;
            } else {
              const int n2 = n - 512;
              p.out[O_MVP + ((size_t)(lm * 2 + bm) * 256 + m) * 512 + n2] = v;
              p.pmvT[((size_t)((lm * 2 + bm) * 4 + (n2 >> 7)) * 128 + (n2 & 127)) * 256 + m] = f2bf(v);
            }
          }
        }
    }
  }
}

DI void prep_phase(const Params& p, int l, char* smem, const bool dry = false) {
  float* rows = (float*)smem;
  float* tw = rows + 9 * DSH;
  float* ta = tw + 512;
  const int tid = otid(), lane = tid & 63, wave = tid >> 6;
  const float* mu = p.mu_shift + l * DSH;
  const float* w2 = p.w2 + (size_t)l * 64 * 512;
  const float* a2 = p.a2 + (size_t)l * 64 * 512;
  for (int task = blockIdx.x; task < TOK / 16; task += gridDim.x) {
    const int tok0 = task * 16;
    const TokInfo t0 = tokinfo(tok0);
    __syncthreads();
    for (int c = tid; c < DSH; c += 256) {
      float pv;
      if (t0.t == 0) pv = t0.isP ? 0.f : p.state_shift[(size_t)(l * 32 + t0.b) * DSH + c];
      else pv = p.bnd[(size_t)(task - 1) * DSH + c];
      rows[c] = pv;
    }
    for (int batch = 0; batch < 2; batch++) {
      const int tb = tok0 + batch * 8;
      __syncthreads();
      for (int f = tid; f < 8 * 416; f += 256) {
        int tk = f / 416, c4 = f - tk * 416;
        *(float4*)(rows + (tk + 1) * DSH + c4 * 4) = *(const float4*)(p.R + (size_t)(tb + tk) * RS + c4 * 4);
      }
      __syncthreads();
      for (int idx = tid; idx < 1024; idx += 256) {
        int tk = idx >> 7, ii = idx & 127;
        int col = 1536 + ii;
        float cur = rows[(tk + 1) * DSH + col], prv = rows[tk * DSH + col];
        float m = cur + (prv - cur) * mu[col];
        if (ii < 64) tw[tk * 64 + ii] = 1.f - 2.f * __builtin_amdgcn_rcpf(1.f + __expf(2.f * m));
        else ta[tk * 64 + ii - 64] = m;
      }
      __syncthreads();
      float accw[2][8], acca[2][8];
#pragma unroll
      for (int ch = 0; ch < 2; ch++) {
        const int c = tid + 256 * ch;
        const float bw = p.w0[l * 512 + c], ba = p.a0[l * 512 + c];
#pragma unroll
        for (int tk = 0; tk < 8; tk++) { accw[ch][tk] = bw; acca[ch][tk] = ba; }
      }
      for (int i4 = 0; i4 < 16; i4++) {
        float4 twv[8], tav[8];
#pragma unroll
        for (int tk = 0; tk < 8; tk++) {
          twv[tk] = *(const float4*)(tw + tk * 64 + i4 * 4);
          tav[tk] = *(const float4*)(ta + tk * 64 + i4 * 4);
        }
#pragma unroll
        for (int ii = 0; ii < 4; ii++) {
          const int i = i4 * 4 + ii;
#pragma unroll
          for (int ch = 0; ch < 2; ch++) {
            const int c = tid + 256 * ch;
            const float wv = w2[i * 512 + c], av = a2[i * 512 + c];
#pragma unroll
            for (int tk = 0; tk < 8; tk++) {
              const float x = ii == 0 ? twv[tk].x : ii == 1 ? twv[tk].y : ii == 2 ? twv[tk].z : twv[tk].w;
              const float y = ii == 0 ? tav[tk].x : ii == 1 ? tav[tk].y : ii == 2 ? tav[tk].z : tav[tk].w;
              accw[ch][tk] += x * wv;
              acca[ch][tk] += y * av;
            }
          }
        }
      }
#pragma unroll
      for (int ch = 0; ch < 2; ch++) {
        const int c = tid + 256 * ch;
        const int head = wave + 4 * ch;
        const float muR = mu[c], muK = mu[512 + c], muV = mu[1024 + c];
        const float kkc = p.k_k[l * 512 + c], kac = p.k_a[l * 512 + c], rkc = p.r_k[l * 512 + c];
#pragma unroll
        for (int tk = 0; tk < 8; tk++) {
          const float* rc = rows + (tk + 1) * DSH;
          const float* rp = rows + tk * DSH;
          const float r = rc[c] + (rp[c] - rc[c]) * muR;
          const float k = rc[512 + c] + (rp[512 + c] - rc[512 + c]) * muK;
          const float v = rc[1024 + c] + (rp[1024 + c] - rc[1024 + c]) * muV;
          const float xw = -accw[ch][tk];
          const float sp = fmaxf(xw, 0.f) + __logf(1.f + __expf(-fabsf(xw)));
          const float w = -sp - 0.5f;
          const float decay = __expf(-__expf(w));
          const float ag = __builtin_amdgcn_rcpf(1.f + __expf(-acca[ch][tk]));
          const float kkr = k * kkc;
          const float ss = wave_sum(kkr * kkr);
          const float kk = kkr * fminf(__builtin_amdgcn_rsqf(ss), 1e12f);
          const float kp = k * (1.f + (ag - 1.f) * kac);
          const float bon = wave_sum(r * kp * rkc);
          float* Rrow = p.R + (size_t)(tb + tk) * RS;
          bf16_t* Rb = (bf16_t*)(Rrow + 512);
          if (!dry) {
            Rrow[c] = decay;
            Rb[c] = f2bf(r);
            Rb[512 + c] = f2bf(kp);
            Rb[1024 + c] = f2bf(v);
            Rb[1536 + c] = f2bf(-kk);
            Rb[2048 + c] = f2bf(kk * ag);
            if (lane == 0) p.bonus[(size_t)(tb + tk) * 8 + head] = bon;
          } else if (decay + r + kp + v + kk + bon == 1.2345e30f) p.wi[0] = 1.f;
        }
      }
      __syncthreads();
      for (int c = tid; c < DSH; c += 256) rows[c] = rows[8 * DSH + c];
    }
  }
}

DI void scan_task(const Params& p, int l, int isP, int b, int h, int rg, char* smem, const bool dry) {
  constexpr int BUFB = 24576 + 8192 + 2048;
  const int tid = otid(), lane = tid & 63, wave = tid >> 6;
  const int g4 = lane >> 4, jq = lane & 15;
  const int T = isP ? 8192 : 64;
  const int tokbase = isP ? b * 8192 : TP + b * 64;
  const int i = rg * 16 + wave * 4 + g4;
  f32x2 Sa = {0.f, 0.f}, Sb = {0.f, 0.f};
  if (!isP) {
    const float4 s = *(const float4*)(p.state_wkv + ((size_t)((l * 32 + b) * 8 + h) * 64 + i) * 64 + jq * 4);
    Sa = (f32x2){s.x, s.y}; Sb = (f32x2){s.z, s.w};
  }
  __builtin_amdgcn_s_setprio(3);
  const int ds = tid >> 4, dj = tid & 15;
  const int lst = (tid >> 3) & 31, lch = tid & 7;
  float4 rd0, rd1;
  uint4 qr, qk, qa, qb, rv;
  const int nch = T >> 5;
  auto gload = [&](int c) {
    const int tk = tokbase + c * 32;
    rd0 = *(const float4*)(p.R + (size_t)(tk + ds) * RS + h * 64 + dj * 4);
    rd1 = *(const float4*)(p.R + (size_t)(tk + 16 + ds) * RS + h * 64 + dj * 4);
    const bf16_t* rb = (const bf16_t*)(p.R + (size_t)(tk + lst) * RS + 512) + h * 64 + lch * 8;
    qr = *(const uint4*)(rb);
    qk = *(const uint4*)(rb + 512);
    qa = *(const uint4*)(rb + 1536);
    qb = *(const uint4*)(rb + 2048);
    if (tid < 64) {
      const int s = tid >> 1, half = tid & 1;
      rv = *(const uint4*)((const bf16_t*)(p.R + (size_t)(tk + s) * RS + 512) + 1024 + h * 64 + rg * 16 + half * 8);
    }
  };
#define CVT8(Q, LO, HI)                                                                            \
  float4 LO, HI;                                                                                   \
  LO.x = __uint_as_float((Q).x << 16); LO.y = __uint_as_float((Q).x & 0xFFFF0000u);                \
  LO.z = __uint_as_float((Q).y << 16); LO.w = __uint_as_float((Q).y & 0xFFFF0000u);                \
  HI.x = __uint_as_float((Q).z << 16); HI.y = __uint_as_float((Q).z & 0xFFFF0000u);                \
  HI.z = __uint_as_float((Q).w << 16); HI.w = __uint_as_float((Q).w & 0xFFFF0000u);
  auto sstore = [&](int bi) {
    char* bb = smem + bi * BUFB;
    *(float4*)(bb + (ds * 64 + dj * 4) * 4) = rd0;
    *(float4*)(bb + ((16 + ds) * 64 + dj * 4) * 4) = rd1;
    {
      CVT8(qa, alo, ahi)
      float* d = (float*)(bb + 8192) + lst * 64 + lch * 8;
      *(float4*)d = alo; *(float4*)(d + 4) = ahi;
    }
    {
      CVT8(qb, blo, bhi)
      float* d = (float*)(bb + 16384) + lst * 64 + lch * 8;
      *(float4*)d = blo; *(float4*)(d + 4) = bhi;
    }
    *(uint4*)(bb + 24576 + (lst * 64 + lch * 8) * 2) = qr;
    *(uint4*)(bb + 28672 + (lst * 64 + lch * 8) * 2) = qk;
    if (tid < 64) {
      const int s = tid >> 1, half = tid & 1;
      CVT8(rv, vlo, vhi)
      float* d = (float*)(bb + 32768) + s * 16 + half * 8;
      *(float4*)d = vlo; *(float4*)(d + 4) = vhi;
    }
  };
#undef CVT8
  __syncthreads();
  gload(0);
  sstore(0);
  __syncthreads();
  for (int c = 0; c < nch; c++) {
    const bool more = c + 1 < nch;
    if (more) gload(c + 1);
    const char* bb = smem + (c & 1) * BUFB;
    const float* fw = (const float*)bb + jq * 4;
    const float* fa = (const float*)(bb + 8192) + jq * 4;
    const float* fb = (const float*)(bb + 16384) + jq * 4;
    const char* pr = bb + 24576 + jq * 8;
    const char* pk = bb + 28672 + jq * 8;
    const float* vb = (const float*)(bb + 32768) + wave * 4 + g4;
    float* yo = p.yscan + (size_t)(tokbase + c * 32 + jq) * 512 + h * 64 + i;
    float ykeep0 = 0.f, ykeep1 = 0.f, yprev = 0.f;
    f32x4 w4 = *(const f32x4*)fw, a4 = *(const f32x4*)fa, b4 = *(const f32x4*)fb;
    uint2 ur = *(const uint2*)pr, uk = *(const uint2*)pk;
    float v = vb[0];
#pragma unroll
    for (int s = 0; s < 32; s++) {
      f32x4 w4n = w4, a4n = a4, b4n = b4;
      uint2 urn = ur, ukn = uk;
      float vn = v;
      if (s < 31) {
        w4n = *(const f32x4*)(fw + (s + 1) * 64);
        a4n = *(const f32x4*)(fa + (s + 1) * 64);
        b4n = *(const f32x4*)(fb + (s + 1) * 64);
        urn = *(const uint2*)(pr + (s + 1) * 128);
        ukn = *(const uint2*)(pk + (s + 1) * 128);
        vn = vb[(s + 1) * 16];
      }
      __builtin_amdgcn_sched_barrier(0);
      const f32x2 klo = {__uint_as_float(uk.x << 16), __uint_as_float(uk.x & 0xFFFF0000u)};
      const f32x2 khi = {__uint_as_float(uk.y << 16), __uint_as_float(uk.y & 0xFFFF0000u)};
      const f32x2 rlo = {__uint_as_float(ur.x << 16), __uint_as_float(ur.x & 0xFFFF0000u)};
      const f32x2 rhi = {__uint_as_float(ur.y << 16), __uint_as_float(ur.y & 0xFFFF0000u)};
      const f32x2 vv = {v, v};
      const f32x2 t = Sa * a4.lo + Sb * a4.hi;
      const f32x2 na = Sa * w4.lo + vv * klo;
      const f32x2 nb = Sb * w4.hi + vv * khi;
      float sa = t.x + t.y;
      float yp = yprev;
      rowsum16x2(sa, yp);
      if (s >= 1 && s <= 16) ykeep0 = (jq == s - 1) ? yp : ykeep0;
      if (s >= 17) ykeep1 = (jq == s - 17) ? yp : ykeep1;
      const f32x2 sv = {sa, sa};
      Sa = na + sv * b4.lo;
      Sb = nb + sv * b4.hi;
      const f32x2 yy = Sa * rlo + Sb * rhi;
      yprev = yy.x + yy.y;
      w4 = w4n; a4 = a4n; b4 = b4n; ur = urn; uk = ukn; v = vn;
    }
    {
      const float yl = rowsum16(yprev);
      ykeep1 = (jq == 15) ? yl : ykeep1;
    }
    if (!dry) { yo[0] = ykeep0; yo[(size_t)16 * 512] = ykeep1; }
    if (more) sstore((c + 1) & 1);
    __syncthreads();
  }
  float* so = isP ? p.out + O_WKVP + ((size_t)((l * 2 + b) * 8 + h) * 64 + i) * 64 + jq * 4
                  : p.out + O_WKVS + ((size_t)((l * 32 + b) * 8 + h) * 64 + i) * 64 + jq * 4;
  if (!dry) *(float4*)so = make_float4(Sa.x, Sa.y, Sb.x, Sb.y);
  __builtin_amdgcn_s_setprio(0);
}

DI void mem_task(const Params& p, int l, int tok0, char* smem, const bool dry) {
  bf16_t* st = (bf16_t*)smem;
  const int tid = otid(), lane = tid & 63, wave = tid >> 6;
  const int g4 = lane >> 4, cl = lane & 15;
  const TokInfo ti = tokinfo(tok0);
  const float* Kb = ti.isP ? p.out + O_MKP + (size_t)(l * 2 + ti.b) * 256 * 512
                           : p.cache_mem_k + (size_t)(l * 32 + ti.b) * 256 * 512;
  const bf16_t* Vb = ti.isP ? p.pmvT + (size_t)(l * 2 + ti.b) * 4 * 128 * 256
                            : p.cmvT + (size_t)(l * 32 + ti.b) * 4 * 128 * 256;
  const int q0 = tok0 + wave * 16;
  for (int h = 0; h < 4; h++) {
    bf16x8 qf[4];
#pragma unroll
    for (int ks = 0; ks < 4; ks++) qf[ks] = *(const bf16x8*)(p.qm + (size_t)(q0 + cl) * 512 + h * 128 + ks * 32 + g4 * 8);
    __syncthreads();
    {
      const float* kp = Kb + (size_t)(tid >> 5) * 512 + h * 128 + (tid & 31) * 4;
      bf16_t* sp = st + (tid >> 5) * 136 + (tid & 31) * 4;
#pragma unroll 1
      for (int hb2 = 0; hb2 < 4; hb2++) {
        float4 kv[8];
#pragma unroll
        for (int u = 0; u < 8; u++) kv[u] = *(const float4*)(kp + (size_t)u * 8 * 512);
#pragma unroll
        for (int u = 0; u < 8; u++) {
          uint2 w;
          w.x = pack2(kv[u].x, kv[u].y);
          w.y = pack2(kv[u].z, kv[u].w);
          *(uint2*)(sp + u * 8 * 136) = w;
        }
        kp += 64 * 512;
        sp += 64 * 136;
      }
    }
    __syncthreads();
    f32x4 S[16];
#pragma unroll
    for (int mt = 0; mt < 16; mt++) {
      f32x4 a = (f32x4){0.f, 0.f, 0.f, 0.f};
      const bf16_t* kr = st + (mt * 16 + cl) * 136 + g4 * 8;
#pragma unroll
      for (int ks = 0; ks < 4; ks++) a = mfma16(*(const bf16x8*)(kr + ks * 32), qf[ks], a);
      S[mt] = a;
      if ((mt & 1) == 1) __builtin_amdgcn_sched_barrier(0);
    }
    float m = -1e30f;
#pragma unroll
    for (int mt = 0; mt < 16; mt++)
#pragma unroll
      for (int r = 0; r < 4; r++) m = fmaxf(m, S[mt][r]);
    m = fmaxf(m, __shfl_xor(m, 16));
    m = fmaxf(m, __shfl_xor(m, 32));
    float sum = 0.f;
#pragma unroll
    for (int mt = 0; mt < 16; mt++)
#pragma unroll
      for (int r = 0; r < 4; r++) {
        const float e = __expf(S[mt][r] - m);
        S[mt][r] = e;
        sum += e;
      }
    sum += __shfl_xor(sum, 16);
    sum += __shfl_xor(sum, 32);
    const float inv = __builtin_amdgcn_rcpf(sum);
    __syncthreads();
    {
      const bf16_t* vp = Vb + (size_t)h * 128 * 256 + (size_t)(tid >> 5) * 256 + (tid & 31) * 8;
      bf16_t* sp = st + (tid >> 5) * 264 + (tid & 31) * 8;
#pragma unroll 1
      for (int hb2 = 0; hb2 < 2; hb2++) {
        uint4 vv[8];
#pragma unroll
        for (int u = 0; u < 8; u++) vv[u] = *(const uint4*)(vp + (size_t)u * 8 * 256);
#pragma unroll
        for (int u = 0; u < 8; u++) *(uint4*)(sp + u * 8 * 264) = vv[u];
        vp += 64 * 256;
        sp += 64 * 264;
      }
    }
    __syncthreads();
    f32x4 o[8];
#pragma unroll
    for (int dt = 0; dt < 8; dt++) o[dt] = (f32x4){0.f, 0.f, 0.f, 0.f};
#pragma unroll
    for (int kk = 0; kk < 8; kk++) {
      union { bf16x8 v; unsigned u[4]; } pf;
      pf.u[0] = pack2(S[2 * kk][0], S[2 * kk][1]);
      pf.u[1] = pack2(S[2 * kk][2], S[2 * kk][3]);
      pf.u[2] = pack2(S[2 * kk + 1][0], S[2 * kk + 1][1]);
      pf.u[3] = pack2(S[2 * kk + 1][2], S[2 * kk + 1][3]);
#pragma unroll
      for (int dt = 0; dt < 8; dt++) {
        const bf16_t* vr = st + (dt * 16 + cl) * 264 + (2 * kk) * 16 + g4 * 4;
        union { bf16x8 v; uint2 u[2]; } vf;
        vf.u[0] = *(const uint2*)vr;
        vf.u[1] = *(const uint2*)(vr + 16);
        o[dt] = mfma16(vf.v, pf.v, o[dt]);
      }
      __builtin_amdgcn_sched_barrier(0);
    }
#pragma unroll
    for (int dt = 0; dt < 8; dt++) {
      uint2 stv;
      stv.x = pack2(o[dt][0] * inv, o[dt][1] * inv);
      stv.y = pack2(o[dt][2] * inv, o[dt][3] * inv);
      if (!dry) *(uint2*)(p.qm + (size_t)(q0 + cl) * 512 + h * 128 + dt * 16 + g4 * 4) = stv;
    }
  }
}

DI unsigned mono_key(float f) {
  const int u = __float_as_int(f + 0.0f);
  return (unsigned)u ^ ((unsigned)(u >> 31) | 0x80000000u);
}
DI float relu_(float x) { return __builtin_amdgcn_fmed3f(x, 0.f, __builtin_inff()); }

DI void dsa_task(const Params& p, int l, int isP, int b, int tq, char* smem, const bool dry) {
  unsigned* hist = (unsigned*)smem;
  unsigned short* idxl = (unsigned short*)(smem + 16384);
  unsigned short* tiel = (unsigned short*)smem;
  bf16_t* kst = (bf16_t*)(smem + 24576);
  float* pl = (float*)(smem + 24576);
  float* op = (float*)(smem + 32768);
  float* ml = (float*)(smem + 40960);
  unsigned* cnt = (unsigned*)(smem + 61440);
  unsigned* res = (unsigned*)(smem + 61504);
  unsigned* ccnt = (unsigned*)(smem + 61632);
  unsigned* ovf = (unsigned*)(smem + 61696);
  unsigned* ckey = (unsigned*)(smem + 61952);
  unsigned* cidx = (unsigned*)(smem + 66048);
  const int tid = otid(), lane = tid & 63, wave = tid >> 6;
  const int g4 = lane >> 4, cl = lane & 15;
  const int tokq0 = (isP ? b * 8192 : TP + b * 64) + tq;
  const int S = isP ? ((tq >> 6) + 1) * 64 : 2112;
  const size_t seqbase = isP ? (size_t)b * 8192 : (size_t)16384 + (size_t)b * 2112;
  const bf16_t* KIs = p.KIB + seqbase * 64;
  const bf16_t* Ks = p.KB + seqbase * 128;
  const bf16_t* Vs = p.VB + seqbase * 128;
  const int nsel = S < 256 ? S : 256;
  __syncthreads();
  if (S <= 256) {
    for (int e = tid; e < 16 * 256; e += 256) idxl[e] = (unsigned short)(e & 255);
  } else {
    const int qloc = wave * 4 + g4;
    bf16x8 aq0, aq1;
    {
      const bf16_t* qp = p.qi + ((size_t)(tokq0 + wave * 4) * 4 + cl) * 64 + g4 * 8;
      aq0 = *(const bf16x8*)qp;
      aq1 = *(const bf16x8*)(qp + 32);
    }
    const float4 wq = *(const float4*)(p.wi + (size_t)(tokq0 + qloc) * 4);
    unsigned prefix = 0u, need = 256u;
    const int nchunks = (S + 255) >> 8;
    const int skey = tid >> 3, sc8 = (tid & 7) * 8;
    for (int pass = 0; pass < 6; pass++) {
      const int kind = (pass == 2) ? 1 : (pass == 5) ? 2 : 0;
      const int shift = pass == 0 ? 24 : pass == 1 ? 16 : pass == 3 ? 8 : 0;
      if (kind == 0) {
        for (int e = tid; e < 1024; e += 256) ((uint4*)hist)[e] = make_uint4(0, 0, 0, 0);
      } else {
        if (tid < 16) { cnt[tid] = 0u; ccnt[tid] = 0u; }
        if (tid == 16) *ovf = 0u;
      }
      unsigned tiecnt = 0u;
      const unsigned G = 256u - need;
      uint4 rg0, rg1, rg2, rg3, rg4, rg5, rg6, rg7;
#define KLOAD(KC)                                                                            \
  {                                                                                          \
    const bf16_t* src = KIs + (size_t)((KC) * 256 + skey) * 64 + sc8;                        \
    const int kb0 = (KC) * 256 + skey;                                                       \
    if (kb0 < S) rg0 = *(const uint4*)(src);                                                 \
    if (kb0 + 32 < S) rg1 = *(const uint4*)(src + 32 * 64);                                  \
    if (kb0 + 64 < S) rg2 = *(const uint4*)(src + 64 * 64);                                  \
    if (kb0 + 96 < S) rg3 = *(const uint4*)(src + 96 * 64);                                  \
    if (kb0 + 128 < S) rg4 = *(const uint4*)(src + 128 * 64);                                \
    if (kb0 + 160 < S) rg5 = *(const uint4*)(src + 160 * 64);                                \
    if (kb0 + 192 < S) rg6 = *(const uint4*)(src + 192 * 64);                                \
    if (kb0 + 224 < S) rg7 = *(const uint4*)(src + 224 * 64);                                \
  }
      rg0 = rg1 = rg2 = rg3 = rg4 = rg5 = rg6 = rg7 = make_uint4(0, 0, 0, 0);
      KLOAD(0)
      for (int kc = 0; kc < nchunks; kc++) {
        __syncthreads();
        {
          bf16_t* d = kst + skey * 72 + sc8;
          *(uint4*)(d) = rg0;
          *(uint4*)(d + 32 * 72) = rg1;
          *(uint4*)(d + 64 * 72) = rg2;
          *(uint4*)(d + 96 * 72) = rg3;
          *(uint4*)(d + 128 * 72) = rg4;
          *(uint4*)(d + 160 * 72) = rg5;
          *(uint4*)(d + 192 * 72) = rg6;
          *(uint4*)(d + 224 * 72) = rg7;
        }
        __syncthreads();
        if (kc + 1 < nchunks) KLOAD(kc + 1)
        const int ngrp = (S - kc * 256) >= 256 ? 4 : ((S - kc * 256) >> 6);
        for (int tg = 0; tg < ngrp; tg++) {
          unsigned keys[4];
#pragma unroll
          for (int tt = 0; tt < 4; tt++) {
            const bf16_t* br = kst + ((tg * 4 + tt) * 16 + cl) * 72 + g4 * 8;
            const bf16x8 b0 = *(const bf16x8*)br;
            const bf16x8 b1 = *(const bf16x8*)(br + 32);
            f32x4 a = (f32x4){0.f, 0.f, 0.f, 0.f};
            a = mfma16(aq0, b0, a);
            a = mfma16(aq1, b1, a);
            const float score = wq.x * relu_(a[0]) + wq.y * relu_(a[1]) + wq.z * relu_(a[2]) + wq.w * relu_(a[3]);
            keys[tt] = mono_key(score);
          }
#pragma unroll
          for (int tt = 0; tt < 4; tt++) {
            const unsigned key = keys[tt];
            const int kidx = kc * 256 + (tg * 4 + tt) * 16 + cl;
            if (kind == 0) {
              const bool match = (pass == 0) || ((key >> (shift + 8)) == prefix);
              if (match) atomicAdd(&hist[qloc * 256 + ((key >> shift) & 255u)], 1u);
            } else if (kind == 1) {
              const unsigned hk = key >> 16;
              const bool tz = (hk == prefix) && ((key & 0xFFFFu) == 0u);
              if (hk > prefix) {
                const unsigned slot = atomicAdd(&cnt[qloc], 1u);
                if (slot < 256u) idxl[qloc * 256 + slot] = (unsigned short)kidx;
              } else if (hk == prefix && !tz) {
                const unsigned c = atomicAdd(&ccnt[qloc], 1u);
                if (c < 64u) { ckey[qloc * 64 + c] = key; cidx[qloc * 64 + c] = (unsigned)kidx; }
              }
              const unsigned long long bm = __ballot(tz);
              if (bm != 0ull) {
                const unsigned mg = (unsigned)(bm >> (g4 * 16)) & 0xFFFFu;
                const unsigned rank = tiecnt + __popc(mg & ((1u << cl) - 1u));
                if (tz && rank < need) tiel[qloc * 256 + rank] = (unsigned short)kidx;
                tiecnt += __popc(mg);
              }
            } else {
              if (key > prefix) {
                const unsigned slot = atomicAdd(&cnt[qloc], 1u);
                if (slot < 256u) idxl[qloc * 256 + slot] = (unsigned short)kidx;
              }
              const bool eq = (key == prefix);
              const unsigned long long bm = __ballot(eq);
              if (bm != 0ull) {
                const unsigned mg = (unsigned)(bm >> (g4 * 16)) & 0xFFFFu;
                const unsigned rank = tiecnt + __popc(mg & ((1u << cl) - 1u));
                if (eq && rank < need) idxl[qloc * 256 + G + rank] = (unsigned short)kidx;
                tiecnt += __popc(mg);
              }
            }
          }
        }
      }
#undef KLOAD
      __syncthreads();
      if (kind == 0) {
        const unsigned* hq = hist + qloc * 256;
        const int top = 255 - 16 * cl;
        unsigned sum = 0u;
#pragma unroll
        for (int u = 0; u < 16; u++) sum += hq[top - u];
        unsigned incl = sum;
#pragma unroll
        for (int d = 1; d < 16; d <<= 1) {
          const unsigned t = __shfl_up(incl, d, 16);
          if (cl >= d) incl += t;
        }
        const unsigned excl = incl - sum;
        if (excl < need && incl >= need) {
          unsigned cum = excl;
          int bsel = top - 15;
          unsigned above = excl;
          bool found = false;
#pragma unroll
          for (int u = 0; u < 16; u++) {
            const unsigned c = hq[top - u];
            if (!found && cum + c >= need) { bsel = top - u; above = cum; found = true; }
            cum += c;
          }
          res[qloc * 2] = (unsigned)bsel;
          res[qloc * 2 + 1] = above;
        }
        __syncthreads();
        const unsigned bstar = res[qloc * 2], above = res[qloc * 2 + 1];
        need -= above;
        prefix = (prefix << 8) | bstar;
      } else if (kind == 1) {
        const unsigned c = ccnt[qloc];
        if (c > 64u) {
          if (cl == 0) *ovf = 1u;
        } else {
          for (unsigned i = cl; i < c; i += 16) {
            const unsigned ki = ckey[qloc * 64 + i], ii = cidx[qloc * 64 + i];
            unsigned rank = 0u;
            for (unsigned j = 0; j < c; j++) {
              const unsigned kj = ckey[qloc * 64 + j], ij = cidx[qloc * 64 + j];
              rank += (kj > ki || (kj == ki && ij < ii)) ? 1u : 0u;
            }
            if (rank < need) idxl[qloc * 256 + G + rank] = (unsigned short)ii;
          }
          const unsigned nso = c < need ? c : need;
          for (unsigned t = cl; t < need - nso; t += 16) idxl[qloc * 256 + G + nso + t] = tiel[qloc * 256 + t];
        }
        __syncthreads();
        if (*ovf == 0u) break;
      }
    }
  }
  __syncthreads();
  float* opq = (float*)smem;
  float* mlq = (float*)(smem + 61952);
  char* vst = smem + 24576 + wave * 9216;
  const bool active = wave * 64 < nsel;
  uint4 vq0, vq1, vq2, vq3, vq4, vq5, vq6, vq7, vq8, vq9, vq10, vq11, vq12, vq13, vq14, vq15;
  bf16x8 kf[2][4][2];
  if (active) {
    vq0 = *(const uint4*)(Vs + (size_t)idxl[wave * 64 + 0 + g4] * 128 + cl * 8);
    vq1 = *(const uint4*)(Vs + (size_t)idxl[wave * 64 + 4 + g4] * 128 + cl * 8);
    vq2 = *(const uint4*)(Vs + (size_t)idxl[wave * 64 + 8 + g4] * 128 + cl * 8);
    vq3 = *(const uint4*)(Vs + (size_t)idxl[wave * 64 + 12 + g4] * 128 + cl * 8);
    vq4 = *(const uint4*)(Vs + (size_t)idxl[wave * 64 + 16 + g4] * 128 + cl * 8);
    vq5 = *(const uint4*)(Vs + (size_t)idxl[wave * 64 + 20 + g4] * 128 + cl * 8);
    vq6 = *(const uint4*)(Vs + (size_t)idxl[wave * 64 + 24 + g4] * 128 + cl * 8);
    vq7 = *(const uint4*)(Vs + (size_t)idxl[wave * 64 + 28 + g4] * 128 + cl * 8);
    vq8 = *(const uint4*)(Vs + (size_t)idxl[wave * 64 + 32 + g4] * 128 + cl * 8);
    vq9 = *(const uint4*)(Vs + (size_t)idxl[wave * 64 + 36 + g4] * 128 + cl * 8);
    vq10 = *(const uint4*)(Vs + (size_t)idxl[wave * 64 + 40 + g4] * 128 + cl * 8);
    vq11 = *(const uint4*)(Vs + (size_t)idxl[wave * 64 + 44 + g4] * 128 + cl * 8);
    vq12 = *(const uint4*)(Vs + (size_t)idxl[wave * 64 + 48 + g4] * 128 + cl * 8);
    vq13 = *(const uint4*)(Vs + (size_t)idxl[wave * 64 + 52 + g4] * 128 + cl * 8);
    vq14 = *(const uint4*)(Vs + (size_t)idxl[wave * 64 + 56 + g4] * 128 + cl * 8);
    vq15 = *(const uint4*)(Vs + (size_t)idxl[wave * 64 + 60 + g4] * 128 + cl * 8);
#pragma unroll
    for (int tt = 0; tt < 4; tt++) {
      const int pos = idxl[wave * 64 + tt * 16 + cl];
#pragma unroll
      for (int j = 0; j < 2; j++) {
        const bf16_t* kr = Ks + (size_t)pos * 128 + j * 64 + g4 * 8;
        kf[j][tt][0] = *(const bf16x8*)kr;
        kf[j][tt][1] = *(const bf16x8*)(kr + 32);
      }
    }
  }
  for (int qq = 0; qq < 16; qq++) {
    const int tok = tokq0 + qq;
    const int qn = qq < 15 ? qq + 1 : 15;
    float* opb = opq + (qq & 1) * 2048;
    float* mlb = mlq + (qq & 1) * 64;
    if (active) {
      union PB { bf16x8 v; unsigned u[4]; };
      PB pb[2][2];
#pragma unroll
      for (int j = 0; j < 2; j++) {
        const bf16_t* qp = p.qa + (size_t)tok * 512 + (j * 4 + (cl & 3)) * 64 + g4 * 8;
        const bf16x8 bq0 = *(const bf16x8*)qp;
        const bf16x8 bq1 = *(const bf16x8*)(qp + 32);
        f32x4 lg[4];
#pragma unroll
        for (int tt = 0; tt < 4; tt++) {
          f32x4 a = (f32x4){0.f, 0.f, 0.f, 0.f};
          a = mfma16(kf[j][tt][0], bq0, a);
          a = mfma16(kf[j][tt][1], bq1, a);
          lg[tt] = a;
        }
        float m = -1e30f;
#pragma unroll
        for (int tt = 0; tt < 4; tt++)
#pragma unroll
          for (int r = 0; r < 4; r++) m = fmaxf(m, lg[tt][r]);
        m = fmaxf(m, __shfl_xor(m, 16));
        m = fmaxf(m, __shfl_xor(m, 32));
        float sum = 0.f;
#pragma unroll
        for (int tt = 0; tt < 4; tt++)
#pragma unroll
          for (int r = 0; r < 4; r++) {
            const float e = __expf(lg[tt][r] - m);
            lg[tt][r] = e;
            sum += e;
          }
        sum += __shfl_xor(sum, 16);
        sum += __shfl_xor(sum, 32);
#pragma unroll
        for (int sI = 0; sI < 2; sI++) {
          pb[j][sI].u[0] = pack2(lg[2 * sI][0], lg[2 * sI][1]);
          pb[j][sI].u[1] = pack2(lg[2 * sI][2], lg[2 * sI][3]);
          pb[j][sI].u[2] = pack2(lg[2 * sI + 1][0], lg[2 * sI + 1][1]);
          pb[j][sI].u[3] = pack2(lg[2 * sI + 1][2], lg[2 * sI + 1][3]);
        }
        if (cl < 4 && g4 == 0) {
          mlb[(wave * 8 + j * 4 + cl) * 2] = m;
          mlb[(wave * 8 + j * 4 + cl) * 2 + 1] = sum;
        }
      }
#pragma unroll
      for (int tt = 0; tt < 4; tt++) {
        const int pos = idxl[qn * 256 + wave * 64 + tt * 16 + cl];
#pragma unroll
        for (int j = 0; j < 2; j++) {
          const bf16_t* kr = Ks + (size_t)pos * 128 + j * 64 + g4 * 8;
          kf[j][tt][0] = *(const bf16x8*)kr;
          kf[j][tt][1] = *(const bf16x8*)(kr + 32);
        }
      }
      f32x4 o[2][4];
#pragma unroll
      for (int j = 0; j < 2; j++)
#pragma unroll
        for (int dt = 0; dt < 4; dt++) o[j][dt] = (f32x4){0.f, 0.f, 0.f, 0.f};
      const lds_cptr vb = (lds_cptr)(vst + (g4 * 4 + (cl >> 2)) * 288 + (cl & 3) * 8);
      {
        *(uint4*)(vst + (0 + g4) * 288 + cl * 16) = vq0;
        *(uint4*)(vst + (4 + g4) * 288 + cl * 16) = vq1;
        *(uint4*)(vst + (8 + g4) * 288 + cl * 16) = vq2;
        *(uint4*)(vst + (12 + g4) * 288 + cl * 16) = vq3;
        *(uint4*)(vst + (16 + g4) * 288 + cl * 16) = vq4;
        *(uint4*)(vst + (20 + g4) * 288 + cl * 16) = vq5;
        *(uint4*)(vst + (24 + g4) * 288 + cl * 16) = vq6;
        *(uint4*)(vst + (28 + g4) * 288 + cl * 16) = vq7;
        __builtin_amdgcn_wave_barrier();
#pragma unroll
        for (int j = 0; j < 2; j++)
#pragma unroll
          for (int dt = 0; dt < 4; dt++) {
            const s16x4 alo = vtr(vb + (j * 64 + dt * 16) * 2);
            const s16x4 ahi = vtr(vb + (j * 64 + dt * 16) * 2 + 16 * 288);
            const bf16x8 af = __builtin_shufflevector(alo, ahi, 0, 1, 2, 3, 4, 5, 6, 7);
            o[j][dt] = mfma16(af, pb[j][0].v, o[j][dt]);
          }
        __builtin_amdgcn_wave_barrier();
      }
      {
        *(uint4*)(vst + (0 + g4) * 288 + cl * 16) = vq8;
        *(uint4*)(vst + (4 + g4) * 288 + cl * 16) = vq9;
        *(uint4*)(vst + (8 + g4) * 288 + cl * 16) = vq10;
        *(uint4*)(vst + (12 + g4) * 288 + cl * 16) = vq11;
        *(uint4*)(vst + (16 + g4) * 288 + cl * 16) = vq12;
        *(uint4*)(vst + (20 + g4) * 288 + cl * 16) = vq13;
        *(uint4*)(vst + (24 + g4) * 288 + cl * 16) = vq14;
        *(uint4*)(vst + (28 + g4) * 288 + cl * 16) = vq15;
        __builtin_amdgcn_wave_barrier();
#pragma unroll
        for (int j = 0; j < 2; j++)
#pragma unroll
          for (int dt = 0; dt < 4; dt++) {
            const s16x4 alo = vtr(vb + (j * 64 + dt * 16) * 2);
            const s16x4 ahi = vtr(vb + (j * 64 + dt * 16) * 2 + 16 * 288);
            const bf16x8 af = __builtin_shufflevector(alo, ahi, 0, 1, 2, 3, 4, 5, 6, 7);
            o[j][dt] = mfma16(af, pb[j][1].v, o[j][dt]);
          }
        __builtin_amdgcn_wave_barrier();
      }
      vq0 = *(const uint4*)(Vs + (size_t)idxl[qn * 256 + wave * 64 + 0 + g4] * 128 + cl * 8);
      vq1 = *(const uint4*)(Vs + (size_t)idxl[qn * 256 + wave * 64 + 4 + g4] * 128 + cl * 8);
      vq2 = *(const uint4*)(Vs + (size_t)idxl[qn * 256 + wave * 64 + 8 + g4] * 128 + cl * 8);
      vq3 = *(const uint4*)(Vs + (size_t)idxl[qn * 256 + wave * 64 + 12 + g4] * 128 + cl * 8);
      vq4 = *(const uint4*)(Vs + (size_t)idxl[qn * 256 + wave * 64 + 16 + g4] * 128 + cl * 8);
      vq5 = *(const uint4*)(Vs + (size_t)idxl[qn * 256 + wave * 64 + 20 + g4] * 128 + cl * 8);
      vq6 = *(const uint4*)(Vs + (size_t)idxl[qn * 256 + wave * 64 + 24 + g4] * 128 + cl * 8);
      vq7 = *(const uint4*)(Vs + (size_t)idxl[qn * 256 + wave * 64 + 28 + g4] * 128 + cl * 8);
      vq8 = *(const uint4*)(Vs + (size_t)idxl[qn * 256 + wave * 64 + 32 + g4] * 128 + cl * 8);
      vq9 = *(const uint4*)(Vs + (size_t)idxl[qn * 256 + wave * 64 + 36 + g4] * 128 + cl * 8);
      vq10 = *(const uint4*)(Vs + (size_t)idxl[qn * 256 + wave * 64 + 40 + g4] * 128 + cl * 8);
      vq11 = *(const uint4*)(Vs + (size_t)idxl[qn * 256 + wave * 64 + 44 + g4] * 128 + cl * 8);
      vq12 = *(const uint4*)(Vs + (size_t)idxl[qn * 256 + wave * 64 + 48 + g4] * 128 + cl * 8);
      vq13 = *(const uint4*)(Vs + (size_t)idxl[qn * 256 + wave * 64 + 52 + g4] * 128 + cl * 8);
      vq14 = *(const uint4*)(Vs + (size_t)idxl[qn * 256 + wave * 64 + 56 + g4] * 128 + cl * 8);
      vq15 = *(const uint4*)(Vs + (size_t)idxl[qn * 256 + wave * 64 + 60 + g4] * 128 + cl * 8);
      if (cl < 4) {
#pragma unroll
        for (int j = 0; j < 2; j++)
#pragma unroll
          for (int dt = 0; dt < 4; dt++) *(f32x4*)(opb + (wave * 8 + j * 4 + cl) * 64 + dt * 16 + g4 * 4) = o[j][dt];
      }
    } else {
      if (lane < 8) {
        mlb[(wave * 8 + lane) * 2] = -1e30f;
        mlb[(wave * 8 + lane) * 2 + 1] = 0.f;
      }
      *(f32x4*)(opb + wave * 512 + lane * 8) = (f32x4){0.f, 0.f, 0.f, 0.f};
      *(f32x4*)(opb + wave * 512 + lane * 8 + 4) = (f32x4){0.f, 0.f, 0.f, 0.f};
    }
    __syncthreads();
    {
      const int e = tid * 2, head = e >> 6, d = e & 63;
      float M = -1e30f;
#pragma unroll
      for (int w = 0; w < 4; w++) M = fmaxf(M, mlb[(w * 8 + head) * 2]);
      float den = 0.f, n0 = 0.f, n1 = 0.f;
#pragma unroll
      for (int w = 0; w < 4; w++) {
        const float f = __expf(mlb[(w * 8 + head) * 2] - M);
        den += mlb[(w * 8 + head) * 2 + 1] * f;
        const float2 o2 = *(const float2*)(opb + (w * 8 + head) * 64 + d);
        n0 += o2.x * f;
        n1 += o2.y * f;
      }
      const float inv = __builtin_amdgcn_rcpf(den);
      if (!dry) *(unsigned*)(p.qa + (size_t)tok * 512 + e) = pack2(n0 * inv, n1 * inv);
    }
  }
  __syncthreads();
}

DI void mixer_phase(const Params& p, int l, char* smem, const bool dry = false, const int ci = 0) {
  const int tid = otid();
  const int NTASK = 64 + 1024 + 1024 + 128 + 288;
  const int NEXTRA = (l == 0 && !dry) ? 456 : 0;
  bool first = true;
  for (;;) {
    int id;
    if (first && blockIdx.x < 64) {
      id = blockIdx.x;
    } else {
      __syncthreads();
      if (tid == 0) *(int*)(smem + SLOT) = 64 + (int)atomicAdd(&p.ctr[l + ci], 1u);
      __syncthreads();
      id = *(const int*)(smem + SLOT);
    }
    first = false;
    if (id >= NTASK + NEXTRA) break;
    if (id >= NTASK) {
      for (int q = 0; q < 8; q++) {
        const int d = (id - NTASK) * 8 + q;
        const int t = d < 1984 ? 2880 + d : d < 2624 ? 2880 + 2240 + (d - 1984) : 5760 + 1024 + (d - 2624);
        transpose_job(p, t, (float*)smem);
      }
      continue;
    }
    const int d = id - 64;
    if (id < 64 || d >= 1440) {
      int isP, b, h, rg;
      if (id < 64) { isP = 1; b = id >> 5; h = (id >> 2) & 7; rg = id & 3; }
      else { const int s = d - 1440; isP = 0; b = s >> 5; h = (s >> 2) & 7; rg = s & 3; }
      if (!(dry && (PROBE_SKIP & 2))) scan_task(p, l, isP, b, h, rg, smem, dry);
    } else if (d < 896 || d >= 1184) {
      int isP, b, tq;
      if (d < 768) { isP = 1; b = d & 1; tq = (511 - (d >> 1)) * 16; }
      else if (d < 896) { const int s = d - 768; isP = 0; b = s >> 2; tq = (s & 3) * 16; }
      else { const int s = d - 1184; isP = 1; b = s & 1; tq = (127 - (s >> 1)) * 16; }
      if (!(dry && (PROBE_SKIP & 1))) dsa_task(p, l, isP, b, tq, smem, dry);
    } else {
      if (!(dry && (PROBE_SKIP & 4))) mem_task(p, l, (d - 896) * 64, smem, dry);
    }
  }
}

DI void post_phase(const Params& p, int l) {
  const int tid = otid(), lane = tid & 63, wave = tid >> 6;
  for (int tok = blockIdx.x * 4 + wave; tok < TOK; tok += gridDim.x * 4) {
    float y[8], lw[8], lb[8], vv[8], bo[8];
    const bf16_t* vb = (const bf16_t*)(p.R + (size_t)tok * RS + 512) + 1024;
#pragma unroll
    for (int h = 0; h < 8; h++) {
      const int c = h * 64 + lane;
      y[h] = p.yscan[(size_t)tok * 512 + c];
      lw[h] = p.ln_w[l * 512 + c];
      lb[h] = p.ln_b[l * 512 + c];
      vv[h] = bf2f(vb[c]);
      bo[h] = p.bonus[(size_t)tok * 8 + h];
    }
#pragma unroll
    for (int h = 0; h < 8; h++) {
      const float mean = wave_sum(y[h]) * (1.f / 64.f);
      const float dv = y[h] - mean;
      const float var = wave_sum(dv * dv) * (1.f / 64.f);
      const float yn = dv * rsqrtf(var + 64e-5f) * lw[h] + lb[h];
      y[h] = yn + bo[h] * vv[h];
    }
#pragma unroll
    for (int h = 0; h < 8; h++) p.o_r[(size_t)tok * 512 + h * 64 + lane] = f2bf(y[h]);
  }
}

DI void gemm2_phase(const Params& p, int l, char* smem, const bool dry = false) {
  bf16_t* sm = (bf16_t*)smem;
  const int tid = otid(), lane = tid & 63, wave = tid >> 6;
  const int wm = wave >> 1, wn = wave & 1, g4 = lane >> 4, cl = lane & 15;
  const int slots = gridDim.x >> 3, slot = blockIdx.x >> 3;
  for (int e = slot;; e += slots) {
    int mt, nt;
    if (!xcd_tile(e, 36, mt, nt)) break;
    f32x4 acc[4][4];
    zero_acc(acc);
    gemm_kloop(p.hb + (size_t)mt * 128 * DM, DM, p.Wt2 + ((size_t)l * N2 + nt * 128) * DM, DM, DM, sm, acc);
    const int nb = nt * 128 + wn * 64;
    if (dry) {
      if (acc[0][0][0] == 1.2345e30f) p.wi[0] = acc[1][1][1] + acc[2][2][2] + acc[3][3][3];
    } else if (nb < 1536) {
      bf16_t* base = (nb < 512 ? p.qa : nb < 1024 ? p.o_r : p.qm) + (nb & 511) + cl;
      bf16_t old[4][4][4];
#pragma unroll
      for (int i = 0; i < 4; i++)
#pragma unroll
        for (int r = 0; r < 4; r++) {
          const int tok = mt * 128 + wm * 64 + i * 16 + g4 * 4 + r;
#pragma unroll
          for (int jn = 0; jn < 4; jn++) old[i][r][jn] = base[(size_t)tok * 512 + jn * 16];
        }
#pragma unroll
      for (int i = 0; i < 4; i++)
#pragma unroll
        for (int r = 0; r < 4; r++) {
          const int tok = mt * 128 + wm * 64 + i * 16 + g4 * 4 + r;
#pragma unroll
          for (int jn = 0; jn < 4; jn++) base[(size_t)tok * 512 + jn * 16] = f2bf(bf2f(old[i][r][jn]) * siluf_(acc[i][jn][r]));
        }
    } else {
#pragma unroll
      for (int i = 0; i < 4; i++)
#pragma unroll
        for (int r = 0; r < 4; r++) {
          const int tok = mt * 128 + wm * 64 + i * 16 + g4 * 4 + r;
#pragma unroll
          for (int jn = 0; jn < 4; jn++)
            p.G[(size_t)tok * 3072 + nb - 1536 + jn * 16 + cl] = f2bf(sigmoidf_(acc[i][jn][r]));
        }
    }
  }
}

DI void merge_phase(const Params& p, int l, char* smem) {
  bf16_t* sm = (bf16_t*)smem;
  const int tid = otid(), lane = tid & 63, wave = tid >> 6;
  const int g4 = lane >> 4, cl = lane & 15;
  const int slots = gridDim.x >> 3, slot = blockIdx.x >> 3;
  for (int e = slot;; e += slots) {
    int mt, nt;
    if (!xcd_tile(e, 16, mt, nt)) break;
    f32x4 tot[2][4];
#pragma unroll
    for (int i = 0; i < 2; i++)
#pragma unroll
      for (int j = 0; j < 4; j++) tot[i][j] = (f32x4){0.f, 0.f, 0.f, 0.f};
#pragma unroll 1
    for (int br = 0; br < 3; br++) {
      f32x4 acc[2][4];
#pragma unroll
      for (int i = 0; i < 2; i++)
#pragma unroll
        for (int j = 0; j < 4; j++) acc[i][j] = (f32x4){0.f, 0.f, 0.f, 0.f};
      const bf16_t* A = (br == 0 ? p.qa : br == 1 ? p.o_r : p.qm) + (size_t)mt * 128 * 512;
      gemm_kloop64(A, 512, p.Wbr + ((size_t)(l * 3 + br) * DM + nt * 64) * 512, 512, 512, sm, acc);
#pragma unroll
      for (int i = 0; i < 2; i++)
#pragma unroll
        for (int r = 0; r < 4; r++) {
          const int tok = mt * 128 + wave * 32 + i * 16 + g4 * 4 + r;
#pragma unroll
          for (int jn = 0; jn < 4; jn++) {
            const int n = nt * 64 + jn * 16 + cl;
            const float g = bf2f(p.G[(size_t)tok * 3072 + br * 1024 + n]);
            tot[i][jn][r] += g * acc[i][jn][r];
          }
        }
    }
#pragma unroll
    for (int i = 0; i < 2; i++)
#pragma unroll
      for (int r = 0; r < 4; r++) {
        const int tok = mt * 128 + wave * 32 + i * 16 + g4 * 4 + r;
#pragma unroll
        for (int jn = 0; jn < 4; jn++) {
          const int n = nt * 64 + jn * 16 + cl;
          p.merged[(size_t)tok * DM + n] = f2bf(tot[i][jn][r]);
        }
      }
  }
}

DI void out_phase(const Params& p, int l, char* smem, const bool dry = false) {
  bf16_t* sm = (bf16_t*)smem;
  const int tid = otid(), lane = tid & 63, wave = tid >> 6;
  const int wm = wave >> 1, wn = wave & 1, g4 = lane >> 4, cl = lane & 15;
  const int slots = gridDim.x >> 3, slot = blockIdx.x >> 3;
  for (int e = slot;; e += slots) {
    int mt, nt;
    if (!xcd_tile(e, 8, mt, nt)) break;
    f32x4 acc[4][4];
    zero_acc(acc);
    gemm_kloop(p.merged + (size_t)mt * 128 * DM, DM, p.Wout + ((size_t)l * DM + nt * 128) * DM, DM, DM, sm, acc);
    if (dry) {
      if (acc[0][0][0] == 1.2345e30f) p.wi[0] = acc[1][1][1] + acc[2][2][2] + acc[3][3][3];
      continue;
    }
    float xo[4][4][4];
#pragma unroll
    for (int i = 0; i < 4; i++)
#pragma unroll
      for (int r = 0; r < 4; r++) {
        const int tok = mt * 128 + wm * 64 + i * 16 + g4 * 4 + r;
        const float* xr = xrow_ptr(p, l, tok);
#pragma unroll
        for (int jn = 0; jn < 4; jn++) xo[i][r][jn] = xr[nt * 128 + wn * 64 + jn * 16 + cl];
      }
#pragma unroll
    for (int i = 0; i < 4; i++)
#pragma unroll
      for (int r = 0; r < 4; r++) {
        const int tok = mt * 128 + wm * 64 + i * 16 + g4 * 4 + r;
#pragma unroll
        for (int jn = 0; jn < 4; jn++) {
          const int n = nt * 128 + wn * 64 + jn * 16 + cl;
          p.out[(size_t)tok * DM + n] = xo[i][r][jn] + acc[i][jn][r];
        }
      }
  }
}

DI void norm_phase(const Params& p, int l) {
  const int wave = otid() >> 6;
  for (int tok = blockIdx.x * 4 + wave; tok < TOK; tok += gridDim.x * 4)
    norm_row_bf16(xrow_ptr(p, l, tok), p.norm_g + l * DM, p.hb + (size_t)tok * DM);
}
DI void final_phase(const Params& p) {
  const int lane = otid() & 63, wave = otid() >> 6;
  for (int tok = blockIdx.x * 4 + wave; tok < TOK; tok += gridDim.x * 4) {
    float* x = p.out + (size_t)tok * DM;
    float4 v[4];
    float ss = 0.f;
#pragma unroll
    for (int i = 0; i < 4; i++) {
      v[i] = *(const float4*)(x + i * 256 + lane * 4);
      ss += v[i].x * v[i].x + v[i].y * v[i].y + v[i].z * v[i].z + v[i].w * v[i].w;
    }
    ss = wave_sum(ss);
    const float rstd = rsqrtf(ss * (1.f / 1024.f) + 1e-6f);
#pragma unroll
    for (int i = 0; i < 4; i++) {
      const float4 g = *(const float4*)(p.final_g + i * 256 + lane * 4);
      *(float4*)(x + i * 256 + lane * 4) = make_float4(v[i].x * rstd * g.x, v[i].y * rstd * g.y, v[i].z * rstd * g.z, v[i].w * rstd * g.w);
    }
  }
}

__global__ void __launch_bounds__(256, 2) mega(Params pk) {
  const Params& p = *(const Params*)__builtin_amdgcn_kernarg_segment_ptr();
  cg::grid_group grid = cg::this_grid();
  __shared__ __attribute__((aligned(16))) char smem[SMEM];
  phase0(p, smem);
  grid.sync();
  GBar gb;
  gbar_init(gb, p.ctr);
#ifndef PROBE_DUP
#define PROBE_DUP 0
#endif
  const bool dryv = PROBE_DUP ? (*(volatile unsigned*)&p.ctr[7] == 0u) : false;
  if (PROBE_DUP & 1) { phase0(p, smem); gbar(gb); }
  for (int l = 0; l < 2; l++) {
    if (l == 1) { norm_phase(p, 1); convert_caches(p, 1); gbar(gb); }
    if (PROBE_DUP & 2) { gemm1_phase(p, l, smem); gbar(gb); }
    gemm1_phase(p, l, smem);
    gbar(gb);
    if (PROBE_DUP & 4) { prep_phase(p, l, smem, dryv); gbar(gb); }
    prep_phase(p, l, smem);
    gbar(gb);
    if (PROBE_DUP & 8) { mixer_phase(p, l, smem, dryv, 2); gbar(gb); }
    mixer_phase(p, l, smem);
    gbar(gb);
    if (PROBE_DUP & 16) { post_phase(p, l); gbar(gb); }
    post_phase(p, l);
    gbar(gb);
    if (PROBE_DUP & 32) { gemm2_phase(p, l, smem, dryv); gbar(gb); }
    gemm2_phase(p, l, smem);
    gbar(gb);
    if (PROBE_DUP & 64) { merge_phase(p, l, smem); gbar(gb); }
    merge_phase(p, l, smem);
    gbar(gb);
    if (PROBE_DUP & 128) { out_phase(p, l, smem, dryv); gbar(gb); }
    out_phase(p, l, smem);
    gbar(gb);
  }
  final_phase(p);
}

extern "C" void kernel_launch(void* const* d_in, const int* in_sizes, int n_in, void* d_out, int out_size, void* d_ws,
                              size_t ws_size, hipStream_t stream) {
  Params p;
  ::memset((void*)&p, 0, sizeof(p));
  const float** f = (const float**)&p;
  for (int i = 0; i < 29; i++) f[i] = (const float*)d_in[i];
  p.out = (float*)d_out;
  char* w = (char*)d_ws;
  size_t off = 0;
  auto take = [&](size_t bytes) { char* r = w + off; off += (bytes + 255) & ~(size_t)255; return r; };
  p.Wt1 = (bf16_t*)take((size_t)2 * N1 * DM * 2);
  p.Wt2 = (bf16_t*)take((size_t)2 * N2 * DM * 2);
  p.Wmem = (bf16_t*)take((size_t)2 * DM * DM * 2);
  p.Wbr = (bf16_t*)take((size_t)2 * 3 * DM * 512 * 2);
  p.Wout = (bf16_t*)take((size_t)2 * DM * DM * 2);
  p.cmvT = (bf16_t*)take((size_t)2 * 32 * 4 * 128 * 256 * 2);
  p.pmvT = (bf16_t*)take((size_t)2 * 2 * 4 * 128 * 256 * 2);
  p.memn = (bf16_t*)take((size_t)2 * 512 * DM * 2);
  p.rope = (float*)take((size_t)8192 * 32 * 2 * 4);
  p.hb = (bf16_t*)take((size_t)TOK * DM * 2);
  p.qa = (bf16_t*)take((size_t)TOK * 512 * 2);
  p.qi = (bf16_t*)take((size_t)TOK * 256 * 2);
  p.qm = (bf16_t*)take((size_t)TOK * 512 * 2);
  p.o_r = (bf16_t*)take((size_t)TOK * 512 * 2);
  p.wi = (float*)take((size_t)TOK * 4 * 4);
  p.R = (float*)take((size_t)TOK * RS * 4);
  p.G = (bf16_t*)p.R;
  p.yscan = (float*)take((size_t)TOK * 512 * 4);
  p.merged = (bf16_t*)p.yscan;
  p.bnd = (float*)take((size_t)(TOK / 16) * DSH * 4);
  p.bonus = (float*)take((size_t)TOK * 8 * 4);
  p.ctr = (unsigned*)take(16384);
  p.KB = (bf16_t*)take((size_t)NROWS * 128 * 2);
  p.VB = (bf16_t*)take((size_t)NROWS * 128 * 2);
  p.KIB = (bf16_t*)take((size_t)NROWS * 64 * 2);
  if (off > ws_size) {
    fprintf(stderr, "workspace too small: need %zu have %zu\n", off, ws_size);
    return;
  }
  static int grid_blocks = 0;
  if (!grid_blocks) {
    int dev = 0, cus = 0, per_cu = 0;
    (void)hipGetDevice(&dev);
    (void)hipDeviceGetAttribute(&cus, hipDeviceAttributeMultiprocessorCount, dev);
    (void)hipOccupancyMaxActiveBlocksPerMultiprocessor(&per_cu, mega, 256, 0);
    if (per_cu > 2) per_cu = 2;
    if (per_cu < 1) per_cu = 1;
    grid_blocks = (cus * per_cu) & ~7;
  }
  (void)hipMemsetAsync(p.ctr, 0, 16384, stream);
  void* args[] = {&p};
  hipError_t e = hipLaunchCooperativeKernel((void*)mega, dim3(grid_blocks), dim3(256), args, 0, stream);
  if (e != hipSuccess) fprintf(stderr, "cooperative launch failed: %s (grid %d)\n", hipGetErrorString(e), grid_blocks);
}
```

```cpp
#include <hip/hip_runtime.h>
#include <hip/hip_cooperative_groups.h>
#include <stdint.h>
#include <stdio.h>
#include <string.h>
namespace cg = cooperative_groups;

#define DI __device__ __forceinline__
#define PROBE_SKIP 2
typedef unsigned short bf16_t;
typedef __attribute__((ext_vector_type(8))) short bf16x8;
typedef __attribute__((ext_vector_type(4))) float f32x4;
typedef __attribute__((ext_vector_type(2))) float f32x2;

constexpr int DM = 1024;
constexpr int TP = 16384;
constexpr int TOK = 18432;
constexpr int DIN = 7876;
constexpr int N1 = 3328;
constexpr int N2 = 4608;
constexpr int RS = 1792;
constexpr int DSH = 1664;
constexpr int SMEM = 73728;
constexpr int SLOT = SMEM - 16;
constexpr int NROWS = 16384 + 32 * 2112;

constexpr size_t O_Y = 0;
constexpr size_t O_KP = 18874368;
constexpr size_t O_VP = O_KP + 4194304;
constexpr size_t O_KIP = O_VP + 4194304;
constexpr size_t O_WKVP = O_KIP + 2097152;
constexpr size_t O_SHP = O_WKVP + 131072;
constexpr size_t O_MKP = O_SHP + 6656;
constexpr size_t O_MVP = O_MKP + 524288;
constexpr size_t O_KS = O_MVP + 524288;
constexpr size_t O_VS = O_KS + 524288;
constexpr size_t O_KIS = O_VS + 524288;
constexpr size_t O_WKVS = O_KIS + 262144;
constexpr size_t O_SHS = O_WKVS + 2097152;

struct Params {
  const float *x_prompt, *x_sample, *mem_prompt, *cache_k, *cache_v, *cache_kidx, *state_wkv, *state_shift,
      *cache_mem_k, *cache_mem_v, *norm_g, *w_in, *mu_shift, *w0, *w2, *a0, *a2, *k_k, *k_a, *r_k, *ln_w, *ln_b,
      *mem_norm_g, *w_mem_kv, *w_br_a, *w_br_r, *w_br_m, *w_out, *final_g;
  float* out;
  bf16_t *Wt1, *Wt2, *Wmem, *Wbr, *Wout, *cmvT, *pmvT, *memn, *hb, *qa, *qi, *qm, *o_r, *merged, *G, *KB, *VB, *KIB;
  float *rope, *wi, *R, *yscan, *bnd, *bonus;
  unsigned* ctr;
};

DI int otid() { int t = __builtin_amdgcn_workitem_id_x(); asm volatile("" : "+v"(t)); return t; }
typedef __bf16 bf16x2_t __attribute__((ext_vector_type(2)));
DI unsigned pack2(float a, float b) {
  const f32x2 v = {a, b};
  const bf16x2_t r = __builtin_convertvector(v, bf16x2_t);
  return __builtin_bit_cast(unsigned, r);
}
DI bf16_t f2bf(float f) { return (bf16_t)(pack2(f, f) & 0xFFFFu); }
DI float bf2f(bf16_t b) { return __uint_as_float(((unsigned)b) << 16); }
DI bf16x8 cvt8(const float* p) {
  float4 x = *(const float4*)p, y = *(const float4*)(p + 4);
  union { bf16x8 v; unsigned u[4]; } r;
  r.u[0] = pack2(x.x, x.y); r.u[1] = pack2(x.z, x.w); r.u[2] = pack2(y.x, y.y); r.u[3] = pack2(y.z, y.w);
  return r.v;
}
template <int CTRL> DI float dpp_add(float x) {
  int y = __builtin_amdgcn_update_dpp(0, __float_as_int(x), CTRL, 0xF, 0xF, false);
  return x + __int_as_float(y);
}
DI float rowsum16(float x) {
  x = dpp_add<0xB1>(x);
  x = dpp_add<0x4E>(x);
  x = dpp_add<0x141>(x);
  x = dpp_add<0x140>(x);
  return x;
}
DI float wave_sum(float v) {
  v = rowsum16(v);
  const float a = __int_as_float(__builtin_amdgcn_readlane(__float_as_int(v), 0));
  const float b = __int_as_float(__builtin_amdgcn_readlane(__float_as_int(v), 16));
  const float c = __int_as_float(__builtin_amdgcn_readlane(__float_as_int(v), 32));
  const float d = __int_as_float(__builtin_amdgcn_readlane(__float_as_int(v), 48));
  return (a + b) + (c + d);
}
typedef __attribute__((address_space(3))) const char* lds_cptr;
typedef short v4i16_t __attribute__((ext_vector_type(4)));
typedef __attribute__((ext_vector_type(4))) short s16x4;
DI s16x4 vtr(lds_cptr p) { return __builtin_bit_cast(s16x4, __builtin_amdgcn_ds_read_tr16_b64_v4i16((__attribute__((address_space(3))) v4i16_t*)p)); }
DI void rowsum16x2(float& x, float& z) {
  x = dpp_add<0xB1>(x);  z = dpp_add<0xB1>(z);
  x = dpp_add<0x4E>(x);  z = dpp_add<0x4E>(z);
  x = dpp_add<0x141>(x); z = dpp_add<0x141>(z);
  x = dpp_add<0x140>(x); z = dpp_add<0x140>(z);
}
typedef unsigned u32x2 __attribute__((ext_vector_type(2)));
DI float red4_sum(float x) {
  const u32x2 r = __builtin_amdgcn_permlane16_swap(__float_as_uint(x), __float_as_uint(x), false, false);
  const float s = __uint_as_float(r.x) + __uint_as_float(r.y);
  const u32x2 q = __builtin_amdgcn_permlane32_swap(__float_as_uint(s), __float_as_uint(s), false, false);
  return __uint_as_float(q.x) + __uint_as_float(q.y);
}
DI float red4_max(float x) {
  const u32x2 r = __builtin_amdgcn_permlane16_swap(__float_as_uint(x), __float_as_uint(x), false, false);
  const float s = fmaxf(__uint_as_float(r.x), __uint_as_float(r.y));
  const u32x2 q = __builtin_amdgcn_permlane32_swap(__float_as_uint(s), __float_as_uint(s), false, false);
  return fmaxf(__uint_as_float(q.x), __uint_as_float(q.y));
}
DI float sigmoidf_(float x) { return __builtin_amdgcn_rcpf(1.f + __expf(-x)); }
DI float siluf_(float x) { return x * __builtin_amdgcn_rcpf(1.f + __expf(-x)); }
DI f32x4 mfma16(bf16x8 a, bf16x8 b, f32x4 c) { return __builtin_amdgcn_mfma_f32_16x16x32_bf16(a, b, c, 0, 0, 0); }

DI const float* xrow_ptr(const Params& p, int l, int tok) {
  if (l == 0) return tok < TP ? p.x_prompt + (size_t)tok * DM : p.x_sample + (size_t)(tok - TP) * DM;
  return p.out + (size_t)tok * DM;
}


DI unsigned xcc_id() { return (unsigned)__builtin_amdgcn_s_getreg((3 << 11) | 20) & 0xFu; }
struct GBar { unsigned* w; unsigned xcc, mycen, nx, k; };
DI void gbar_init(GBar& g, unsigned* w) {
  g.w = w; g.xcc = (unsigned)__builtin_amdgcn_readfirstlane((int)xcc_id()); g.k = 0;
  unsigned nx = 0, mycen = 0;
  for (unsigned x = 0; x < 16; x++) {
    const unsigned c = __hip_atomic_load(&w[64 + 64 * x], __ATOMIC_RELAXED, __HIP_MEMORY_SCOPE_AGENT);
    if (c) nx++;
    if (x == g.xcc) mycen = c;
  }
  g.nx = (unsigned)__builtin_amdgcn_readfirstlane((int)nx);
  g.mycen = (unsigned)__builtin_amdgcn_readfirstlane((int)mycen);
}
DI void gbar(GBar& g) {
  g.k++;
  asm volatile("s_waitcnt vmcnt(0) lgkmcnt(0)" ::: "memory");
  __syncthreads();
  if (otid() == 0) {
    const unsigned a = __hip_atomic_fetch_add(&g.w[1152 + 64 * g.xcc], 1u, __ATOMIC_RELAXED, __HIP_MEMORY_SCOPE_AGENT) + 1u;
    if (a == g.k * g.mycen) {
      __builtin_amdgcn_fence(__ATOMIC_RELEASE, "agent");
      asm volatile("s_waitcnt vmcnt(0)" ::: "memory");
      __hip_atomic_fetch_add(&g.w[2240], 1u, __ATOMIC_RELAXED, __HIP_MEMORY_SCOPE_AGENT);
    }
    while (__hip_atomic_load(&g.w[2240], __ATOMIC_RELAXED, __HIP_MEMORY_SCOPE_AGENT) < g.k * g.nx) __builtin_amdgcn_s_sleep(1);
    __builtin_amdgcn_fence(__ATOMIC_ACQUIRE, "agent");
    asm volatile("s_waitcnt vmcnt(0)" ::: "memory");
  }
  __syncthreads();
}

DI int colmap(int kind, int n) {
  if (kind == 1) {
    if (n < 1092) return n;
    if (n < 1152) return -1;
    if (n < 2816) return 1604 + (n - 1152);
    return 3780 + (n - 2816);
  } else if (kind == 2) {
    if (n < 512) return 1092 + n;
    if (n < 1024) return 3268 + (n - 512);
    if (n < 1536) return 4292 + (n - 1024);
    return 4804 + (n - 1536);
  }
  return n;
}
DI void transpose_tile(const float* __restrict__ src, int ldsrc, int kind, int k0, int n0, bf16_t* __restrict__ dst,
                       int lddst, float* tile) {
  const int tid = otid();
  float v[16];
#pragma unroll
  for (int r = 0; r < 16; r++) {
    const int kk = r * 4 + (tid >> 6), nn = tid & 63;
    const int sc = colmap(kind, n0 + nn);
    v[r] = sc >= 0 ? src[(size_t)(k0 + kk) * ldsrc + sc] : 0.f;
  }
  __syncthreads();
#pragma unroll
  for (int r = 0; r < 16; r++) tile[(r * 4 + (tid >> 6)) * 65 + (tid & 63)] = v[r];
  __syncthreads();
#pragma unroll
  for (int r = 0; r < 8; r++) {
    const int nn = r * 8 + (tid >> 5), kk = (tid & 31) * 2;
    *(unsigned*)(dst + (size_t)(n0 + nn) * lddst + k0 + kk) = pack2(tile[kk * 65 + nn], tile[(kk + 1) * 65 + nn]);
  }
}
DI void norm_row_bf16(const float* __restrict__ x, const float* __restrict__ g, bf16_t* __restrict__ dst) {
  const int lane = otid() & 63;
  float4 v[4];
  float ss = 0.f;
#pragma unroll
  for (int i = 0; i < 4; i++) {
    v[i] = *(const float4*)(x + i * 256 + lane * 4);
    ss += v[i].x * v[i].x + v[i].y * v[i].y + v[i].z * v[i].z + v[i].w * v[i].w;
  }
  ss = wave_sum(ss);
  float rstd = rsqrtf(ss * (1.f / 1024.f) + 1e-6f);
#pragma unroll
  for (int i = 0; i < 4; i++) {
    float4 gg = *(const float4*)(g + i * 256 + lane * 4);
    uint2 o;
    o.x = pack2(v[i].x * rstd * gg.x, v[i].y * rstd * gg.y);
    o.y = pack2(v[i].z * rstd * gg.z, v[i].w * rstd * gg.w);
    *(uint2*)(dst + i * 256 + lane * 4) = o;
  }
}


DI void convert_caches(const Params& p, int l) {
  const int tid = otid();
  const long total = (long)32 * 2048 * 40;
  for (long e = (long)blockIdx.x * 256 + tid; e < total; e += (long)gridDim.x * 256) {
    const int row = (int)(e / 40), c = (int)(e - (long)row * 40);
    const int b = row >> 11, pos = row & 2047;
    const size_t drow = (size_t)16384 + (size_t)b * 2112 + pos;
    const size_t srow = (size_t)(l * 32 + b) * 2048 + pos;
    if (c < 16) *(bf16x8*)(p.KB + drow * 128 + c * 8) = cvt8(p.cache_k + srow * 128 + c * 8);
    else if (c < 32) *(bf16x8*)(p.VB + drow * 128 + (c - 16) * 8) = cvt8(p.cache_v + srow * 128 + (c - 16) * 8);
    else *(bf16x8*)(p.KIB + drow * 64 + (c - 32) * 8) = cvt8(p.cache_kidx + srow * 64 + (c - 32) * 8);
  }
}

DI void transpose_job(const Params& p, int t, float* tile) {
  const int NTW = 2880;
  if (t < 2 * NTW) {
    int l = t / NTW, r = t - l * NTW;
    if (r < 832) {
      int nt = r >> 4, kt = r & 15;
      transpose_tile(p.w_in + (size_t)l * DM * DIN, DIN, 1, kt * 64, nt * 64, p.Wt1 + (size_t)l * N1 * DM, DM, tile);
    } else if (r < 832 + 1152) {
      r -= 832;
      int nt = r >> 4, kt = r & 15;
      transpose_tile(p.w_in + (size_t)l * DM * DIN, DIN, 2, kt * 64, nt * 64, p.Wt2 + (size_t)l * N2 * DM, DM, tile);
    } else if (r < 832 + 1152 + 256) {
      r -= 1984;
      int nt = r >> 4, kt = r & 15;
      transpose_tile(p.w_mem_kv + (size_t)l * DM * DM, DM, 0, kt * 64, nt * 64, p.Wmem + (size_t)l * DM * DM, DM, tile);
    } else if (r < 2240 + 384) {
      r -= 2240;
      int br = r >> 7; r &= 127;
      int nt = r >> 3, kt = r & 7;
      const float* src = (br == 0 ? p.w_br_a : br == 1 ? p.w_br_r : p.w_br_m) + (size_t)l * 512 * DM;
      transpose_tile(src, DM, 0, kt * 64, nt * 64, p.Wbr + (size_t)(l * 3 + br) * DM * 512, 512, tile);
    } else {
      r -= 2624;
      int nt = r >> 4, kt = r & 15;
      transpose_tile(p.w_out + (size_t)l * DM * DM, DM, 0, kt * 64, nt * 64, p.Wout + (size_t)l * DM * DM, DM, tile);
    }
  } else {
    int r = t - 2 * NTW;
    int job = r >> 3, sub = r & 7;
    int lb = job >> 2, h = job & 3;
    int nt = sub >> 2, kt = sub & 3;
    transpose_tile(p.cache_mem_v + (size_t)lb * 256 * 512 + h * 128, 512, 0, kt * 64, nt * 64,
                   p.cmvT + (size_t)(lb * 4 + h) * 128 * 256, 256, tile);
  }
}

DI void phase0(const Params& p, char* smem) {
  const int tid = otid();
  float* tile = (float*)smem;
  if (tid == 0) __hip_atomic_fetch_add(&p.ctr[64 + 64 * xcc_id()], 1u, __ATOMIC_RELAXED, __HIP_MEMORY_SCOPE_AGENT);
  for (int t = blockIdx.x; t < 2 * 2880 + 2048; t += gridDim.x) {
    const bool deferred = (t >= 2880 && t < 5760 && !(t - 2880 >= 1984 && t - 2880 < 2240)) || (t >= 5760 + 1024);
    if (!deferred) transpose_job(p, t, tile);
  }
  convert_caches(p, 0);
  for (int e = blockIdx.x * 256 + tid; e < 8192 * 32; e += gridDim.x * 256) {
    int pos = e >> 5, i = e & 31;
    float inv = powf(10000.f, -(float)(2 * i) / 64.f);
    float ang = (float)pos * inv;
    float s, c;
    sincosf(ang, &s, &c);
    p.rope[2 * e] = c;
    p.rope[2 * e + 1] = s;
  }
  const int wave = tid >> 6;
  for (int r = blockIdx.x * 4 + wave; r < 1024 + TOK; r += gridDim.x * 4) {
    if (r < 1024) {
      int l = r >> 9, row = r & 511;
      norm_row_bf16(p.mem_prompt + (size_t)row * DM, p.mem_norm_g + l * DM, p.memn + (size_t)r * DM);
    } else {
      int tok = r - 1024;
      norm_row_bf16(xrow_ptr(p, 0, tok), p.norm_g, p.hb + (size_t)tok * DM);
    }
  }
}

constexpr int LDT = 72;
constexpr int TILE_E = 128 * LDT;
DI void gemm_kloop(const bf16_t* __restrict__ A, int lda, const bf16_t* __restrict__ B, int ldb, int K, bf16_t* sm,
                   f32x4 (&acc)[4][4]) {
  const int tid = otid(), lane = tid & 63, wave = tid >> 6;
  const int wm = wave >> 1, wn = wave & 1;
  const int lrow = tid >> 3, lkc = (tid & 7) * 8;
  const unsigned toa = (unsigned)(lrow * lda + lkc), tob = (unsigned)(lrow * ldb + lkc);
  uint4 ra0_0, ra0_1, ra0_2, ra0_3, rb0_0, rb0_1, rb0_2, rb0_3, ra1_0, ra1_1, ra1_2, ra1_3, rb1_0, rb1_1, rb1_2, rb1_3;
  const int fr = lane & 15, fk = (lane >> 4) * 8;
  const int nk = K >> 6;
#define GLOAD(RA, RB, K0)                                                   \
  {                                                                         \
    RA##_0 = *(const uint4*)((A + (size_t)(K0)) + toa);                     \
    RA##_1 = *(const uint4*)((A + (size_t)(32 * lda + (K0))) + toa);        \
    RA##_2 = *(const uint4*)((A + (size_t)(64 * lda + (K0))) + toa);        \
    RA##_3 = *(const uint4*)((A + (size_t)(96 * lda + (K0))) + toa);        \
    RB##_0 = *(const uint4*)((B + (size_t)(K0)) + tob);                     \
    RB##_1 = *(const uint4*)((B + (size_t)(32 * ldb + (K0))) + tob);        \
    RB##_2 = *(const uint4*)((B + (size_t)(64 * ldb + (K0))) + tob);        \
    RB##_3 = *(const uint4*)((B + (size_t)(96 * ldb + (K0))) + tob);        \
  }
#define SSTORE(RA, RB, BUF)                                                 \
  {                                                                         \
    bf16_t* sd = sm + (BUF) * (2 * TILE_E) + lrow * LDT + lkc;              \
    *(uint4*)(sd) = RA##_0;                                                 \
    *(uint4*)(sd + 32 * LDT) = RA##_1;                                      \
    *(uint4*)(sd + 64 * LDT) = RA##_2;                                      \
    *(uint4*)(sd + 96 * LDT) = RA##_3;                                      \
    *(uint4*)(sd + TILE_E) = RB##_0;                                        \
    *(uint4*)(sd + TILE_E + 32 * LDT) = RB##_1;                             \
    *(uint4*)(sd + TILE_E + 64 * LDT) = RB##_2;                             \
    *(uint4*)(sd + TILE_E + 96 * LDT) = RB##_3;                             \
  }
#define COMPUTE(BUF)                                                        \
  {                                                                         \
    const bf16_t* sa = sm + (BUF) * (2 * TILE_E) + (wm * 64 + fr) * LDT + fk;           \
    const bf16_t* sb = sm + (BUF) * (2 * TILE_E) + TILE_E + (wn * 64 + fr) * LDT + fk;  \
    _Pragma("unroll") for (int s = 0; s < 2; s++) {                         \
      bf16x8 af[4], bfr[4];                                                 \
      _Pragma("unroll") for (int i = 0; i < 4; i++) {                       \
        af[i] = *(const bf16x8*)(sa + i * 16 * LDT + s * 32);               \
        bfr[i] = *(const bf16x8*)(sb + i * 16 * LDT + s * 32);              \
      }                                                                     \
      _Pragma("unroll") for (int i = 0; i < 4; i++)                         \
        _Pragma("unroll") for (int j = 0; j < 4; j++) acc[i][j] = mfma16(af[i], bfr[j], acc[i][j]);  \
    }                                                                       \
  }
  __syncthreads();
  GLOAD(ra0, rb0, 0)
  GLOAD(ra1, rb1, 64)
  SSTORE(ra0, rb0, 0)
  __syncthreads();
  for (int kt = 0; kt < nk - 2; kt += 2) {
    GLOAD(ra0, rb0, (kt + 2) << 6)
    COMPUTE(0)
    SSTORE(ra1, rb1, 1)
    __syncthreads();
    GLOAD(ra1, rb1, (kt + 3) << 6)
    COMPUTE(1)
    SSTORE(ra0, rb0, 0)
    __syncthreads();
  }
  COMPUTE(0)
  SSTORE(ra1, rb1, 1)
  __syncthreads();
  COMPUTE(1)
  __syncthreads();
#undef GLOAD
#undef SSTORE
#undef COMPUTE
}
DI void zero_acc(f32x4 (&acc)[4][4]) {
#pragma unroll
  for (int i = 0; i < 4; i++)
#pragma unroll
    for (int j = 0; j < 4; j++) acc[i][j] = (f32x4){0.f, 0.f, 0.f, 0.f};
}


DI void gemm_kloop64(const bf16_t* __restrict__ A, int lda, const bf16_t* __restrict__ B, int ldb, int K, bf16_t* sm,
                     f32x4 (&acc)[2][4]) {
  const int tid = otid(), lane = tid & 63, wave = tid >> 6;
  const int lrow = tid >> 3, lkc = (tid & 7) * 8;
  const unsigned toa = (unsigned)(lrow * lda + lkc), tob = (unsigned)(lrow * ldb + lkc);
  uint4 ra0_0, ra0_1, ra0_2, ra0_3, rb0_0, rb0_1, ra1_0, ra1_1, ra1_2, ra1_3, rb1_0, rb1_1;
  const int fr = lane & 15, fk = (lane >> 4) * 8;
  const int nk = K >> 6;
#define GLOAD(RA, RB, K0)                                                   \
  {                                                                         \
    RA##_0 = *(const uint4*)((A + (size_t)(K0)) + toa);                     \
    RA##_1 = *(const uint4*)((A + (size_t)(32 * lda + (K0))) + toa);        \
    RA##_2 = *(const uint4*)((A + (size_t)(64 * lda + (K0))) + toa);        \
    RA##_3 = *(const uint4*)((A + (size_t)(96 * lda + (K0))) + toa);        \
    RB##_0 = *(const uint4*)((B + (size_t)(K0)) + tob);                     \
    RB##_1 = *(const uint4*)((B + (size_t)(32 * ldb + (K0))) + tob);        \
  }
#define SSTORE(RA, RB, BUF)                                                 \
  {                                                                         \
    bf16_t* sd = sm + (BUF) * (2 * TILE_E) + lrow * LDT + lkc;              \
    *(uint4*)(sd) = RA##_0;                                                 \
    *(uint4*)(sd + 32 * LDT) = RA##_1;                                      \
    *(uint4*)(sd + 64 * LDT) = RA##_2;                                      \
    *(uint4*)(sd + 96 * LDT) = RA##_3;                                      \
    *(uint4*)(sd + TILE_E) = RB##_0;                                        \
    *(uint4*)(sd + TILE_E + 32 * LDT) = RB##_1;                             \
  }
#define COMPUTE(BUF)                                                                            \
  {                                                                                             \
    const bf16_t* sa = sm + (BUF) * (2 * TILE_E) + (wave * 32 + fr) * LDT + fk;                 \
    const bf16_t* sb = sm + (BUF) * (2 * TILE_E) + TILE_E + fr * LDT + fk;                      \
    _Pragma("unroll") for (int s = 0; s < 2; s++) {                                             \
      bf16x8 af[2], bfr[4];                                                                     \
      _Pragma("unroll") for (int i = 0; i < 2; i++) af[i] = *(const bf16x8*)(sa + i * 16 * LDT + s * 32);   \
      _Pragma("unroll") for (int j = 0; j < 4; j++) bfr[j] = *(const bf16x8*)(sb + j * 16 * LDT + s * 32);  \
      _Pragma("unroll") for (int i = 0; i < 2; i++)                                             \
        _Pragma("unroll") for (int j = 0; j < 4; j++) acc[i][j] = mfma16(af[i], bfr[j], acc[i][j]);         \
    }                                                                                           \
  }
  __syncthreads();
  GLOAD(ra0, rb0, 0)
  GLOAD(ra1, rb1, 64)
  SSTORE(ra0, rb0, 0)
  __syncthreads();
  for (int kt = 0; kt < nk - 2; kt += 2) {
    GLOAD(ra0, rb0, (kt + 2) << 6)
    COMPUTE(0)
    SSTORE(ra1, rb1, 1)
    __syncthreads();
    GLOAD(ra1, rb1, (kt + 3) << 6)
    COMPUTE(1)
    SSTORE(ra0, rb0, 0)
    __syncthreads();
  }
  COMPUTE(0)
  SSTORE(ra1, rb1, 1)
  __syncthreads();
  COMPUTE(1)
  __syncthreads();
#undef GLOAD
#undef SSTORE
#undef COMPUTE
}

DI bool xcd_tile(int e, int NNT, int& mt, int& nt) {
  const int xcd = blockIdx.x & 7;
  const int per_mb = 9 * NNT;
  if (e >= 2 * per_mb) return false;
  const int mb = e >= per_mb ? 1 : 0;
  int r = e - mb * per_mb;
  const int full = NNT >> 3, rem = NNT & 7;
  int nb = r / 72;
  int w = 8;
  if (nb >= full) { nb = full; w = rem; }
  r -= nb * 72;
  const int mi = r / w, ni = r - mi * w;
  mt = xcd * 18 + mb * 9 + mi;
  nt = nb * 8 + ni;
  return true;
}

struct TokInfo { int isP, b, t, pos; };
DI TokInfo tokinfo(int tok) {
  TokInfo ti;
  if (tok < TP) { ti.isP = 1; ti.b = tok >> 13; ti.t = tok & 8191; ti.pos = ti.t; }
  else { int s = tok - TP; ti.isP = 0; ti.b = s >> 6; ti.t = s & 63; ti.pos = 2048 + ti.t; }
  return ti;
}

DI void gemm1_phase(const Params& p, int l, char* smem) {
  bf16_t* sm = (bf16_t*)smem;
  const int tid = otid(), lane = tid & 63, wave = tid >> 6;
  const int wm = wave >> 1, wn = wave & 1, g4 = lane >> 4, cl = lane & 15;
  const int NT1 = 144 * 26;
  const int slots = gridDim.x >> 3, slot = blockIdx.x >> 3;
  const int nmain = 18 * 26;
  const int nextra = (l == 0 ? 8 : 0);
  for (int e = slot; e < nmain + nextra; e += slots) {
    f32x4 acc[4][4];
    zero_acc(acc);
    int mt = 0, nt = 0;
    const bool is_main = xcd_tile(e, 26, mt, nt);
    const int t = is_main ? 0 : NT1 + (e - nmain) * 8 + (blockIdx.x & 7);
    if (is_main) {
      gemm_kloop(p.hb + (size_t)mt * 128 * DM, DM, p.Wt1 + ((size_t)l * N1 + nt * 128) * DM, DM, DM, sm, acc);
      const int nb = nt * 128 + wn * 64;
#pragma unroll
      for (int i = 0; i < 4; i++) {
        float2 csv[4][2];
        if (nb < 1088 && !(nb >= 640 && nb < 768)) {
#pragma unroll
          for (int r = 0; r < 4; r++) {
            const TokInfo tj = tokinfo(mt * 128 + wm * 64 + i * 16 + g4 * 4 + r);
#pragma unroll
            for (int jn = 0; jn < 2; jn++) csv[r][jn] = *(const float2*)(p.rope + (size_t)(tj.pos * 32 + jn * 16 + cl) * 2);
          }
        }
#pragma unroll
        for (int r = 0; r < 4; r++) {
          const int tok = mt * 128 + wm * 64 + i * 16 + g4 * 4 + r;
          const TokInfo ti = tokinfo(tok);
          if (nb < 1088) {
            if (nb >= 640 && nb < 768) {
              float* dst = ti.isP ? p.out + O_VP + ((size_t)(l * 2 + ti.b) * 8192 + ti.t) * 128
                                  : p.out + O_VS + ((size_t)(l * 32 + ti.b) * 64 + ti.t) * 128;
              bf16_t* dvb = p.VB + (size_t)(ti.isP ? ti.b * 8192 + ti.t : 16384 + ti.b * 2112 + 2048 + ti.t) * 128;
#pragma unroll
              for (int jn = 0; jn < 4; jn++) {
                dst[nb - 640 + jn * 16 + cl] = acc[i][jn][r];
                dvb[nb - 640 + jn * 16 + cl] = f2bf(acc[i][jn][r]);
              }
            } else {
#pragma unroll
              for (int jn = 0; jn < 2; jn++) {
                const int d = jn * 16 + cl;
                const float2 cs = csv[r][jn];
                const float x1 = acc[i][jn][r], x2 = acc[i][jn + 2][r];
                const float y1 = x1 * cs.x - x2 * cs.y, y2 = x1 * cs.y + x2 * cs.x;
                const int c1 = nb + d, c2 = nb + d + 32;
                if (nb < 512) {
                  p.qa[(size_t)tok * 512 + c1] = f2bf(y1 * 0.125f);
                  p.qa[(size_t)tok * 512 + c2] = f2bf(y2 * 0.125f);
                } else if (nb < 640) {
                  float* dst = ti.isP ? p.out + O_KP + ((size_t)(l * 2 + ti.b) * 8192 + ti.t) * 128
                                      : p.out + O_KS + ((size_t)(l * 32 + ti.b) * 64 + ti.t) * 128;
                  dst[c1 - 512] = y1;
                  dst[c2 - 512] = y2;
                  bf16_t* dkb = p.KB + (size_t)(ti.isP ? ti.b * 8192 + ti.t : 16384 + ti.b * 2112 + 2048 + ti.t) * 128;
                  dkb[c1 - 512] = f2bf(y1);
                  dkb[c2 - 512] = f2bf(y2);
                } else if (nb < 1024) {
                  p.qi[(size_t)tok * 256 + c1 - 768] = f2bf(y1 * 0.125f);
                  p.qi[(size_t)tok * 256 + c2 - 768] = f2bf(y2 * 0.125f);
                } else {
                  float* dst = ti.isP ? p.out + O_KIP + ((size_t)(l * 2 + ti.b) * 8192 + ti.t) * 64
                                      : p.out + O_KIS + ((size_t)(l * 32 + ti.b) * 64 + ti.t) * 64;
                  dst[c1 - 1024] = y1;
                  dst[c2 - 1024] = y2;
                  bf16_t* dib = p.KIB + (size_t)(ti.isP ? ti.b * 8192 + ti.t : 16384 + ti.b * 2112 + 2048 + ti.t) * 64;
                  dib[c1 - 1024] = f2bf(y1);
                  dib[c2 - 1024] = f2bf(y2);
                }
              }
            }
          } else if (nb == 1088) {
            if (cl < 4) p.wi[(size_t)tok * 4 + cl] = acc[i][0][r] * 0.5f;
          } else if (nb < 2816) {
            const int T = ti.isP ? 8192 : 64;
#pragma unroll
            for (int jn = 0; jn < 4; jn++) {
              const int c = nb - 1152 + jn * 16 + cl;
              const float v = acc[i][jn][r];
              p.R[(size_t)tok * RS + c] = v;
              if (ti.t == T - 1) {
                float* dst = ti.isP ? p.out + O_SHP + (size_t)(l * 2 + ti.b) * DSH : p.out + O_SHS + (size_t)(l * 32 + ti.b) * DSH;
                dst[c] = v;
              }
              if ((tok & 15) == 15) p.bnd[(size_t)(tok >> 4) * DSH + c] = v;
            }
          } else {
#pragma unroll
            for (int jn = 0; jn < 4; jn++)
              p.qm[(size_t)tok * 512 + nb - 2816 + jn * 16 + cl] = f2bf(acc[i][jn][r] * 0.08838834764831845f);
          }
        }
      }
    } else {
      const int u = t - NT1;
      const int lm = u >> 5, mt = (u >> 3) & 3, nt = u & 7;
      gemm_kloop(p.memn + ((size_t)lm * 512 + mt * 128) * DM, DM, p.Wmem + ((size_t)lm * DM + nt * 128) * DM, DM, DM, sm, acc);
#pragma unroll
      for (int i = 0; i < 4; i++)
#pragma unroll
        for (int r = 0; r < 4; r++) {
          const int row = mt * 128 + wm * 64 + i * 16 + g4 * 4 + r;
          const int bm = row >> 8, m = row & 255;
#pragma unroll
          for (int jn = 0; jn < 4; jn++) {
            const int n = nt * 128 + wn * 64 + jn * 16 + cl;
            const float v = acc[i][jn][r];
            if (n < 512) {
              p.out[O_MKP + ((size_t)(lm * 2 + bm) * 256 + m) * 512 + n] = v;
            } else {
              const int n2 = n - 512;
              p.out[O_MVP + ((size_t)(lm * 2 + bm) * 256 + m) * 512 + n2] = v;
              p.pmvT[((size_t)((lm * 2 + bm) * 4 + (n2 >> 7)) * 128 + (n2 & 127)) * 256 + m] = f2bf(v);
            }
          }
        }
    }
  }
}

DI void prep_phase(const Params& p, int l, char* smem, const bool dry = false) {
  float* rows = (float*)smem;
  float* tw = rows + 9 * DSH;
  float* ta = tw + 512;
  const int tid = otid(), lane = tid & 63, wave = tid >> 6;
  const float* mu = p.mu_shift + l * DSH;
  const float* w2 = p.w2 + (size_t)l * 64 * 512;
  const float* a2 = p.a2 + (size_t)l * 64 * 512;
  for (int task = blockIdx.x; task < TOK / 16; task += gridDim.x) {
    const int tok0 = task * 16;
    const TokInfo t0 = tokinfo(tok0);
    __syncthreads();
    for (int c = tid; c < DSH; c += 256) {
      float pv;
      if (t0.t == 0) pv = t0.isP ? 0.f : p.state_shift[(size_t)(l * 32 + t0.b) * DSH + c];
      else pv = p.bnd[(size_t)(task - 1) * DSH + c];
      rows[c] = pv;
    }
    for (int batch = 0; batch < 2; batch++) {
      const int tb = tok0 + batch * 8;
      __syncthreads();
      for (int f = tid; f < 8 * 416; f += 256) {
        int tk = f / 416, c4 = f - tk * 416;
        *(float4*)(rows + (tk + 1) * DSH + c4 * 4) = *(const float4*)(p.R + (size_t)(tb + tk) * RS + c4 * 4);
      }
      __syncthreads();
      for (int idx = tid; idx < 1024; idx += 256) {
        int tk = idx >> 7, ii = idx & 127;
        int col = 1536 + ii;
        float cur = rows[(tk + 1) * DSH + col], prv = rows[tk * DSH + col];
        float m = cur + (prv - cur) * mu[col];
        if (ii < 64) tw[tk * 64 + ii] = 1.f - 2.f * __builtin_amdgcn_rcpf(1.f + __expf(2.f * m));
        else ta[tk * 64 + ii - 64] = m;
      }
      __syncthreads();
      float accw[2][8], acca[2][8];
#pragma unroll
      for (int ch = 0; ch < 2; ch++) {
        const int c = tid + 256 * ch;
        const float bw = p.w0[l * 512 + c], ba = p.a0[l * 512 + c];
#pragma unroll
        for (int tk = 0; tk < 8; tk++) { accw[ch][tk] = bw; acca[ch][tk] = ba; }
      }
      for (int i4 = 0; i4 < 16; i4++) {
        float4 twv[8], tav[8];
#pragma unroll
        for (int tk = 0; tk < 8; tk++) {
          twv[tk] = *(const float4*)(tw + tk * 64 + i4 * 4);
          tav[tk] = *(const float4*)(ta + tk * 64 + i4 * 4);
        }
#pragma unroll
        for (int ii = 0; ii < 4; ii++) {
          const int i = i4 * 4 + ii;
#pragma unroll
          for (int ch = 0; ch < 2; ch++) {
            const int c = tid + 256 * ch;
            const float wv = w2[i * 512 + c], av = a2[i * 512 + c];
#pragma unroll
            for (int tk = 0; tk < 8; tk++) {
              const float x = ii == 0 ? twv[tk].x : ii == 1 ? twv[tk].y : ii == 2 ? twv[tk].z : twv[tk].w;
              const float y = ii == 0 ? tav[tk].x : ii == 1 ? tav[tk].y : ii == 2 ? tav[tk].z : tav[tk].w;
              accw[ch][tk] += x * wv;
              acca[ch][tk] += y * av;
            }
          }
        }
      }
#pragma unroll
      for (int ch = 0; ch < 2; ch++) {
        const int c = tid + 256 * ch;
        const int head = wave + 4 * ch;
        const float muR = mu[c], muK = mu[512 + c], muV = mu[1024 + c];
        const float kkc = p.k_k[l * 512 + c], kac = p.k_a[l * 512 + c], rkc = p.r_k[l * 512 + c];
#pragma unroll
        for (int tk = 0; tk < 8; tk++) {
          const float* rc = rows + (tk + 1) * DSH;
          const float* rp = rows + tk * DSH;
          const float r = rc[c] + (rp[c] - rc[c]) * muR;
          const float k = rc[512 + c] + (rp[512 + c] - rc[512 + c]) * muK;
          const float v = rc[1024 + c] + (rp[1024 + c] - rc[1024 + c]) * muV;
          const float xw = -accw[ch][tk];
          const float sp = fmaxf(xw, 0.f) + __logf(1.f + __expf(-fabsf(xw)));
          const float w = -sp - 0.5f;
          const float decay = __expf(-__expf(w));
          const float ag = __builtin_amdgcn_rcpf(1.f + __expf(-acca[ch][tk]));
          const float kkr = k * kkc;
          const float ss = wave_sum(kkr * kkr);
          const float kk = kkr * fminf(__builtin_amdgcn_rsqf(ss), 1e12f);
          const float kp = k * (1.f + (ag - 1.f) * kac);
          const float bon = wave_sum(r * kp * rkc);
          float* Rrow = p.R + (size_t)(tb + tk) * RS;
          bf16_t* Rb = (bf16_t*)(Rrow + 512);
          if (!dry) {
            Rrow[c] = decay;
            Rb[c] = f2bf(r);
            Rb[512 + c] = f2bf(kp);
            Rb[1024 + c] = f2bf(v);
            Rb[1536 + c] = f2bf(-kk);
            Rb[2048 + c] = f2bf(kk * ag);
            if (lane == 0) p.bonus[(size_t)(tb + tk) * 8 + head] = bon;
          } else if (decay + r + kp + v + kk + bon == 1.2345e30f) p.wi[0] = 1.f;
        }
      }
      __syncthreads();
      for (int c = tid; c < DSH; c += 256) rows[c] = rows[8 * DSH + c];
    }
  }
}

DI void scan_task(const Params& p, int l, int isP, int b, int h, int rg, char* smem, const bool dry) {
  constexpr int BUFB = 24576 + 8192 + 2048;
  const int tid = otid(), lane = tid & 63, wave = tid >> 6;
  const int g4 = lane >> 4, jq = lane & 15;
  const int T = isP ? 8192 : 64;
  const int tokbase = isP ? b * 8192 : TP + b * 64;
  const int i = rg * 16 + wave * 4 + g4;
  f32x2 Sa = {0.f, 0.f}, Sb = {0.f, 0.f};
  if (!isP) {
    const float4 s = *(const float4*)(p.state_wkv + ((size_t)((l * 32 + b) * 8 + h) * 64 + i) * 64 + jq * 4);
    Sa = (f32x2){s.x, s.y}; Sb = (f32x2){s.z, s.w};
  }
  __builtin_amdgcn_s_setprio(3);
  const int ds = tid >> 4, dj = tid & 15;
  const int lst = (tid >> 3) & 31, lch = tid & 7;
  float4 rd0, rd1;
  uint4 qr, qk, qa, qb, rv;
  const int nch = T >> 5;
  auto gload = [&](int c) {
    const int tk = tokbase + c * 32;
    rd0 = *(const float4*)(p.R + (size_t)(tk + ds) * RS + h * 64 + dj * 4);
    rd1 = *(const float4*)(p.R + (size_t)(tk + 16 + ds) * RS + h * 64 + dj * 4);
    const bf16_t* rb = (const bf16_t*)(p.R + (size_t)(tk + lst) * RS + 512) + h * 64 + lch * 8;
    qr = *(const uint4*)(rb);
    qk = *(const uint4*)(rb + 512);
    qa = *(const uint4*)(rb + 1536);
    qb = *(const uint4*)(rb + 2048);
    if (tid < 64) {
      const int s = tid >> 1, half = tid & 1;
      rv = *(const uint4*)((const bf16_t*)(p.R + (size_t)(tk + s) * RS + 512) + 1024 + h * 64 + rg * 16 + half * 8);
    }
  };
#define CVT8(Q, LO, HI)                                                                            \
  float4 LO, HI;                                                                                   \
  LO.x = __uint_as_float((Q).x << 16); LO.y = __uint_as_float((Q).x & 0xFFFF0000u);                \
  LO.z = __uint_as_float((Q).y << 16); LO.w = __uint_as_float((Q).y & 0xFFFF0000u);                \
  HI.x = __uint_as_float((Q).z << 16); HI.y = __uint_as_float((Q).z & 0xFFFF0000u);                \
  HI.z = __uint_as_float((Q).w << 16); HI.w = __uint_as_float((Q).w & 0xFFFF0000u);
  auto sstore = [&](int bi) {
    char* bb = smem + bi * BUFB;
    *(float4*)(bb + (ds * 64 + dj * 4) * 4) = rd0;
    *(float4*)(bb + ((16 + ds) * 64 + dj * 4) * 4) = rd1;
    {
      CVT8(qa, alo, ahi)
      float* d = (float*)(bb + 8192) + lst * 64 + lch * 8;
      *(float4*)d = alo; *(float4*)(d + 4) = ahi;
    }
    {
      CVT8(qb, blo, bhi)
      float* d = (float*)(bb + 16384) + lst * 64 + lch * 8;
      *(float4*)d = blo; *(float4*)(d + 4) = bhi;
    }
    *(uint4*)(bb + 24576 + (lst * 64 + lch * 8) * 2) = qr;
    *(uint4*)(bb + 28672 + (lst * 64 + lch * 8) * 2) = qk;
    if (tid < 64) {
      const int s = tid >> 1, half = tid & 1;
      CVT8(rv, vlo, vhi)
      float* d = (float*)(bb + 32768) + s * 16 + half * 8;
      *(float4*)d = vlo; *(float4*)(d + 4) = vhi;
    }
  };
#undef CVT8
  __syncthreads();
  gload(0);
  sstore(0);
  __syncthreads();
  for (int c = 0; c < nch; c++) {
    const bool more = c + 1 < nch;
    if (more) gload(c + 1);
    const char* bb = smem + (c & 1) * BUFB;
    const float* fw = (const float*)bb + jq * 4;
    const float* fa = (const float*)(bb + 8192) + jq * 4;
    const float* fb = (const float*)(bb + 16384) + jq * 4;
    const char* pr = bb + 24576 + jq * 8;
    const char* pk = bb + 28672 + jq * 8;
    const float* vb = (const float*)(bb + 32768) + wave * 4 + g4;
    float* yo = p.yscan + (size_t)(tokbase + c * 32 + jq) * 512 + h * 64 + i;
    float ykeep0 = 0.f, ykeep1 = 0.f, yprev = 0.f;
    f32x4 w4 = *(const f32x4*)fw, a4 = *(const f32x4*)fa, b4 = *(const f32x4*)fb;
    uint2 ur = *(const uint2*)pr, uk = *(const uint2*)pk;
    float v = vb[0];
#pragma unroll
    for (int s = 0; s < 32; s++) {
      f32x4 w4n = w4, a4n = a4, b4n = b4;
      uint2 urn = ur, ukn = uk;
      float vn = v;
      if (s < 31) {
        w4n = *(const f32x4*)(fw + (s + 1) * 64);
        a4n = *(const f32x4*)(fa + (s + 1) * 64);
        b4n = *(const f32x4*)(fb + (s + 1) * 64);
        urn = *(const uint2*)(pr + (s + 1) * 128);
        ukn = *(const uint2*)(pk + (s + 1) * 128);
        vn = vb[(s + 1) * 16];
      }
      __builtin_amdgcn_sched_barrier(0);
      const f32x2 klo = {__uint_as_float(uk.x << 16), __uint_as_float(uk.x & 0xFFFF0000u)};
      const f32x2 khi = {__uint_as_float(uk.y << 16), __uint_as_float(uk.y & 0xFFFF0000u)};
      const f32x2 rlo = {__uint_as_float(ur.x << 16), __uint_as_float(ur.x & 0xFFFF0000u)};
      const f32x2 rhi = {__uint_as_float(ur.y << 16), __uint_as_float(ur.y & 0xFFFF0000u)};
      const f32x2 vv = {v, v};
      const f32x2 t = Sa * a4.lo + Sb * a4.hi;
      const f32x2 na = Sa * w4.lo + vv * klo;
      const f32x2 nb = Sb * w4.hi + vv * khi;
      float sa = t.x + t.y;
      float yp = yprev;
      rowsum16x2(sa, yp);
      if (s >= 1 && s <= 16) ykeep0 = (jq == s - 1) ? yp : ykeep0;
      if (s >= 17) ykeep1 = (jq == s - 17) ? yp : ykeep1;
      const f32x2 sv = {sa, sa};
      Sa = na + sv * b4.lo;
      Sb = nb + sv * b4.hi;
      const f32x2 yy = Sa * rlo + Sb * rhi;
      yprev = yy.x + yy.y;
      w4 = w4n; a4 = a4n; b4 = b4n; ur = urn; uk = ukn; v = vn;
    }
    {
      const float yl = rowsum16(yprev);
      ykeep1 = (jq == 15) ? yl : ykeep1;
    }
    if (!dry) { yo[0] = ykeep0; yo[(size_t)16 * 512] = ykeep1; }
    if (more) sstore((c + 1) & 1);
    __syncthreads();
  }
  float* so = isP ? p.out + O_WKVP + ((size_t)((l * 2 + b) * 8 + h) * 64 + i) * 64 + jq * 4
                  : p.out + O_WKVS + ((size_t)((l * 32 + b) * 8 + h) * 64 + i) * 64 + jq * 4;
  if (!dry) *(float4*)so = make_float4(Sa.x, Sa.y, Sb.x, Sb.y);
  __builtin_amdgcn_s_setprio(0);
}

DI void mem_task(const Params& p, int l, int tok0, char* smem, const bool dry) {
  bf16_t* st = (bf16_t*)smem;
  const int tid = otid(), lane = tid & 63, wave = tid >> 6;
  const int g4 = lane >> 4, cl = lane & 15;
  const TokInfo ti = tokinfo(tok0);
  const float* Kb = ti.isP ? p.out + O_MKP + (size_t)(l * 2 + ti.b) * 256 * 512
                           : p.cache_mem_k + (size_t)(l * 32 + ti.b) * 256 * 512;
  const bf16_t* Vb = ti.isP ? p.pmvT + (size_t)(l * 2 + ti.b) * 4 * 128 * 256
                            : p.cmvT + (size_t)(l * 32 + ti.b) * 4 * 128 * 256;
  const int q0 = tok0 + wave * 16;
  for (int h = 0; h < 4; h++) {
    bf16x8 qf[4];
#pragma unroll
    for (int ks = 0; ks < 4; ks++) qf[ks] = *(const bf16x8*)(p.qm + (size_t)(q0 + cl) * 512 + h * 128 + ks * 32 + g4 * 8);
    __syncthreads();
    {
      const float* kp = Kb + (size_t)(tid >> 5) * 512 + h * 128 + (tid & 31) * 4;
      bf16_t* sp = st + (tid >> 5) * 136 + (tid & 31) * 4;
#pragma unroll 1
      for (int hb2 = 0; hb2 < 4; hb2++) {
        float4 kv[8];
#pragma unroll
        for (int u = 0; u < 8; u++) kv[u] = *(const float4*)(kp + (size_t)u * 8 * 512);
#pragma unroll
        for (int u = 0; u < 8; u++) {
          uint2 w;
          w.x = pack2(kv[u].x, kv[u].y);
          w.y = pack2(kv[u].z, kv[u].w);
          *(uint2*)(sp + u * 8 * 136) = w;
        }
        kp += 64 * 512;
        sp += 64 * 136;
      }
    }
    __syncthreads();
    f32x4 S[16];
#pragma unroll
    for (int mt = 0; mt < 16; mt++) {
      f32x4 a = (f32x4){0.f, 0.f, 0.f, 0.f};
      const bf16_t* kr = st + (mt * 16 + cl) * 136 + g4 * 8;
#pragma unroll
      for (int ks = 0; ks < 4; ks++) a = mfma16(*(const bf16x8*)(kr + ks * 32), qf[ks], a);
      S[mt] = a;
      if ((mt & 1) == 1) __builtin_amdgcn_sched_barrier(0);
    }
    float m = -1e30f;
#pragma unroll
    for (int mt = 0; mt < 16; mt++)
#pragma unroll
      for (int r = 0; r < 4; r++) m = fmaxf(m, S[mt][r]);
    m = red4_max(m);
    float sum = 0.f;
#pragma unroll
    for (int mt = 0; mt < 16; mt++)
#pragma unroll
      for (int r = 0; r < 4; r++) {
        const float e = __expf(S[mt][r] - m);
        S[mt][r] = e;
        sum += e;
      }
    sum = red4_sum(sum);
    const float inv = __builtin_amdgcn_rcpf(sum);
    __syncthreads();
    {
      const bf16_t* vp = Vb + (size_t)h * 128 * 256 + (size_t)(tid >> 5) * 256 + (tid & 31) * 8;
      bf16_t* sp = st + (tid >> 5) * 264 + (tid & 31) * 8;
#pragma unroll 1
      for (int hb2 = 0; hb2 < 2; hb2++) {
        uint4 vv[8];
#pragma unroll
        for (int u = 0; u < 8; u++) vv[u] = *(const uint4*)(vp + (size_t)u * 8 * 256);
#pragma unroll
        for (int u = 0; u < 8; u++) *(uint4*)(sp + u * 8 * 264) = vv[u];
        vp += 64 * 256;
        sp += 64 * 264;
      }
    }
    __syncthreads();
    f32x4 o[8];
#pragma unroll
    for (int dt = 0; dt < 8; dt++) o[dt] = (f32x4){0.f, 0.f, 0.f, 0.f};
#pragma unroll
    for (int kk = 0; kk < 8; kk++) {
      union { bf16x8 v; unsigned u[4]; } pf;
      pf.u[0] = pack2(S[2 * kk][0], S[2 * kk][1]);
      pf.u[1] = pack2(S[2 * kk][2], S[2 * kk][3]);
      pf.u[2] = pack2(S[2 * kk + 1][0], S[2 * kk + 1][1]);
      pf.u[3] = pack2(S[2 * kk + 1][2], S[2 * kk + 1][3]);
#pragma unroll
      for (int dt = 0; dt < 8; dt++) {
        const bf16_t* vr = st + (dt * 16 + cl) * 264 + (2 * kk) * 16 + g4 * 4;
        union { bf16x8 v; uint2 u[2]; } vf;
        vf.u[0] = *(const uint2*)vr;
        vf.u[1] = *(const uint2*)(vr + 16);
        o[dt] = mfma16(vf.v, pf.v, o[dt]);
      }
      __builtin_amdgcn_sched_barrier(0);
    }
#pragma unroll
    for (int dt = 0; dt < 8; dt++) {
      uint2 stv;
      stv.x = pack2(o[dt][0] * inv, o[dt][1] * inv);
      stv.y = pack2(o[dt][2] * inv, o[dt][3] * inv);
      if (!dry) *(uint2*)(p.qm + (size_t)(q0 + cl) * 512 + h * 128 + dt * 16 + g4 * 4) = stv;
    }
  }
}

DI unsigned mono_key(float f) {
  const int u = __float_as_int(f + 0.0f);
  return (unsigned)u ^ ((unsigned)(u >> 31) | 0x80000000u);
}
DI float relu_(float x) { return __builtin_amdgcn_fmed3f(x, 0.f, __builtin_inff()); }

DI void dsa_task(const Params& p, int l, int isP, int b, int tq, char* smem, const bool dry) {
  unsigned* hist = (unsigned*)smem;
  unsigned short* idxl = (unsigned short*)(smem + 16384);
  unsigned short* tiel = (unsigned short*)smem;
  bf16_t* kst = (bf16_t*)(smem + 24576);
  float* pl = (float*)(smem + 24576);
  float* op = (float*)(smem + 32768);
  float* ml = (float*)(smem + 40960);
  unsigned* cnt = (unsigned*)(smem + 61440);
  unsigned* res = (unsigned*)(smem + 61504);
  unsigned* ccnt = (unsigned*)(smem + 61632);
  unsigned* ovf = (unsigned*)(smem + 61696);
  unsigned* ckey = (unsigned*)(smem + 61952);
  unsigned* cidx = (unsigned*)(smem + 66048);
  const int tid = otid(), lane = tid & 63, wave = tid >> 6;
  const int g4 = lane >> 4, cl = lane & 15;
  const int tokq0 = (isP ? b * 8192 : TP + b * 64) + tq;
  const int S = isP ? ((tq >> 6) + 1) * 64 : 2112;
  const size_t seqbase = isP ? (size_t)b * 8192 : (size_t)16384 + (size_t)b * 2112;
  const bf16_t* KIs = p.KIB + seqbase * 64;
  const bf16_t* Ks = p.KB + seqbase * 128;
  const bf16_t* Vs = p.VB + seqbase * 128;
  const int nsel = S < 256 ? S : 256;
  __syncthreads();
  if (S <= 256) {
    for (int e = tid; e < 16 * 256; e += 256) idxl[e] = (unsigned short)(e & 255);
  } else {
    const int qloc = wave * 4 + g4;
    bf16x8 aq0, aq1;
    {
      const bf16_t* qp = p.qi + ((size_t)(tokq0 + wave * 4) * 4 + cl) * 64 + g4 * 8;
      aq0 = *(const bf16x8*)qp;
      aq1 = *(const bf16x8*)(qp + 32);
    }
    const float4 wq = *(const float4*)(p.wi + (size_t)(tokq0 + qloc) * 4);
    unsigned prefix = 0u, need = 256u;
    const int nchunks = (S + 255) >> 8;
    const int skey = tid >> 3, sc8 = (tid & 7) * 8;
    for (int pass = 0; pass < 6; pass++) {
      const int kind = (pass == 2) ? 1 : (pass == 5) ? 2 : 0;
      const int shift = pass == 0 ? 24 : pass == 1 ? 16 : pass == 3 ? 8 : 0;
      if (kind == 0) {
        for (int e = tid; e < 1024; e += 256) ((uint4*)hist)[e] = make_uint4(0, 0, 0, 0);
      } else {
        if (tid < 16) { cnt[tid] = 0u; ccnt[tid] = 0u; }
        if (tid == 16) *ovf = 0u;
      }
      unsigned tiecnt = 0u;
      const unsigned G = 256u - need;
      uint4 rg0, rg1, rg2, rg3, rg4, rg5, rg6, rg7;
#define KLOAD(KC)                                                                            \
  {                                                                                          \
    const bf16_t* src = KIs + (size_t)((KC) * 256 + skey) * 64 + sc8;                        \
    const int kb0 = (KC) * 256 + skey;                                                       \
    if (kb0 < S) rg0 = *(const uint4*)(src);                                                 \
    if (kb0 + 32 < S) rg1 = *(const uint4*)(src + 32 * 64);                                  \
    if (kb0 + 64 < S) rg2 = *(const uint4*)(src + 64 * 64);                                  \
    if (kb0 + 96 < S) rg3 = *(const uint4*)(src + 96 * 64);                                  \
    if (kb0 + 128 < S) rg4 = *(const uint4*)(src + 128 * 64);                                \
    if (kb0 + 160 < S) rg5 = *(const uint4*)(src + 160 * 64);                                \
    if (kb0 + 192 < S) rg6 = *(const uint4*)(src + 192 * 64);                                \
    if (kb0 + 224 < S) rg7 = *(const uint4*)(src + 224 * 64);                                \
  }
      rg0 = rg1 = rg2 = rg3 = rg4 = rg5 = rg6 = rg7 = make_uint4(0, 0, 0, 0);
      KLOAD(0)
      for (int kc = 0; kc < nchunks; kc++) {
        __syncthreads();
        {
          bf16_t* d = kst + skey * 72 + sc8;
          *(uint4*)(d) = rg0;
          *(uint4*)(d + 32 * 72) = rg1;
          *(uint4*)(d + 64 * 72) = rg2;
          *(uint4*)(d + 96 * 72) = rg3;
          *(uint4*)(d + 128 * 72) = rg4;
          *(uint4*)(d + 160 * 72) = rg5;
          *(uint4*)(d + 192 * 72) = rg6;
          *(uint4*)(d + 224 * 72) = rg7;
        }
        __syncthreads();
        if (kc + 1 < nchunks) KLOAD(kc + 1)
        const int ngrp = (S - kc * 256) >= 256 ? 4 : ((S - kc * 256) >> 6);
        for (int tg = 0; tg < ngrp; tg++) {
          unsigned keys[4];
#pragma unroll
          for (int tt = 0; tt < 4; tt++) {
            const bf16_t* br = kst + ((tg * 4 + tt) * 16 + cl) * 72 + g4 * 8;
            const bf16x8 b0 = *(const bf16x8*)br;
            const bf16x8 b1 = *(const bf16x8*)(br + 32);
            f32x4 a = (f32x4){0.f, 0.f, 0.f, 0.f};
            a = mfma16(aq0, b0, a);
            a = mfma16(aq1, b1, a);
            const float score = wq.x * relu_(a[0]) + wq.y * relu_(a[1]) + wq.z * relu_(a[2]) + wq.w * relu_(a[3]);
            keys[tt] = mono_key(score);
          }
#pragma unroll
          for (int tt = 0; tt < 4; tt++) {
            const unsigned key = keys[tt];
            const int kidx = kc * 256 + (tg * 4 + tt) * 16 + cl;
            if (kind == 0) {
              const bool match = (pass == 0) || ((key >> (shift + 8)) == prefix);
              if (match) atomicAdd(&hist[qloc * 256 + ((key >> shift) & 255u)], 1u);
            } else if (kind == 1) {
              const unsigned hk = key >> 16;
              const bool tz = (hk == prefix) && ((key & 0xFFFFu) == 0u);
              if (hk > prefix) {
                const unsigned slot = atomicAdd(&cnt[qloc], 1u);
                if (slot < 256u) idxl[qloc * 256 + slot] = (unsigned short)kidx;
              } else if (hk == prefix && !tz) {
                const unsigned c = atomicAdd(&ccnt[qloc], 1u);
                if (c < 64u) { ckey[qloc * 64 + c] = key; cidx[qloc * 64 + c] = (unsigned)kidx; }
              }
              const unsigned long long bm = __ballot(tz);
              if (bm != 0ull) {
                const unsigned mg = (unsigned)(bm >> (g4 * 16)) & 0xFFFFu;
                const unsigned rank = tiecnt + __popc(mg & ((1u << cl) - 1u));
                if (tz && rank < need) tiel[qloc * 256 + rank] = (unsigned short)kidx;
                tiecnt += __popc(mg);
              }
            } else {
              if (key > prefix) {
                const unsigned slot = atomicAdd(&cnt[qloc], 1u);
                if (slot < 256u) idxl[qloc * 256 + slot] = (unsigned short)kidx;
              }
              const bool eq = (key == prefix);
              const unsigned long long bm = __ballot(eq);
              if (bm != 0ull) {
                const unsigned mg = (unsigned)(bm >> (g4 * 16)) & 0xFFFFu;
                const unsigned rank = tiecnt + __popc(mg & ((1u << cl) - 1u));
                if (eq && rank < need) idxl[qloc * 256 + G + rank] = (unsigned short)kidx;
                tiecnt += __popc(mg);
              }
            }
          }
        }
      }
#undef KLOAD
      __syncthreads();
      if (kind == 0) {
        const unsigned* hq = hist + qloc * 256;
        const int top = 255 - 16 * cl;
        unsigned sum = 0u;
#pragma unroll
        for (int u = 0; u < 16; u++) sum += hq[top - u];
        unsigned incl = sum;
#pragma unroll
        for (int d = 1; d < 16; d <<= 1) {
          const unsigned t = __shfl_up(incl, d, 16);
          if (cl >= d) incl += t;
        }
        const unsigned excl = incl - sum;
        if (excl < need && incl >= need) {
          unsigned cum = excl;
          int bsel = top - 15;
          unsigned above = excl;
          bool found = false;
#pragma unroll
          for (int u = 0; u < 16; u++) {
            const unsigned c = hq[top - u];
            if (!found && cum + c >= need) { bsel = top - u; above = cum; found = true; }
            cum += c;
          }
          res[qloc * 2] = (unsigned)bsel;
          res[qloc * 2 + 1] = above;
        }
        __syncthreads();
        const unsigned bstar = res[qloc * 2], above = res[qloc * 2 + 1];
        need -= above;
        prefix = (prefix << 8) | bstar;
      } else if (kind == 1) {
        const unsigned c = ccnt[qloc];
        if (c > 64u) {
          if (cl == 0) *ovf = 1u;
        } else {
          for (unsigned i = cl; i < c; i += 16) {
            const unsigned ki = ckey[qloc * 64 + i], ii = cidx[qloc * 64 + i];
            unsigned rank = 0u;
            for (unsigned j = 0; j < c; j++) {
              const unsigned kj = ckey[qloc * 64 + j], ij = cidx[qloc * 64 + j];
              rank += (kj > ki || (kj == ki && ij < ii)) ? 1u : 0u;
            }
            if (rank < need) idxl[qloc * 256 + G + rank] = (unsigned short)ii;
          }
          const unsigned nso = c < need ? c : need;
          for (unsigned t = cl; t < need - nso; t += 16) idxl[qloc * 256 + G + nso + t] = tiel[qloc * 256 + t];
        }
        __syncthreads();
        if (*ovf == 0u) break;
      }
    }
  }
  __syncthreads();
  float* opq = (float*)smem;
  float* mlq = (float*)(smem + 61952);
  char* vst = smem + 24576 + wave * 9216;
  const bool active = wave * 64 < nsel;
  uint4 vq0, vq1, vq2, vq3, vq4, vq5, vq6, vq7, vq8, vq9, vq10, vq11, vq12, vq13, vq14, vq15;
  bf16x8 kf[2][4][2];
  if (active) {
    vq0 = *(const uint4*)(Vs + (size_t)idxl[wave * 64 + 0 + g4] * 128 + cl * 8);
    vq1 = *(const uint4*)(Vs + (size_t)idxl[wave * 64 + 4 + g4] * 128 + cl * 8);
    vq2 = *(const uint4*)(Vs + (size_t)idxl[wave * 64 + 8 + g4] * 128 + cl * 8);
    vq3 = *(const uint4*)(Vs + (size_t)idxl[wave * 64 + 12 + g4] * 128 + cl * 8);
    vq4 = *(const uint4*)(Vs + (size_t)idxl[wave * 64 + 16 + g4] * 128 + cl * 8);
    vq5 = *(const uint4*)(Vs + (size_t)idxl[wave * 64 + 20 + g4] * 128 + cl * 8);
    vq6 = *(const uint4*)(Vs + (size_t)idxl[wave * 64 + 24 + g4] * 128 + cl * 8);
    vq7 = *(const uint4*)(Vs + (size_t)idxl[wave * 64 + 28 + g4] * 128 + cl * 8);
    vq8 = *(const uint4*)(Vs + (size_t)idxl[wave * 64 + 32 + g4] * 128 + cl * 8);
    vq9 = *(const uint4*)(Vs + (size_t)idxl[wave * 64 + 36 + g4] * 128 + cl * 8);
    vq10 = *(const uint4*)(Vs + (size_t)idxl[wave * 64 + 40 + g4] * 128 + cl * 8);
    vq11 = *(const uint4*)(Vs + (size_t)idxl[wave * 64 + 44 + g4] * 128 + cl * 8);
    vq12 = *(const uint4*)(Vs + (size_t)idxl[wave * 64 + 48 + g4] * 128 + cl * 8);
    vq13 = *(const uint4*)(Vs + (size_t)idxl[wave * 64 + 52 + g4] * 128 + cl * 8);
    vq14 = *(const uint4*)(Vs + (size_t)idxl[wave * 64 + 56 + g4] * 128 + cl * 8);
    vq15 = *(const uint4*)(Vs + (size_t)idxl[wave * 64 + 60 + g4] * 128 + cl * 8);
#pragma unroll
    for (int tt = 0; tt < 4; tt++) {
      const int pos = idxl[wave * 64 + tt * 16 + cl];
#pragma unroll
      for (int j = 0; j < 2; j++) {
        const bf16_t* kr = Ks + (size_t)pos * 128 + j * 64 + g4 * 8;
        kf[j][tt][0] = *(const bf16x8*)kr;
        kf[j][tt][1] = *(const bf16x8*)(kr + 32);
      }
    }
  }
  for (int qq = 0; qq < 16; qq++) {
    const int tok = tokq0 + qq;
    const int qn = qq < 15 ? qq + 1 : 15;
    float* opb = opq + (qq & 1) * 2048;
    float* mlb = mlq + (qq & 1) * 64;
    if (active) {
      union PB { bf16x8 v; unsigned u[4]; };
      PB pb[2][2];
#pragma unroll
      for (int j = 0; j < 2; j++) {
        const bf16_t* qp = p.qa + (size_t)tok * 512 + (j * 4 + (cl & 3)) * 64 + g4 * 8;
        const bf16x8 bq0 = *(const bf16x8*)qp;
        const bf16x8 bq1 = *(const bf16x8*)(qp + 32);
        f32x4 lg[4];
#pragma unroll
        for (int tt = 0; tt < 4; tt++) {
          f32x4 a = (f32x4){0.f, 0.f, 0.f, 0.f};
          a = mfma16(kf[j][tt][0], bq0, a);
          a = mfma16(kf[j][tt][1], bq1, a);
          lg[tt] = a;
        }
        float m = -1e30f;
#pragma unroll
        for (int tt = 0; tt < 4; tt++)
#pragma unroll
          for (int r = 0; r < 4; r++) m = fmaxf(m, lg[tt][r]);
        m = red4_max(m);
        float sum = 0.f;
#pragma unroll
        for (int tt = 0; tt < 4; tt++)
#pragma unroll
          for (int r = 0; r < 4; r++) {
            const float e = __expf(lg[tt][r] - m);
            lg[tt][r] = e;
            sum += e;
          }
        sum = red4_sum(sum);
#pragma unroll
        for (int sI = 0; sI < 2; sI++) {
          pb[j][sI].u[0] = pack2(lg[2 * sI][0], lg[2 * sI][1]);
          pb[j][sI].u[1] = pack2(lg[2 * sI][2], lg[2 * sI][3]);
          pb[j][sI].u[2] = pack2(lg[2 * sI + 1][0], lg[2 * sI + 1][1]);
          pb[j][sI].u[3] = pack2(lg[2 * sI + 1][2], lg[2 * sI + 1][3]);
        }
        if (cl < 4 && g4 == 0) {
          mlb[(wave * 8 + j * 4 + cl) * 2] = m;
          mlb[(wave * 8 + j * 4 + cl) * 2 + 1] = sum;
        }
      }
#pragma unroll
      for (int tt = 0; tt < 4; tt++) {
        const int pos = idxl[qn * 256 + wave * 64 + tt * 16 + cl];
#pragma unroll
        for (int j = 0; j < 2; j++) {
          const bf16_t* kr = Ks + (size_t)pos * 128 + j * 64 + g4 * 8;
          kf[j][tt][0] = *(const bf16x8*)kr;
          kf[j][tt][1] = *(const bf16x8*)(kr + 32);
        }
      }
      f32x4 o[2][4];
#pragma unroll
      for (int j = 0; j < 2; j++)
#pragma unroll
        for (int dt = 0; dt < 4; dt++) o[j][dt] = (f32x4){0.f, 0.f, 0.f, 0.f};
      const lds_cptr vb = (lds_cptr)(vst + (g4 * 4 + (cl >> 2)) * 288 + (cl & 3) * 8);
      {
        *(uint4*)(vst + (0 + g4) * 288 + cl * 16) = vq0;
        *(uint4*)(vst + (4 + g4) * 288 + cl * 16) = vq1;
        *(uint4*)(vst + (8 + g4) * 288 + cl * 16) = vq2;
        *(uint4*)(vst + (12 + g4) * 288 + cl * 16) = vq3;
        *(uint4*)(vst + (16 + g4) * 288 + cl * 16) = vq4;
        *(uint4*)(vst + (20 + g4) * 288 + cl * 16) = vq5;
        *(uint4*)(vst + (24 + g4) * 288 + cl * 16) = vq6;
        *(uint4*)(vst + (28 + g4) * 288 + cl * 16) = vq7;
        __builtin_amdgcn_wave_barrier();
#pragma unroll
        for (int j = 0; j < 2; j++)
#pragma unroll
          for (int dt = 0; dt < 4; dt++) {
            const s16x4 alo = vtr(vb + (j * 64 + dt * 16) * 2);
            const s16x4 ahi = vtr(vb + (j * 64 + dt * 16) * 2 + 16 * 288);
            const bf16x8 af = __builtin_shufflevector(alo, ahi, 0, 1, 2, 3, 4, 5, 6, 7);
            o[j][dt] = mfma16(af, pb[j][0].v, o[j][dt]);
          }
        __builtin_amdgcn_wave_barrier();
      }
      {
        *(uint4*)(vst + (0 + g4) * 288 + cl * 16) = vq8;
        *(uint4*)(vst + (4 + g4) * 288 + cl * 16) = vq9;
        *(uint4*)(vst + (8 + g4) * 288 + cl * 16) = vq10;
        *(uint4*)(vst + (12 + g4) * 288 + cl * 16) = vq11;
        *(uint4*)(vst + (16 + g4) * 288 + cl * 16) = vq12;
        *(uint4*)(vst + (20 + g4) * 288 + cl * 16) = vq13;
        *(uint4*)(vst + (24 + g4) * 288 + cl * 16) = vq14;
        *(uint4*)(vst + (28 + g4) * 288 + cl * 16) = vq15;
        __builtin_amdgcn_wave_barrier();
#pragma unroll
        for (int j = 0; j < 2; j++)
#pragma unroll
          for (int dt = 0; dt < 4; dt++) {
            const s16x4 alo = vtr(vb + (j * 64 + dt * 16) * 2);
            const s16x4 ahi = vtr(vb + (j * 64 + dt * 16) * 2 + 16 * 288);
            const bf16x8 af = __builtin_shufflevector(alo, ahi, 0, 1, 2, 3, 4, 5, 6, 7);
            o[j][dt] = mfma16(af, pb[j][1].v, o[j][dt]);
          }
        __builtin_amdgcn_wave_barrier();
      }
      vq0 = *(const uint4*)(Vs + (size_t)idxl[qn * 256 + wave * 64 + 0 + g4] * 128 + cl * 8);
      vq1 = *(const uint4*)(Vs + (size_t)idxl[qn * 256 + wave * 64 + 4 + g4] * 128 + cl * 8);
      vq2 = *(const uint4*)(Vs + (size_t)idxl[qn * 256 + wave * 64 + 8 + g4] * 128 + cl * 8);
      vq3 = *(const uint4*)(Vs + (size_t)idxl[qn * 256 + wave * 64 + 12 + g4] * 128 + cl * 8);
      vq4 = *(const uint4*)(Vs + (size_t)idxl[qn * 256 + wave * 64 + 16 + g4] * 128 + cl * 8);
      vq5 = *(const uint4*)(Vs + (size_t)idxl[qn * 256 + wave * 64 + 20 + g4] * 128 + cl * 8);
      vq6 = *(const uint4*)(Vs + (size_t)idxl[qn * 256 + wave * 64 + 24 + g4] * 128 + cl * 8);
      vq7 = *(const uint4*)(Vs + (size_t)idxl[qn * 256 + wave * 64 + 28 + g4] * 128 + cl * 8);
      vq8 = *(const uint4*)(Vs + (size_t)idxl[qn * 256 + wave * 64 + 32 + g4] * 128 + cl * 8);
      vq9 = *(const uint4*)(Vs + (size_t)idxl[qn * 256 + wave * 64 + 36 + g4] * 128 + cl * 8);
      vq10 = *(const uint4*)(Vs + (size_t)idxl[qn * 256 + wave * 64 + 40 + g4] * 128 + cl * 8);
      vq11 = *(const uint4*)(Vs + (size_t)idxl[qn * 256 + wave * 64 + 44 + g4] * 128 + cl * 8);
      vq12 = *(const uint4*)(Vs + (size_t)idxl[qn * 256 + wave * 64 + 48 + g4] * 128 + cl * 8);
      vq13 = *(const uint4*)(Vs + (size_t)idxl[qn * 256 + wave * 64 + 52 + g4] * 128 + cl * 8);
      vq14 = *(const uint4*)(Vs + (size_t)idxl[qn * 256 + wave * 64 + 56 + g4] * 128 + cl * 8);
      vq15 = *(const uint4*)(Vs + (size_t)idxl[qn * 256 + wave * 64 + 60 + g4] * 128 + cl * 8);
      if (cl < 4) {
#pragma unroll
        for (int j = 0; j < 2; j++)
#pragma unroll
          for (int dt = 0; dt < 4; dt++) *(f32x4*)(opb + (wave * 8 + j * 4 + cl) * 64 + dt * 16 + g4 * 4) = o[j][dt];
      }
    } else {
      if (lane < 8) {
        mlb[(wave * 8 + lane) * 2] = -1e30f;
        mlb[(wave * 8 + lane) * 2 + 1] = 0.f;
      }
      *(f32x4*)(opb + wave * 512 + lane * 8) = (f32x4){0.f, 0.f, 0.f, 0.f};
      *(f32x4*)(opb + wave * 512 + lane * 8 + 4) = (f32x4){0.f, 0.f, 0.f, 0.f};
    }
    __syncthreads();
    {
      const int e = tid * 2, head = e >> 6, d = e & 63;
      float M = -1e30f;
#pragma unroll
      for (int w = 0; w < 4; w++) M = fmaxf(M, mlb[(w * 8 + head) * 2]);
      float den = 0.f, n0 = 0.f, n1 = 0.f;
#pragma unroll
      for (int w = 0; w < 4; w++) {
        const float f = __expf(mlb[(w * 8 + head) * 2] - M);
        den += mlb[(w * 8 + head) * 2 + 1] * f;
        const float2 o2 = *(const float2*)(opb + (w * 8 + head) * 64 + d);
        n0 += o2.x * f;
        n1 += o2.y * f;
      }
      const float inv = __builtin_amdgcn_rcpf(den);
      if (!dry) *(unsigned*)(p.qa + (size_t)tok * 512 + e) = pack2(n0 * inv, n1 * inv);
    }
  }
  __syncthreads();
}

DI void mixer_phase(const Params& p, int l, char* smem, const bool dry = false, const int ci = 0) {
  const int tid = otid();
  const int NTASK = 64 + 1024 + 1024 + 128 + 288;
  const int NEXTRA = (l == 0 && !dry) ? 456 : 0;
  bool first = true;
  for (;;) {
    int id;
    if (first && blockIdx.x < 64) {
      id = blockIdx.x;
    } else {
      __syncthreads();
      if (tid == 0) *(int*)(smem + SLOT) = 64 + (int)atomicAdd(&p.ctr[l + ci], 1u);
      __syncthreads();
      id = *(const int*)(smem + SLOT);
    }
    first = false;
    if (id >= NTASK + NEXTRA) break;
    if (id >= NTASK) {
      for (int q = 0; q < 8; q++) {
        const int d = (id - NTASK) * 8 + q;
        const int t = d < 1984 ? 2880 + d : d < 2624 ? 2880 + 2240 + (d - 1984) : 5760 + 1024 + (d - 2624);
        transpose_job(p, t, (float*)smem);
      }
      continue;
    }
    const int d = id - 64;
    if (id < 64 || d >= 1440) {
      int isP, b, h, rg;
      if (id < 64) { isP = 1; b = id >> 5; h = (id >> 2) & 7; rg = id & 3; }
      else { const int s = d - 1440; isP = 0; b = s >> 5; h = (s >> 2) & 7; rg = s & 3; }
      if (!(dry && (PROBE_SKIP & 2))) scan_task(p, l, isP, b, h, rg, smem, dry);
    } else if (d < 896 || d >= 1184) {
      int isP, b, tq;
      if (d < 768) { isP = 1; b = d & 1; tq = (511 - (d >> 1)) * 16; }
      else if (d < 896) { const int s = d - 768; isP = 0; b = s >> 2; tq = (s & 3) * 16; }
      else { const int s = d - 1184; isP = 1; b = s & 1; tq = (127 - (s >> 1)) * 16; }
      if (!(dry && (PROBE_SKIP & 1))) dsa_task(p, l, isP, b, tq, smem, dry);
    } else {
      if (!(dry && (PROBE_SKIP & 4))) mem_task(p, l, (d - 896) * 64, smem, dry);
    }
  }
}

DI void post_phase(const Params& p, int l) {
  const int tid = otid(), lane = tid & 63, wave = tid >> 6;
  for (int tok = blockIdx.x * 4 + wave; tok < TOK; tok += gridDim.x * 4) {
    float y[8], lw[8], lb[8], vv[8], bo[8];
    const bf16_t* vb = (const bf16_t*)(p.R + (size_t)tok * RS + 512) + 1024;
#pragma unroll
    for (int h = 0; h < 8; h++) {
      const int c = h * 64 + lane;
      y[h] = p.yscan[(size_t)tok * 512 + c];
      lw[h] = p.ln_w[l * 512 + c];
      lb[h] = p.ln_b[l * 512 + c];
      vv[h] = bf2f(vb[c]);
      bo[h] = p.bonus[(size_t)tok * 8 + h];
    }
#pragma unroll
    for (int h = 0; h < 8; h++) {
      const float mean = wave_sum(y[h]) * (1.f / 64.f);
      const float dv = y[h] - mean;
      const float var = wave_sum(dv * dv) * (1.f / 64.f);
      const float yn = dv * rsqrtf(var + 64e-5f) * lw[h] + lb[h];
      y[h] = yn + bo[h] * vv[h];
    }
#pragma unroll
    for (int h = 0; h < 8; h++) p.o_r[(size_t)tok * 512 + h * 64 + lane] = f2bf(y[h]);
  }
}

DI void gemm2_phase(const Params& p, int l, char* smem, const bool dry = false) {
  bf16_t* sm = (bf16_t*)smem;
  const int tid = otid(), lane = tid & 63, wave = tid >> 6;
  const int wm = wave >> 1, wn = wave & 1, g4 = lane >> 4, cl = lane & 15;
  const int slots = gridDim.x >> 3, slot = blockIdx.x >> 3;
  for (int e = slot;; e += slots) {
    int mt, nt;
    if (!xcd_tile(e, 36, mt, nt)) break;
    f32x4 acc[4][4];
    zero_acc(acc);
    gemm_kloop(p.hb + (size_t)mt * 128 * DM, DM, p.Wt2 + ((size_t)l * N2 + nt * 128) * DM, DM, DM, sm, acc);
    const int nb = nt * 128 + wn * 64;
    if (dry) {
      if (acc[0][0][0] == 1.2345e30f) p.wi[0] = acc[1][1][1] + acc[2][2][2] + acc[3][3][3];
    } else if (nb < 1536) {
      bf16_t* base = (nb < 512 ? p.qa : nb < 1024 ? p.o_r : p.qm) + (nb & 511) + cl;
      bf16_t old[4][4][4];
#pragma unroll
      for (int i = 0; i < 4; i++)
#pragma unroll
        for (int r = 0; r < 4; r++) {
          const int tok = mt * 128 + wm * 64 + i * 16 + g4 * 4 + r;
#pragma unroll
          for (int jn = 0; jn < 4; jn++) old[i][r][jn] = base[(size_t)tok * 512 + jn * 16];
        }
#pragma unroll
      for (int i = 0; i < 4; i++)
#pragma unroll
        for (int r = 0; r < 4; r++) {
          const int tok = mt * 128 + wm * 64 + i * 16 + g4 * 4 + r;
#pragma unroll
          for (int jn = 0; jn < 4; jn++) base[(size_t)tok * 512 + jn * 16] = f2bf(bf2f(old[i][r][jn]) * siluf_(acc[i][jn][r]));
        }
    } else {
#pragma unroll
      for (int i = 0; i < 4; i++)
#pragma unroll
        for (int r = 0; r < 4; r++) {
          const int tok = mt * 128 + wm * 64 + i * 16 + g4 * 4 + r;
#pragma unroll
          for (int jn = 0; jn < 4; jn++)
            p.G[(size_t)tok * 3072 + nb - 1536 + jn * 16 + cl] = f2bf(sigmoidf_(acc[i][jn][r]));
        }
    }
  }
}

DI void merge_phase(const Params& p, int l, char* smem) {
  bf16_t* sm = (bf16_t*)smem;
  const int tid = otid(), lane = tid & 63, wave = tid >> 6;
  const int g4 = lane >> 4, cl = lane & 15;
  const int slots = gridDim.x >> 3, slot = blockIdx.x >> 3;
  for (int e = slot;; e += slots) {
    int mt, nt;
    if (!xcd_tile(e, 16, mt, nt)) break;
    f32x4 tot[2][4];
#pragma unroll
    for (int i = 0; i < 2; i++)
#pragma unroll
      for (int j = 0; j < 4; j++) tot[i][j] = (f32x4){0.f, 0.f, 0.f, 0.f};
#pragma unroll 1
    for (int br = 0; br < 3; br++) {
      f32x4 acc[2][4];
#pragma unroll
      for (int i = 0; i < 2; i++)
#pragma unroll
        for (int j = 0; j < 4; j++) acc[i][j] = (f32x4){0.f, 0.f, 0.f, 0.f};
      const bf16_t* A = (br == 0 ? p.qa : br == 1 ? p.o_r : p.qm) + (size_t)mt * 128 * 512;
      gemm_kloop64(A, 512, p.Wbr + ((size_t)(l * 3 + br) * DM + nt * 64) * 512, 512, 512, sm, acc);
#pragma unroll
      for (int i = 0; i < 2; i++)
#pragma unroll
        for (int r = 0; r < 4; r++) {
          const int tok = mt * 128 + wave * 32 + i * 16 + g4 * 4 + r;
#pragma unroll
          for (int jn = 0; jn < 4; jn++) {
            const int n = nt * 64 + jn * 16 + cl;
            const float g = bf2f(p.G[(size_t)tok * 3072 + br * 1024 + n]);
            tot[i][jn][r] += g * acc[i][jn][r];
          }
        }
    }
#pragma unroll
    for (int i = 0; i < 2; i++)
#pragma unroll
      for (int r = 0; r < 4; r++) {
        const int tok = mt * 128 + wave * 32 + i * 16 + g4 * 4 + r;
#pragma unroll
        for (int jn = 0; jn < 4; jn++) {
          const int n = nt * 64 + jn * 16 + cl;
          p.merged[(size_t)tok * DM + n] = f2bf(tot[i][jn][r]);
        }
      }
  }
}

DI void out_phase(const Params& p, int l, char* smem, const bool dry = false) {
  bf16_t* sm = (bf16_t*)smem;
  const int tid = otid(), lane = tid & 63, wave = tid >> 6;
  const int wm = wave >> 1, wn = wave & 1, g4 = lane >> 4, cl = lane & 15;
  const int slots = gridDim.x >> 3, slot = blockIdx.x >> 3;
  for (int e = slot;; e += slots) {
    int mt, nt;
    if (!xcd_tile(e, 8, mt, nt)) break;
    f32x4 acc[4][4];
    zero_acc(acc);
    gemm_kloop(p.merged + (size_t)mt * 128 * DM, DM, p.Wout + ((size_t)l * DM + nt * 128) * DM, DM, DM, sm, acc);
    if (dry) {
      if (acc[0][0][0] == 1.2345e30f) p.wi[0] = acc[1][1][1] + acc[2][2][2] + acc[3][3][3];
      continue;
    }
    float xo[4][4][4];
#pragma unroll
    for (int i = 0; i < 4; i++)
#pragma unroll
      for (int r = 0; r < 4; r++) {
        const int tok = mt * 128 + wm * 64 + i * 16 + g4 * 4 + r;
        const float* xr = xrow_ptr(p, l, tok);
#pragma unroll
        for (int jn = 0; jn < 4; jn++) xo[i][r][jn] = xr[nt * 128 + wn * 64 + jn * 16 + cl];
      }
#pragma unroll
    for (int i = 0; i < 4; i++)
#pragma unroll
      for (int r = 0; r < 4; r++) {
        const int tok = mt * 128 + wm * 64 + i * 16 + g4 * 4 + r;
#pragma unroll
        for (int jn = 0; jn < 4; jn++) {
          const int n = nt * 128 + wn * 64 + jn * 16 + cl;
          p.out[(size_t)tok * DM + n] = xo[i][r][jn] + acc[i][jn][r];
        }
      }
  }
}

DI void norm_phase(const Params& p, int l) {
  const int wave = otid() >> 6;
  for (int tok = blockIdx.x * 4 + wave; tok < TOK; tok += gridDim.x * 4)
    norm_row_bf16(xrow_ptr(p, l, tok), p.norm_g + l * DM, p.hb + (size_t)tok * DM);
}
DI void final_phase(const Params& p) {
  const int lane = otid() & 63, wave = otid() >> 6;
  for (int tok = blockIdx.x * 4 + wave; tok < TOK; tok += gridDim.x * 4) {
    float* x = p.out + (size_t)tok * DM;
    float4 v[4];
    float ss = 0.f;
#pragma unroll
    for (int i = 0; i < 4; i++) {
      v[i] = *(const float4*)(x + i * 256 + lane * 4);
      ss += v[i].x * v[i].x + v[i].y * v[i].y + v[i].z * v[i].z + v[i].w * v[i].w;
    }
    ss = wave_sum(ss);
    const float rstd = rsqrtf(ss * (1.f / 1024.f) + 1e-6f);
#pragma unroll
    for (int i = 0; i < 4; i++) {
      const float4 g = *(const float4*)(p.final_g + i * 256 + lane * 4);
      *(float4*)(x + i * 256 + lane * 4) = make_float4(v[i].x * rstd * g.x, v[i].y * rstd * g.y, v[i].z * rstd * g.z, v[i].w * rstd * g.w);
    }
  }
}

__global__ void __launch_bounds__(256, 2) mega(Params pk) {
  const Params& p = *(const Params*)__builtin_amdgcn_kernarg_segment_ptr();
  cg::grid_group grid = cg::this_grid();
  __shared__ __attribute__((aligned(16))) char smem[SMEM];
  phase0(p, smem);
  grid.sync();
  GBar gb;
  gbar_init(gb, p.ctr);
#ifndef PROBE_DUP
#define PROBE_DUP 0
#endif
  const bool dryv = PROBE_DUP ? (*(volatile unsigned*)&p.ctr[7] == 0u) : false;
  if (PROBE_DUP & 1) { phase0(p, smem); gbar(gb); }
  for (int l = 0; l < 2; l++) {
    if (l == 1) { norm_phase(p, 1); convert_caches(p, 1); gbar(gb); }
    if (PROBE_DUP & 2) { gemm1_phase(p, l, smem); gbar(gb); }
    gemm1_phase(p, l, smem);
    gbar(gb);
    if (PROBE_DUP & 4) { prep_phase(p, l, smem, dryv); gbar(gb); }
    prep_phase(p, l, smem);
    gbar(gb);
    if (PROBE_DUP & 8) { mixer_phase(p, l, smem, dryv, 2); gbar(gb); }
    mixer_phase(p, l, smem);
    gbar(gb);
    if (PROBE_DUP & 16) { post_phase(p, l); gbar(gb); }
    post_phase(p, l);
    gbar(gb);
    if (PROBE_DUP & 32) { gemm2_phase(p, l, smem, dryv); gbar(gb); }
    gemm2_phase(p, l, smem);
    gbar(gb);
    if (PROBE_DUP & 64) { merge_phase(p, l, smem); gbar(gb); }
    merge_phase(p, l, smem);
    gbar(gb);
    if (PROBE_DUP & 128) { out_phase(p, l, smem, dryv); gbar(gb); }
    out_phase(p, l, smem);
    gbar(gb);
  }
  final_phase(p);
}

extern "C" void kernel_launch(void* const* d_in, const int* in_sizes, int n_in, void* d_out, int out_size, void* d_ws,
                              size_t ws_size, hipStream_t stream) {
  Params p;
  ::memset((void*)&p, 0, sizeof(p));
  const float** f = (const float**)&p;
  for (int i = 0; i < 29; i++) f[i] = (const float*)d_in[i];
  p.out = (float*)d_out;
  char* w = (char*)d_ws;
  size_t off = 0;
  auto take = [&](size_t bytes) { char* r = w + off; off += (bytes + 255) & ~(size_t)255; return r; };
  p.Wt1 = (bf16_t*)take((size_t)2 * N1 * DM * 2);
  p.Wt2 = (bf16_t*)take((size_t)2 * N2 * DM * 2);
  p.Wmem = (bf16_t*)take((size_t)2 * DM * DM * 2);
  p.Wbr = (bf16_t*)take((size_t)2 * 3 * DM * 512 * 2);
  p.Wout = (bf16_t*)take((size_t)2 * DM * DM * 2);
  p.cmvT = (bf16_t*)take((size_t)2 * 32 * 4 * 128 * 256 * 2);
  p.pmvT = (bf16_t*)take((size_t)2 * 2 * 4 * 128 * 256 * 2);
  p.memn = (bf16_t*)take((size_t)2 * 512 * DM * 2);
  p.rope = (float*)take((size_t)8192 * 32 * 2 * 4);
  p.hb = (bf16_t*)take((size_t)TOK * DM * 2);
  p.qa = (bf16_t*)take((size_t)TOK * 512 * 2);
  p.qi = (bf16_t*)take((size_t)TOK * 256 * 2);
  p.qm = (bf16_t*)take((size_t)TOK * 512 * 2);
  p.o_r = (bf16_t*)take((size_t)TOK * 512 * 2);
  p.wi = (float*)take((size_t)TOK * 4 * 4);
  p.R = (float*)take((size_t)TOK * RS * 4);
  p.G = (bf16_t*)p.R;
  p.yscan = (float*)take((size_t)TOK * 512 * 4);
  p.merged = (bf16_t*)p.yscan;
  p.bnd = (float*)take((size_t)(TOK / 16) * DSH * 4);
  p.bonus = (float*)take((size_t)TOK * 8 * 4);
  p.ctr = (unsigned*)take(16384);
  p.KB = (bf16_t*)take((size_t)NROWS * 128 * 2);
  p.VB = (bf16_t*)take((size_t)NROWS * 128 * 2);
  p.KIB = (bf16_t*)take((size_t)NROWS * 64 * 2);
  if (off > ws_size) {
    fprintf(stderr, "workspace too small: need %zu have %zu\n", off, ws_size);
    return;
  }
  static int grid_blocks = 0;
  if (!grid_blocks) {
    int dev = 0, cus = 0, per_cu = 0;
    (void)hipGetDevice(&dev);
    (void)hipDeviceGetAttribute(&cus, hipDeviceAttributeMultiprocessorCount, dev);
    (void)hipOccupancyMaxActiveBlocksPerMultiprocessor(&per_cu, mega, 256, 0);
    if (per_cu > 2) per_cu = 2;
    if (per_cu < 1) per_cu = 1;
    grid_blocks = (cus * per_cu) & ~7;
  }
  (void)hipMemsetAsync(p.ctr, 0, 16384, stream);
  void* args[] = {&p};
  hipError_t e = hipLaunchCooperativeKernel((void*)mega, dim3(grid_blocks), dim3(256), args, 0, stream);
  if (e != hipSuccess) fprintf(stderr, "cooperative launch failed: %s (grid %d)\n", hipGetErrorString(e), grid_blocks);
}
```

```cpp
#include <hip/hip_runtime.h>
#include <hip/hip_cooperative_groups.h>
#include <stdint.h>
#include <stdio.h>
#include <string.h>
namespace cg = cooperative_groups;

#define DI __device__ __forceinline__
#define PROBE_SKIP 2
typedef unsigned short bf16_t;
typedef __attribute__((ext_vector_type(8))) short bf16x8;
typedef __attribute__((ext_vector_type(4))) float f32x4;
typedef __attribute__((ext_vector_type(2))) float f32x2;

constexpr int DM = 1024;
constexpr int TP = 16384;
constexpr int TOK = 18432;
constexpr int DIN = 7876;
constexpr int N1 = 3328;
constexpr int N2 = 4608;
constexpr int RS = 1792;
constexpr int DSH = 1664;
constexpr int SMEM = 73728;
constexpr int SLOT = SMEM - 16;
constexpr int NROWS = 16384 + 32 * 2112;

constexpr size_t O_Y = 0;
constexpr size_t O_KP = 18874368;
constexpr size_t O_VP = O_KP + 4194304;
constexpr size_t O_KIP = O_VP + 4194304;
constexpr size_t O_WKVP = O_KIP + 2097152;
constexpr size_t O_SHP = O_WKVP + 131072;
constexpr size_t O_MKP = O_SHP + 6656;
constexpr size_t O_MVP = O_MKP + 524288;
constexpr size_t O_KS = O_MVP + 524288;
constexpr size_t O_VS = O_KS + 524288;
constexpr size_t O_KIS = O_VS + 524288;
constexpr size_t O_WKVS = O_KIS + 262144;
constexpr size_t O_SHS = O_WKVS + 2097152;

struct Params {
  const float *x_prompt, *x_sample, *mem_prompt, *cache_k, *cache_v, *cache_kidx, *state_wkv, *state_shift,
      *cache_mem_k, *cache_mem_v, *norm_g, *w_in, *mu_shift, *w0, *w2, *a0, *a2, *k_k, *k_a, *r_k, *ln_w, *ln_b,
      *mem_norm_g, *w_mem_kv, *w_br_a, *w_br_r, *w_br_m, *w_out, *final_g;
  float* out;
  bf16_t *Wt1, *Wt2, *Wmem, *Wbr, *Wout, *cmvT, *pmvT, *memn, *hb, *qa, *qi, *qm, *o_r, *merged, *G, *KB, *VB, *KIB;
  float *rope, *wi, *R, *yscan, *bnd, *bonus;
  unsigned* ctr;
};

DI int otid() { int t = __builtin_amdgcn_workitem_id_x(); asm volatile("" : "+v"(t)); return t; }
typedef __bf16 bf16x2_t __attribute__((ext_vector_type(2)));
DI unsigned pack2(float a, float b) {
  const f32x2 v = {a, b};
  const bf16x2_t r = __builtin_convertvector(v, bf16x2_t);
  return __builtin_bit_cast(unsigned, r);
}
DI bf16_t f2bf(float f) { return (bf16_t)(pack2(f, f) & 0xFFFFu); }
DI float bf2f(bf16_t b) { return __uint_as_float(((unsigned)b) << 16); }
DI bf16x8 cvt8(const float* p) {
  float4 x = *(const float4*)p, y = *(const float4*)(p + 4);
  union { bf16x8 v; unsigned u[4]; } r;
  r.u[0] = pack2(x.x, x.y); r.u[1] = pack2(x.z, x.w); r.u[2] = pack2(y.x, y.y); r.u[3] = pack2(y.z, y.w);
  return r.v;
}
template <int CTRL> DI float dpp_add(float x) {
  int y = __builtin_amdgcn_update_dpp(0, __float_as_int(x), CTRL, 0xF, 0xF, false);
  return x + __int_as_float(y);
}
DI float rowsum16(float x) {
  x = dpp_add<0xB1>(x);
  x = dpp_add<0x4E>(x);
  x = dpp_add<0x141>(x);
  x = dpp_add<0x140>(x);
  return x;
}
DI float wave_sum(float v) {
  v = rowsum16(v);
  const float a = __int_as_float(__builtin_amdgcn_readlane(__float_as_int(v), 0));
  const float b = __int_as_float(__builtin_amdgcn_readlane(__float_as_int(v), 16));
  const float c = __int_as_float(__builtin_amdgcn_readlane(__float_as_int(v), 32));
  const float d = __int_as_float(__builtin_amdgcn_readlane(__float_as_int(v), 48));
  return (a + b) + (c + d);
}
typedef __attribute__((address_space(3))) const char* lds_cptr;
typedef short v4i16_t __attribute__((ext_vector_type(4)));
typedef __attribute__((ext_vector_type(4))) short s16x4;
DI s16x4 vtr(lds_cptr p) { return __builtin_bit_cast(s16x4, __builtin_amdgcn_ds_read_tr16_b64_v4i16((__attribute__((address_space(3))) v4i16_t*)p)); }
DI void rowsum16x2(float& x, float& z) {
  x = dpp_add<0xB1>(x);  z = dpp_add<0xB1>(z);
  x = dpp_add<0x4E>(x);  z = dpp_add<0x4E>(z);
  x = dpp_add<0x141>(x); z = dpp_add<0x141>(z);
  x = dpp_add<0x140>(x); z = dpp_add<0x140>(z);
}
typedef unsigned u32x2 __attribute__((ext_vector_type(2)));
DI float red4_sum(float x) {
  const u32x2 r = __builtin_amdgcn_permlane16_swap(__float_as_uint(x), __float_as_uint(x), false, false);
  const float s = __uint_as_float(r.x) + __uint_as_float(r.y);
  const u32x2 q = __builtin_amdgcn_permlane32_swap(__float_as_uint(s), __float_as_uint(s), false, false);
  return __uint_as_float(q.x) + __uint_as_float(q.y);
}
DI float red4_max(float x) {
  const u32x2 r = __builtin_amdgcn_permlane16_swap(__float_as_uint(x), __float_as_uint(x), false, false);
  const float s = fmaxf(__uint_as_float(r.x), __uint_as_float(r.y));
  const u32x2 q = __builtin_amdgcn_permlane32_swap(__float_as_uint(s), __float_as_uint(s), false, false);
  return fmaxf(__uint_as_float(q.x), __uint_as_float(q.y));
}
DI float sigmoidf_(float x) { return __builtin_amdgcn_rcpf(1.f + __expf(-x)); }
DI float siluf_(float x) { return x * __builtin_amdgcn_rcpf(1.f + __expf(-x)); }
DI f32x4 mfma16(bf16x8 a, bf16x8 b, f32x4 c) { return __builtin_amdgcn_mfma_f32_16x16x32_bf16(a, b, c, 0, 0, 0); }

DI const float* xrow_ptr(const Params& p, int l, int tok) {
  if (l == 0) return tok < TP ? p.x_prompt + (size_t)tok * DM : p.x_sample + (size_t)(tok - TP) * DM;
  return p.out + (size_t)tok * DM;
}


DI unsigned xcc_id() { return (unsigned)__builtin_amdgcn_s_getreg((3 << 11) | 20) & 0xFu; }
struct GBar { unsigned* w; unsigned xcc, mycen, nx, k; };
DI void gbar_init(GBar& g, unsigned* w) {
  g.w = w; g.xcc = (unsigned)__builtin_amdgcn_readfirstlane((int)xcc_id()); g.k = 0;
  unsigned nx = 0, mycen = 0;
  for (unsigned x = 0; x < 16; x++) {
    const unsigned c = __hip_atomic_load(&w[64 + 64 * x], __ATOMIC_RELAXED, __HIP_MEMORY_SCOPE_AGENT);
    if (c) nx++;
    if (x == g.xcc) mycen = c;
  }
  g.nx = (unsigned)__builtin_amdgcn_readfirstlane((int)nx);
  g.mycen = (unsigned)__builtin_amdgcn_readfirstlane((int)mycen);
}
DI void gbar(GBar& g) {
  g.k++;
  asm volatile("s_waitcnt vmcnt(0) lgkmcnt(0)" ::: "memory");
  __syncthreads();
  if (otid() == 0) {
    const unsigned a = __hip_atomic_fetch_add(&g.w[1152 + 64 * g.xcc], 1u, __ATOMIC_RELAXED, __HIP_MEMORY_SCOPE_AGENT) + 1u;
    if (a == g.k * g.mycen) {
      __builtin_amdgcn_fence(__ATOMIC_RELEASE, "agent");
      asm volatile("s_waitcnt vmcnt(0)" ::: "memory");
      __hip_atomic_fetch_add(&g.w[2240], 1u, __ATOMIC_RELAXED, __HIP_MEMORY_SCOPE_AGENT);
    }
    while (__hip_atomic_load(&g.w[2240], __ATOMIC_RELAXED, __HIP_MEMORY_SCOPE_AGENT) < g.k * g.nx) __builtin_amdgcn_s_sleep(1);
    __builtin_amdgcn_fence(__ATOMIC_ACQUIRE, "agent");
    asm volatile("s_waitcnt vmcnt(0)" ::: "memory");
  }
  __syncthreads();
}

DI int colmap(int kind, int n) {
  if (kind == 1) {
    if (n < 1092) return n;
    if (n < 1152) return -1;
    if (n < 2816) return 1604 + (n - 1152);
    return 3780 + (n - 2816);
  } else if (kind == 2) {
    if (n < 512) return 1092 + n;
    if (n < 1024) return 3268 + (n - 512);
    if (n < 1536) return 4292 + (n - 1024);
    return 4804 + (n - 1536);
  }
  return n;
}
DI void transpose_tile(const float* __restrict__ src, int ldsrc, int kind, int k0, int n0, bf16_t* __restrict__ dst,
                       int lddst, float* tile) {
  const int tid = otid();
  float v[16];
#pragma unroll
  for (int r = 0; r < 16; r++) {
    const int kk = r * 4 + (tid >> 6), nn = tid & 63;
    const int sc = colmap(kind, n0 + nn);
    v[r] = sc >= 0 ? src[(size_t)(k0 + kk) * ldsrc + sc] : 0.f;
  }
  __syncthreads();
#pragma unroll
  for (int r = 0; r < 16; r++) tile[(r * 4 + (tid >> 6)) * 65 + (tid & 63)] = v[r];
  __syncthreads();
#pragma unroll
  for (int r = 0; r < 8; r++) {
    const int nn = r * 8 + (tid >> 5), kk = (tid & 31) * 2;
    *(unsigned*)(dst + (size_t)(n0 + nn) * lddst + k0 + kk) = pack2(tile[kk * 65 + nn], tile[(kk + 1) * 65 + nn]);
  }
}
DI void norm_row_bf16(const float* __restrict__ x, const float* __restrict__ g, bf16_t* __restrict__ dst) {
  const int lane = otid() & 63;
  float4 v[4];
  float ss = 0.f;
#pragma unroll
  for (int i = 0; i < 4; i++) {
    v[i] = *(const float4*)(x + i * 256 + lane * 4);
    ss += v[i].x * v[i].x + v[i].y * v[i].y + v[i].z * v[i].z + v[i].w * v[i].w;
  }
  ss = wave_sum(ss);
  float rstd = rsqrtf(ss * (1.f / 1024.f) + 1e-6f);
#pragma unroll
  for (int i = 0; i < 4; i++) {
    float4 gg = *(const float4*)(g + i * 256 + lane * 4);
    uint2 o;
    o.x = pack2(v[i].x * rstd * gg.x, v[i].y * rstd * gg.y);
    o.y = pack2(v[i].z * rstd * gg.z, v[i].w * rstd * gg.w);
    *(uint2*)(dst + i * 256 + lane * 4) = o;
  }
}


DI void convert_caches(const Params& p, int l) {
  const int tid = otid();
  const long total = (long)32 * 2048 * 40;
  for (long e = (long)blockIdx.x * 256 + tid; e < total; e += (long)gridDim.x * 256) {
    const int row = (int)(e / 40), c = (int)(e - (long)row * 40);
    const int b = row >> 11, pos = row & 2047;
    const size_t drow = (size_t)16384 + (size_t)b * 2112 + pos;
    const size_t srow = (size_t)(l * 32 + b) * 2048 + pos;
    if (c < 16) *(bf16x8*)(p.KB + drow * 128 + c * 8) = cvt8(p.cache_k + srow * 128 + c * 8);
    else if (c < 32) *(bf16x8*)(p.VB + drow * 128 + (c - 16) * 8) = cvt8(p.cache_v + srow * 128 + (c - 16) * 8);
    else *(bf16x8*)(p.KIB + drow * 64 + (c - 32) * 8) = cvt8(p.cache_kidx + srow * 64 + (c - 32) * 8);
  }
}

DI void transpose_job(const Params& p, int t, float* tile) {
  const int NTW = 2880;
  if (t < 2 * NTW) {
    int l = t / NTW, r = t - l * NTW;
    if (r < 832) {
      int nt = r >> 4, kt = r & 15;
      transpose_tile(p.w_in + (size_t)l * DM * DIN, DIN, 1, kt * 64, nt * 64, p.Wt1 + (size_t)l * N1 * DM, DM, tile);
    } else if (r < 832 + 1152) {
      r -= 832;
      int nt = r >> 4, kt = r & 15;
      transpose_tile(p.w_in + (size_t)l * DM * DIN, DIN, 2, kt * 64, nt * 64, p.Wt2 + (size_t)l * N2 * DM, DM, tile);
    } else if (r < 832 + 1152 + 256) {
      r -= 1984;
      int nt = r >> 4, kt = r & 15;
      transpose_tile(p.w_mem_kv + (size_t)l * DM * DM, DM, 0, kt * 64, nt * 64, p.Wmem + (size_t)l * DM * DM, DM, tile);
    } else if (r < 2240 + 384) {
      r -= 2240;
      int br = r >> 7; r &= 127;
      int nt = r >> 3, kt = r & 7;
      const float* src = (br == 0 ? p.w_br_a : br == 1 ? p.w_br_r : p.w_br_m) + (size_t)l * 512 * DM;
      transpose_tile(src, DM, 0, kt * 64, nt * 64, p.Wbr + (size_t)(l * 3 + br) * DM * 512, 512, tile);
    } else {
      r -= 2624;
      int nt = r >> 4, kt = r & 15;
      transpose_tile(p.w_out + (size_t)l * DM * DM, DM, 0, kt * 64, nt * 64, p.Wout + (size_t)l * DM * DM, DM, tile);
    }
  } else {
    int r = t - 2 * NTW;
    int job = r >> 3, sub = r & 7;
    int lb = job >> 2, h = job & 3;
    int nt = sub >> 2, kt = sub & 3;
    transpose_tile(p.cache_mem_v + (size_t)lb * 256 * 512 + h * 128, 512, 0, kt * 64, nt * 64,
                   p.cmvT + (size_t)(lb * 4 + h) * 128 * 256, 256, tile);
  }
}

DI void phase0(const Params& p, char* smem) {
  const int tid = otid();
  float* tile = (float*)smem;
  if (tid == 0) __hip_atomic_fetch_add(&p.ctr[64 + 64 * xcc_id()], 1u, __ATOMIC_RELAXED, __HIP_MEMORY_SCOPE_AGENT);
  for (int t = blockIdx.x; t < 2 * 2880 + 2048; t += gridDim.x) {
    const bool deferred = (t >= 2880 && t < 5760 && !(t - 2880 >= 1984 && t - 2880 < 2240)) || (t >= 5760 + 1024);
    if (!deferred) transpose_job(p, t, tile);
  }
  convert_caches(p, 0);
  for (int e = blockIdx.x * 256 + tid; e < 8192 * 32; e += gridDim.x * 256) {
    int pos = e >> 5, i = e & 31;
    float inv = powf(10000.f, -(float)(2 * i) / 64.f);
    float ang = (float)pos * inv;
    float s, c;
    sincosf(ang, &s, &c);
    p.rope[2 * e] = c;
    p.rope[2 * e + 1] = s;
  }
  const int wave = tid >> 6;
  for (int r = blockIdx.x * 4 + wave; r < 1024 + TOK; r += gridDim.x * 4) {
    if (r < 1024) {
      int l = r >> 9, row = r & 511;
      norm_row_bf16(p.mem_prompt + (size_t)row * DM, p.mem_norm_g + l * DM, p.memn + (size_t)r * DM);
    } else {
      int tok = r - 1024;
      norm_row_bf16(xrow_ptr(p, 0, tok), p.norm_g, p.hb + (size_t)tok * DM);
    }
  }
}

constexpr int LDT = 72;
constexpr int TILE_E = 128 * LDT;
DI void gemm_kloop(const bf16_t* __restrict__ A, int lda, const bf16_t* __restrict__ B, int ldb, int K, bf16_t* sm,
                   f32x4 (&acc)[4][4]) {
  const int tid = otid(), lane = tid & 63, wave = tid >> 6;
  const int wm = wave >> 1, wn = wave & 1;
  const int lrow = tid >> 3, lkc = (tid & 7) * 8;
  const unsigned toa = (unsigned)(lrow * lda + lkc), tob = (unsigned)(lrow * ldb + lkc);
  uint4 ra0_0, ra0_1, ra0_2, ra0_3, rb0_0, rb0_1, rb0_2, rb0_3, ra1_0, ra1_1, ra1_2, ra1_3, rb1_0, rb1_1, rb1_2, rb1_3;
  const int fr = lane & 15, fk = (lane >> 4) * 8;
  const int nk = K >> 6;
#define GLOAD(RA, RB, K0)                                                   \
  {                                                                         \
    RA##_0 = *(const uint4*)((A + (size_t)(K0)) + toa);                     \
    RA##_1 = *(const uint4*)((A + (size_t)(32 * lda + (K0))) + toa);        \
    RA##_2 = *(const uint4*)((A + (size_t)(64 * lda + (K0))) + toa);        \
    RA##_3 = *(const uint4*)((A + (size_t)(96 * lda + (K0))) + toa);        \
    RB##_0 = *(const uint4*)((B + (size_t)(K0)) + tob);                     \
    RB##_1 = *(const uint4*)((B + (size_t)(32 * ldb + (K0))) + tob);        \
    RB##_2 = *(const uint4*)((B + (size_t)(64 * ldb + (K0))) + tob);        \
    RB##_3 = *(const uint4*)((B + (size_t)(96 * ldb + (K0))) + tob);        \
  }
#define SSTORE(RA, RB, BUF)                                                 \
  {                                                                         \
    bf16_t* sd = sm + (BUF) * (2 * TILE_E) + lrow * LDT + lkc;              \
    *(uint4*)(sd) = RA##_0;                                                 \
    *(uint4*)(sd + 32 * LDT) = RA##_1;                                      \
    *(uint4*)(sd + 64 * LDT) = RA##_2;                                      \
    *(uint4*)(sd + 96 * LDT) = RA##_3;                                      \
    *(uint4*)(sd + TILE_E) = RB##_0;                                        \
    *(uint4*)(sd + TILE_E + 32 * LDT) = RB##_1;                             \
    *(uint4*)(sd + TILE_E + 64 * LDT) = RB##_2;                             \
    *(uint4*)(sd + TILE_E + 96 * LDT) = RB##_3;                             \
  }
#define COMPUTE(BUF)                                                        \
  {                                                                         \
    const bf16_t* sa = sm + (BUF) * (2 * TILE_E) + (wm * 64 + fr) * LDT + fk;           \
    const bf16_t* sb = sm + (BUF) * (2 * TILE_E) + TILE_E + (wn * 64 + fr) * LDT + fk;  \
    _Pragma("unroll") for (int s = 0; s < 2; s++) {                         \
      bf16x8 af[4], bfr[4];                                                 \
      _Pragma("unroll") for (int i = 0; i < 4; i++) {                       \
        af[i] = *(const bf16x8*)(sa + i * 16 * LDT + s * 32);               \
        bfr[i] = *(const bf16x8*)(sb + i * 16 * LDT + s * 32);              \
      }                                                                     \
      _Pragma("unroll") for (int i = 0; i < 4; i++)                         \
        _Pragma("unroll") for (int j = 0; j < 4; j++) acc[i][j] = mfma16(af[i], bfr[j], acc[i][j]);  \
    }                                                                       \
  }
  __syncthreads();
  GLOAD(ra0, rb0, 0)
  GLOAD(ra1, rb1, 64)
  SSTORE(ra0, rb0, 0)
  __syncthreads();
  for (int kt = 0; kt < nk - 2; kt += 2) {
    GLOAD(ra0, rb0, (kt + 2) << 6)
    COMPUTE(0)
    SSTORE(ra1, rb1, 1)
    __syncthreads();
    GLOAD(ra1, rb1, (kt + 3) << 6)
    COMPUTE(1)
    SSTORE(ra0, rb0, 0)
    __syncthreads();
  }
  COMPUTE(0)
  SSTORE(ra1, rb1, 1)
  __syncthreads();
  COMPUTE(1)
  __syncthreads();
#undef GLOAD
#undef SSTORE
#undef COMPUTE
}
DI void zero_acc(f32x4 (&acc)[4][4]) {
#pragma unroll
  for (int i = 0; i < 4; i++)
#pragma unroll
    for (int j = 0; j < 4; j++) acc[i][j] = (f32x4){0.f, 0.f, 0.f, 0.f};
}


DI void gemm_kloop64(const bf16_t* __restrict__ A, int lda, const bf16_t* __restrict__ B, int ldb, int K, bf16_t* sm,
                     f32x4 (&acc)[2][4]) {
  const int tid = otid(), lane = tid & 63, wave = tid >> 6;
  const int lrow = tid >> 3, lkc = (tid & 7) * 8;
  const unsigned toa = (unsigned)(lrow * lda + lkc), tob = (unsigned)(lrow * ldb + lkc);
  uint4 ra0_0, ra0_1, ra0_2, ra0_3, rb0_0, rb0_1, ra1_0, ra1_1, ra1_2, ra1_3, rb1_0, rb1_1;
  const int fr = lane & 15, fk = (lane >> 4) * 8;
  const int nk = K >> 6;
#define GLOAD(RA, RB, K0)                                                   \
  {                                                                         \
    RA##_0 = *(const uint4*)((A + (size_t)(K0)) + toa);                     \
    RA##_1 = *(const uint4*)((A + (size_t)(32 * lda + (K0))) + toa);        \
    RA##_2 = *(const uint4*)((A + (size_t)(64 * lda + (K0))) + toa);        \
    RA##_3 = *(const uint4*)((A + (size_t)(96 * lda + (K0))) + toa);        \
    RB##_0 = *(const uint4*)((B + (size_t)(K0)) + tob);                     \
    RB##_1 = *(const uint4*)((B + (size_t)(32 * ldb + (K0))) + tob);        \
  }
#define SSTORE(RA, RB, BUF)                                                 \
  {                                                                         \
    bf16_t* sd = sm + (BUF) * (2 * TILE_E) + lrow * LDT + lkc;              \
    *(uint4*)(sd) = RA##_0;                                                 \
    *(uint4*)(sd + 32 * LDT) = RA##_1;                                      \
    *(uint4*)(sd + 64 * LDT) = RA##_2;                                      \
    *(uint4*)(sd + 96 * LDT) = RA##_3;                                      \
    *(uint4*)(sd + TILE_E) = RB##_0;                                        \
    *(uint4*)(sd + TILE_E + 32 * LDT) = RB##_1;                             \
  }
#define COMPUTE(BUF)                                                                            \
  {                                                                                             \
    const bf16_t* sa = sm + (BUF) * (2 * TILE_E) + (wave * 32 + fr) * LDT + fk;                 \
    const bf16_t* sb = sm + (BUF) * (2 * TILE_E) + TILE_E + fr * LDT + fk;                      \
    _Pragma("unroll") for (int s = 0; s < 2; s++) {                                             \
      bf16x8 af[2], bfr[4];                                                                     \
      _Pragma("unroll") for (int i = 0; i < 2; i++) af[i] = *(const bf16x8*)(sa + i * 16 * LDT + s * 32);   \
      _Pragma("unroll") for (int j = 0; j < 4; j++) bfr[j] = *(const bf16x8*)(sb + j * 16 * LDT + s * 32);  \
      _Pragma("unroll") for (int i = 0; i < 2; i++)                                             \
        _Pragma("unroll") for (int j = 0; j < 4; j++) acc[i][j] = mfma16(af[i], bfr[j], acc[i][j]);         \
    }                                                                                           \
  }
  __syncthreads();
  GLOAD(ra0, rb0, 0)
  GLOAD(ra1, rb1, 64)
  SSTORE(ra0, rb0, 0)
  __syncthreads();
  for (int kt = 0; kt < nk - 2; kt += 2) {
    GLOAD(ra0, rb0, (kt + 2) << 6)
    COMPUTE(0)
    SSTORE(ra1, rb1, 1)
    __syncthreads();
    GLOAD(ra1, rb1, (kt + 3) << 6)
    COMPUTE(1)
    SSTORE(ra0, rb0, 0)
    __syncthreads();
  }
  COMPUTE(0)
  SSTORE(ra1, rb1, 1)
  __syncthreads();
  COMPUTE(1)
  __syncthreads();
#undef GLOAD
#undef SSTORE
#undef COMPUTE
}

DI bool xcd_tile(int e, int NNT, int& mt, int& nt) {
  const int xcd = blockIdx.x & 7;
  const int per_mb = 9 * NNT;
  if (e >= 2 * per_mb) return false;
  const int mb = e >= per_mb ? 1 : 0;
  int r = e - mb * per_mb;
  const int full = NNT >> 3, rem = NNT & 7;
  int nb = r / 72;
  int w = 8;
  if (nb >= full) { nb = full; w = rem; }
  r -= nb * 72;
  const int mi = r / w, ni = r - mi * w;
  mt = xcd * 18 + mb * 9 + mi;
  nt = nb * 8 + ni;
  return true;
}

struct TokInfo { int isP, b, t, pos; };
DI TokInfo tokinfo(int tok) {
  TokInfo ti;
  if (tok < TP) { ti.isP = 1; ti.b = tok >> 13; ti.t = tok & 8191; ti.pos = ti.t; }
  else { int s = tok - TP; ti.isP = 0; ti.b = s >> 6; ti.t = s & 63; ti.pos = 2048 + ti.t; }
  return ti;
}

DI void gemm1_phase(const Params& p, int l, char* smem) {
  bf16_t* sm = (bf16_t*)smem;
  const int tid = otid(), lane = tid & 63, wave = tid >> 6;
  const int wm = wave >> 1, wn = wave & 1, g4 = lane >> 4, cl = lane & 15;
  const int NT1 = 144 * 26;
  const int slots = gridDim.x >> 3, slot = blockIdx.x >> 3;
  const int nmain = 18 * 26;
  const int nextra = (l == 0 ? 8 : 0);
  for (int e = slot; e < nmain + nextra; e += slots) {
    f32x4 acc[4][4];
    zero_acc(acc);
    int mt = 0, nt = 0;
    const bool is_main = xcd_tile(e, 26, mt, nt);
    const int t = is_main ? 0 : NT1 + (e - nmain) * 8 + (blockIdx.x & 7);
    if (is_main) {
      gemm_kloop(p.hb + (size_t)mt * 128 * DM, DM, p.Wt1 + ((size_t)l * N1 + nt * 128) * DM, DM, DM, sm, acc);
      const int nb = nt * 128 + wn * 64;
#pragma unroll
      for (int i = 0; i < 4; i++) {
        float2 csv[4][2];
        if (nb < 1088 && !(nb >= 640 && nb < 768)) {
#pragma unroll
          for (int r = 0; r < 4; r++) {
            const TokInfo tj = tokinfo(mt * 128 + wm * 64 + i * 16 + g4 * 4 + r);
#pragma unroll
            for (int jn = 0; jn < 2; jn++) csv[r][jn] = *(const float2*)(p.rope + (size_t)(tj.pos * 32 + jn * 16 + cl) * 2);
          }
        }
#pragma unroll
        for (int r = 0; r < 4; r++) {
          const int tok = mt * 128 + wm * 64 + i * 16 + g4 * 4 + r;
          const TokInfo ti = tokinfo(tok);
          if (nb < 1088) {
            if (nb >= 640 && nb < 768) {
              float* dst = ti.isP ? p.out + O_VP + ((size_t)(l * 2 + ti.b) * 8192 + ti.t) * 128
                                  : p.out + O_VS + ((size_t)(l * 32 + ti.b) * 64 + ti.t) * 128;
              bf16_t* dvb = p.VB + (size_t)(ti.isP ? ti.b * 8192 + ti.t : 16384 + ti.b * 2112 + 2048 + ti.t) * 128;
#pragma unroll
              for (int jn = 0; jn < 4; jn++) {
                dst[nb - 640 + jn * 16 + cl] = acc[i][jn][r];
                dvb[nb - 640 + jn * 16 + cl] = f2bf(acc[i][jn][r]);
              }
            } else {
#pragma unroll
              for (int jn = 0; jn < 2; jn++) {
                const int d = jn * 16 + cl;
                const float2 cs = csv[r][jn];
                const float x1 = acc[i][jn][r], x2 = acc[i][jn + 2][r];
                const float y1 = x1 * cs.x - x2 * cs.y, y2 = x1 * cs.y + x2 * cs.x;
                const int c1 = nb + d, c2 = nb + d + 32;
                if (nb < 512) {
                  p.qa[(size_t)tok * 512 + c1] = f2bf(y1 * 0.125f);
                  p.qa[(size_t)tok * 512 + c2] = f2bf(y2 * 0.125f);
                } else if (nb < 640) {
                  float* dst = ti.isP ? p.out + O_KP + ((size_t)(l * 2 + ti.b) * 8192 + ti.t) * 128
                                      : p.out + O_KS + ((size_t)(l * 32 + ti.b) * 64 + ti.t) * 128;
                  dst[c1 - 512] = y1;
                  dst[c2 - 512] = y2;
                  bf16_t* dkb = p.KB + (size_t)(ti.isP ? ti.b * 8192 + ti.t : 16384 + ti.b * 2112 + 2048 + ti.t) * 128;
                  dkb[c1 - 512] = f2bf(y1);
                  dkb[c2 - 512] = f2bf(y2);
                } else if (nb < 1024) {
                  p.qi[(size_t)tok * 256 + c1 - 768] = f2bf(y1 * 0.125f);
                  p.qi[(size_t)tok * 256 + c2 - 768] = f2bf(y2 * 0.125f);
                } else {
                  float* dst = ti.isP ? p.out + O_KIP + ((size_t)(l * 2 + ti.b) * 8192 + ti.t) * 64
                                      : p.out + O_KIS + ((size_t)(l * 32 + ti.b) * 64 + ti.t) * 64;
                  dst[c1 - 1024] = y1;
                  dst[c2 - 1024] = y2;
                  bf16_t* dib = p.KIB + (size_t)(ti.isP ? ti.b * 8192 + ti.t : 16384 + ti.b * 2112 + 2048 + ti.t) * 64;
                  dib[c1 - 1024] = f2bf(y1);
                  dib[c2 - 1024] = f2bf(y2);
                }
              }
            }
          } else if (nb == 1088) {
            if (cl < 4) p.wi[(size_t)tok * 4 + cl] = acc[i][0][r] * 0.5f;
          } else if (nb < 2816) {
            const int T = ti.isP ? 8192 : 64;
#pragma unroll
            for (int jn = 0; jn < 4; jn++) {
              const int c = nb - 1152 + jn * 16 + cl;
              const float v = acc[i][jn][r];
              p.R[(size_t)tok * RS + c] = v;
              if (ti.t == T - 1) {
                float* dst = ti.isP ? p.out + O_SHP + (size_t)(l * 2 + ti.b) * DSH : p.out + O_SHS + (size_t)(l * 32 + ti.b) * DSH;
                dst[c] = v;
              }
              if ((tok & 15) == 15) p.bnd[(size_t)(tok >> 4) * DSH + c] = v;
            }
          } else {
#pragma unroll
            for (int jn = 0; jn < 4; jn++)
              p.qm[(size_t)tok * 512 + nb - 2816 + jn * 16 + cl] = f2bf(acc[i][jn][r] * 0.08838834764831845f);
          }
        }
      }
    } else {
      const int u = t - NT1;
      const int lm = u >> 5, mt = (u >> 3) & 3, nt = u & 7;
      gemm_kloop(p.memn + ((size_t)lm * 512 + mt * 128) * DM, DM, p.Wmem + ((size_t)lm * DM + nt * 128) * DM, DM, DM, sm, acc);
#pragma unroll
      for (int i = 0; i < 4; i++)
#pragma unroll
        for (int r = 0; r < 4; r++) {
          const int row = mt * 128 + wm * 64 + i * 16 + g4 * 4 + r;
          const int bm = row >> 8, m = row & 255;
#pragma unroll
          for (int jn = 0; jn < 4; jn++) {
            const int n = nt * 128 + wn * 64 + jn * 16 + cl;
            const float v = acc[i][jn][r];
            if (n < 512) {
              p.out[O_MKP + ((size_t)(lm * 2 + bm) * 256 + m) * 512 + n] = v;
            } else {
              const int n2 = n - 512;
              p.out[O_MVP + ((size_t)(lm * 2 + bm) * 256 + m) * 512 + n2] = v;
              p.pmvT[((size_t)((lm * 2 + bm) * 4 + (n2 >> 7)) * 128 + (n2 & 127)) * 256 + m] = f2bf(v);
            }
          }
        }
    }
  }
}

DI void prep_phase(const Params& p, int l, char* smem, const bool dry = false) {
  float* rows = (float*)smem;
  float* tw = rows + 9 * DSH;
  float* ta = tw + 512;
  const int tid = otid(), lane = tid & 63, wave = tid >> 6;
  const float* mu = p.mu_shift + l * DSH;
  const float* w2 = p.w2 + (size_t)l * 64 * 512;
  const float* a2 = p.a2 + (size_t)l * 64 * 512;
  for (int task = blockIdx.x; task < TOK / 16; task += gridDim.x) {
    const int tok0 = task * 16;
    const TokInfo t0 = tokinfo(tok0);
    __syncthreads();
    for (int c = tid; c < DSH; c += 256) {
      float pv;
      if (t0.t == 0) pv = t0.isP ? 0.f : p.state_shift[(size_t)(l * 32 + t0.b) * DSH + c];
      else pv = p.bnd[(size_t)(task - 1) * DSH + c];
      rows[c] = pv;
    }
    for (int batch = 0; batch < 2; batch++) {
      const int tb = tok0 + batch * 8;
      __syncthreads();
      for (int f = tid; f < 8 * 416; f += 256) {
        int tk = f / 416, c4 = f - tk * 416;
        *(float4*)(rows + (tk + 1) * DSH + c4 * 4) = *(const float4*)(p.R + (size_t)(tb + tk) * RS + c4 * 4);
      }
      __syncthreads();
      for (int idx = tid; idx < 1024; idx += 256) {
        int tk = idx >> 7, ii = idx & 127;
        int col = 1536 + ii;
        float cur = rows[(tk + 1) * DSH + col], prv = rows[tk * DSH + col];
        float m = cur + (prv - cur) * mu[col];
        if (ii < 64) tw[tk * 64 + ii] = 1.f - 2.f * __builtin_amdgcn_rcpf(1.f + __expf(2.f * m));
        else ta[tk * 64 + ii - 64] = m;
      }
      __syncthreads();
      float accw[2][8], acca[2][8];
#pragma unroll
      for (int ch = 0; ch < 2; ch++) {
        const int c = tid + 256 * ch;
        const float bw = p.w0[l * 512 + c], ba = p.a0[l * 512 + c];
#pragma unroll
        for (int tk = 0; tk < 8; tk++) { accw[ch][tk] = bw; acca[ch][tk] = ba; }
      }
      for (int i4 = 0; i4 < 16; i4++) {
        float4 twv[8], tav[8];
#pragma unroll
        for (int tk = 0; tk < 8; tk++) {
          twv[tk] = *(const float4*)(tw + tk * 64 + i4 * 4);
          tav[tk] = *(const float4*)(ta + tk * 64 + i4 * 4);
        }
#pragma unroll
        for (int ii = 0; ii < 4; ii++) {
          const int i = i4 * 4 + ii;
#pragma unroll
          for (int ch = 0; ch < 2; ch++) {
            const int c = tid + 256 * ch;
            const float wv = w2[i * 512 + c], av = a2[i * 512 + c];
#pragma unroll
            for (int tk = 0; tk < 8; tk++) {
              const float x = ii == 0 ? twv[tk].x : ii == 1 ? twv[tk].y : ii == 2 ? twv[tk].z : twv[tk].w;
              const float y = ii == 0 ? tav[tk].x : ii == 1 ? tav[tk].y : ii == 2 ? tav[tk].z : tav[tk].w;
              accw[ch][tk] += x * wv;
              acca[ch][tk] += y * av;
            }
          }
        }
      }
#pragma unroll
      for (int ch = 0; ch < 2; ch++) {
        const int c = tid + 256 * ch;
        const int head = wave + 4 * ch;
        const float muR = mu[c], muK = mu[512 + c], muV = mu[1024 + c];
        const float kkc = p.k_k[l * 512 + c], kac = p.k_a[l * 512 + c], rkc = p.r_k[l * 512 + c];
#pragma unroll
        for (int tk = 0; tk < 8; tk++) {
          const float* rc = rows + (tk + 1) * DSH;
          const float* rp = rows + tk * DSH;
          const float r = rc[c] + (rp[c] - rc[c]) * muR;
          const float k = rc[512 + c] + (rp[512 + c] - rc[512 + c]) * muK;
          const float v = rc[1024 + c] + (rp[1024 + c] - rc[1024 + c]) * muV;
          const float xw = -accw[ch][tk];
          const float sp = fmaxf(xw, 0.f) + __logf(1.f + __expf(-fabsf(xw)));
          const float w = -sp - 0.5f;
          const float decay = __expf(-__expf(w));
          const float ag = __builtin_amdgcn_rcpf(1.f + __expf(-acca[ch][tk]));
          const float kkr = k * kkc;
          const float ss = wave_sum(kkr * kkr);
          const float kk = kkr * fminf(__builtin_amdgcn_rsqf(ss), 1e12f);
          const float kp = k * (1.f + (ag - 1.f) * kac);
          const float bon = wave_sum(r * kp * rkc);
          float* Rrow = p.R + (size_t)(tb + tk) * RS;
          bf16_t* Rb = (bf16_t*)(Rrow + 512);
          if (!dry) {
            Rrow[c] = decay;
            Rb[c] = f2bf(r);
            Rb[512 + c] = f2bf(kp);
            Rb[1024 + c] = f2bf(v);
            Rb[1536 + c] = f2bf(-kk);
            Rb[2048 + c] = f2bf(kk * ag);
            if (lane == 0) p.bonus[(size_t)(tb + tk) * 8 + head] = bon;
          } else if (decay + r + kp + v + kk + bon == 1.2345e30f) p.wi[0] = 1.f;
        }
      }
      __syncthreads();
      for (int c = tid; c < DSH; c += 256) rows[c] = rows[8 * DSH + c];
    }
  }
}

DI void scan_task(const Params& p, int l, int isP, int b, int h, int rg, char* smem, const bool dry) {
  constexpr int BUFB = 24576 + 8192 + 2048;
  const int tid = otid(), lane = tid & 63, wave = tid >> 6;
  const int g4 = lane >> 4, jq = lane & 15;
  const int T = isP ? 8192 : 64;
  const int tokbase = isP ? b * 8192 : TP + b * 64;
  const int i = rg * 16 + wave * 4 + g4;
  f32x2 Sa = {0.f, 0.f}, Sb = {0.f, 0.f};
  if (!isP) {
    const float4 s = *(const float4*)(p.state_wkv + ((size_t)((l * 32 + b) * 8 + h) * 64 + i) * 64 + jq * 4);
    Sa = (f32x2){s.x, s.y}; Sb = (f32x2){s.z, s.w};
  }
  __builtin_amdgcn_s_setprio(3);
  const int ds = tid >> 4, dj = tid & 15;
  const int lst = (tid >> 3) & 31, lch = tid & 7;
  float4 rd0, rd1;
  uint4 qr, qk, qa, qb, rv;
  const int nch = T >> 5;
  auto gload = [&](int c) {
    const int tk = tokbase + c * 32;
    rd0 = *(const float4*)(p.R + (size_t)(tk + ds) * RS + h * 64 + dj * 4);
    rd1 = *(const float4*)(p.R + (size_t)(tk + 16 + ds) * RS + h * 64 + dj * 4);
    const bf16_t* rb = (const bf16_t*)(p.R + (size_t)(tk + lst) * RS + 512) + h * 64 + lch * 8;
    qr = *(const uint4*)(rb);
    qk = *(const uint4*)(rb + 512);
    qa = *(const uint4*)(rb + 1536);
    qb = *(const uint4*)(rb + 2048);
    if (tid < 64) {
      const int s = tid >> 1, half = tid & 1;
      rv = *(const uint4*)((const bf16_t*)(p.R + (size_t)(tk + s) * RS + 512) + 1024 + h * 64 + rg * 16 + half * 8);
    }
  };
#define CVT8(Q, LO, HI)                                                                            \
  float4 LO, HI;                                                                                   \
  LO.x = __uint_as_float((Q).x << 16); LO.y = __uint_as_float((Q).x & 0xFFFF0000u);                \
  LO.z = __uint_as_float((Q).y << 16); LO.w = __uint_as_float((Q).y & 0xFFFF0000u);                \
  HI.x = __uint_as_float((Q).z << 16); HI.y = __uint_as_float((Q).z & 0xFFFF0000u);                \
  HI.z = __uint_as_float((Q).w << 16); HI.w = __uint_as_float((Q).w & 0xFFFF0000u);
  auto sstore = [&](int bi) {
    char* bb = smem + bi * BUFB;
    *(float4*)(bb + (ds * 64 + dj * 4) * 4) = rd0;
    *(float4*)(bb + ((16 + ds) * 64 + dj * 4) * 4) = rd1;
    {
      CVT8(qa, alo, ahi)
      float* d = (float*)(bb + 8192) + lst * 64 + lch * 8;
      *(float4*)d = alo; *(float4*)(d + 4) = ahi;
    }
    {
      CVT8(qb, blo, bhi)
      float* d = (float*)(bb + 16384) + lst * 64 + lch * 8;
      *(float4*)d = blo; *(float4*)(d + 4) = bhi;
    }
    *(uint4*)(bb + 24576 + (lst * 64 + lch * 8) * 2) = qr;
    *(uint4*)(bb + 28672 + (lst * 64 + lch * 8) * 2) = qk;
    if (tid < 64) {
      const int s = tid >> 1, half = tid & 1;
      CVT8(rv, vlo, vhi)
      float* d = (float*)(bb + 32768) + s * 16 + half * 8;
      *(float4*)d = vlo; *(float4*)(d + 4) = vhi;
    }
  };
#undef CVT8
  __syncthreads();
  gload(0);
  sstore(0);
  __syncthreads();
  for (int c = 0; c < nch; c++) {
    const bool more = c + 1 < nch;
    if (more) gload(c + 1);
    const char* bb = smem + (c & 1) * BUFB;
    const float* fw = (const float*)bb + jq * 4;
    const float* fa = (const float*)(bb + 8192) + jq * 4;
    const float* fb = (const float*)(bb + 16384) + jq * 4;
    const char* pr = bb + 24576 + jq * 8;
    const char* pk = bb + 28672 + jq * 8;
    const float* vb = (const float*)(bb + 32768) + wave * 4 + g4;
    float* yo = p.yscan + (size_t)(tokbase + c * 32 + jq) * 512 + h * 64 + i;
    float ykeep0 = 0.f, ykeep1 = 0.f, yprev = 0.f;
    f32x4 w4 = *(const f32x4*)fw, a4 = *(const f32x4*)fa, b4 = *(const f32x4*)fb;
    uint2 ur = *(const uint2*)pr, uk = *(const uint2*)pk;
    float v = vb[0];
#pragma unroll
    for (int s = 0; s < 32; s++) {
      f32x4 w4n = w4, a4n = a4, b4n = b4;
      uint2 urn = ur, ukn = uk;
      float vn = v;
      if (s < 31) {
        w4n = *(const f32x4*)(fw + (s + 1) * 64);
        a4n = *(const f32x4*)(fa + (s + 1) * 64);
        b4n = *(const f32x4*)(fb + (s + 1) * 64);
        urn = *(const uint2*)(pr + (s + 1) * 128);
        ukn = *(const uint2*)(pk + (s + 1) * 128);
        vn = vb[(s + 1) * 16];
      }
      __builtin_amdgcn_sched_barrier(0);
      const f32x2 klo = {__uint_as_float(uk.x << 16), __uint_as_float(uk.x & 0xFFFF0000u)};
      const f32x2 khi = {__uint_as_float(uk.y << 16), __uint_as_float(uk.y & 0xFFFF0000u)};
      const f32x2 rlo = {__uint_as_float(ur.x << 16), __uint_as_float(ur.x & 0xFFFF0000u)};
      const f32x2 rhi = {__uint_as_float(ur.y << 16), __uint_as_float(ur.y & 0xFFFF0000u)};
      const f32x2 vv = {v, v};
      const f32x2 t = Sa * a4.lo + Sb * a4.hi;
      const f32x2 na = Sa * w4.lo + vv * klo;
      const f32x2 nb = Sb * w4.hi + vv * khi;
      float sa = t.x + t.y;
      float yp = yprev;
      rowsum16x2(sa, yp);
      if (s >= 1 && s <= 16) ykeep0 = (jq == s - 1) ? yp : ykeep0;
      if (s >= 17) ykeep1 = (jq == s - 17) ? yp : ykeep1;
      const f32x2 sv = {sa, sa};
      Sa = na + sv * b4.lo;
      Sb = nb + sv * b4.hi;
      const f32x2 yy = Sa * rlo + Sb * rhi;
      yprev = yy.x + yy.y;
      w4 = w4n; a4 = a4n; b4 = b4n; ur = urn; uk = ukn; v = vn;
    }
    {
      const float yl = rowsum16(yprev);
      ykeep1 = (jq == 15) ? yl : ykeep1;
    }
    if (!dry) { yo[0] = ykeep0; yo[(size_t)16 * 512] = ykeep1; }
    if (more) sstore((c + 1) & 1);
    __syncthreads();
  }
  float* so = isP ? p.out + O_WKVP + ((size_t)((l * 2 + b) * 8 + h) * 64 + i) * 64 + jq * 4
                  : p.out + O_WKVS + ((size_t)((l * 32 + b) * 8 + h) * 64 + i) * 64 + jq * 4;
  if (!dry) *(float4*)so = make_float4(Sa.x, Sa.y, Sb.x, Sb.y);
  __builtin_amdgcn_s_setprio(0);
}

DI void mem_task(const Params& p, int l, int tok0, char* smem, const bool dry) {
  bf16_t* st = (bf16_t*)smem;
  const int tid = otid(), lane = tid & 63, wave = tid >> 6;
  const int g4 = lane >> 4, cl = lane & 15;
  const TokInfo ti = tokinfo(tok0);
  const float* Kb = ti.isP ? p.out + O_MKP + (size_t)(l * 2 + ti.b) * 256 * 512
                           : p.cache_mem_k + (size_t)(l * 32 + ti.b) * 256 * 512;
  const bf16_t* Vb = ti.isP ? p.pmvT + (size_t)(l * 2 + ti.b) * 4 * 128 * 256
                            : p.cmvT + (size_t)(l * 32 + ti.b) * 4 * 128 * 256;
  const int q0 = tok0 + wave * 16;
  for (int h = 0; h < 4; h++) {
    bf16x8 qf[4];
#pragma unroll
    for (int ks = 0; ks < 4; ks++) qf[ks] = *(const bf16x8*)(p.qm + (size_t)(q0 + cl) * 512 + h * 128 + ks * 32 + g4 * 8);
    __syncthreads();
    {
      const float* kp = Kb + (size_t)(tid >> 5) * 512 + h * 128 + (tid & 31) * 4;
      bf16_t* sp = st + (tid >> 5) * 136 + (tid & 31) * 4;
#pragma unroll 1
      for (int hb2 = 0; hb2 < 4; hb2++) {
        float4 kv[8];
#pragma unroll
        for (int u = 0; u < 8; u++) kv[u] = *(const float4*)(kp + (size_t)u * 8 * 512);
#pragma unroll
        for (int u = 0; u < 8; u++) {
          uint2 w;
          w.x = pack2(kv[u].x, kv[u].y);
          w.y = pack2(kv[u].z, kv[u].w);
          *(uint2*)(sp + u * 8 * 136) = w;
        }
        kp += 64 * 512;
        sp += 64 * 136;
      }
    }
    __syncthreads();
    f32x4 S[16];
#pragma unroll
    for (int mt = 0; mt < 16; mt++) {
      f32x4 a = (f32x4){0.f, 0.f, 0.f, 0.f};
      const bf16_t* kr = st + (mt * 16 + cl) * 136 + g4 * 8;
#pragma unroll
      for (int ks = 0; ks < 4; ks++) a = mfma16(*(const bf16x8*)(kr + ks * 32), qf[ks], a);
      S[mt] = a;
      if ((mt & 1) == 1) __builtin_amdgcn_sched_barrier(0);
    }
    float m = -1e30f;
#pragma unroll
    for (int mt = 0; mt < 16; mt++)
#pragma unroll
      for (int r = 0; r < 4; r++) m = fmaxf(m, S[mt][r]);
    m = red4_max(m);
    float sum = 0.f;
#pragma unroll
    for (int mt = 0; mt < 16; mt++)
#pragma unroll
      for (int r = 0; r < 4; r++) {
        const float e = __expf(S[mt][r] - m);
        S[mt][r] = e;
        sum += e;
      }
    sum = red4_sum(sum);
    const float inv = __builtin_amdgcn_rcpf(sum);
    __syncthreads();
    {
      const bf16_t* vp = Vb + (size_t)h * 128 * 256 + (size_t)(tid >> 5) * 256 + (tid & 31) * 8;
      bf16_t* sp = st + (tid >> 5) * 264 + (tid & 31) * 8;
#pragma unroll 1
      for (int hb2 = 0; hb2 < 2; hb2++) {
        uint4 vv[8];
#pragma unroll
        for (int u = 0; u < 8; u++) vv[u] = *(const uint4*)(vp + (size_t)u * 8 * 256);
#pragma unroll
        for (int u = 0; u < 8; u++) *(uint4*)(sp + u * 8 * 264) = vv[u];
        vp += 64 * 256;
        sp += 64 * 264;
      }
    }
    __syncthreads();
    f32x4 o[8];
#pragma unroll
    for (int dt = 0; dt < 8; dt++) o[dt] = (f32x4){0.f, 0.f, 0.f, 0.f};
#pragma unroll
    for (int kk = 0; kk < 8; kk++) {
      union { bf16x8 v; unsigned u[4]; } pf;
      pf.u[0] = pack2(S[2 * kk][0], S[2 * kk][1]);
      pf.u[1] = pack2(S[2 * kk][2], S[2 * kk][3]);
      pf.u[2] = pack2(S[2 * kk + 1][0], S[2 * kk + 1][1]);
      pf.u[3] = pack2(S[2 * kk + 1][2], S[2 * kk + 1][3]);
#pragma unroll
      for (int dt = 0; dt < 8; dt++) {
        const bf16_t* vr = st + (dt * 16 + cl) * 264 + (2 * kk) * 16 + g4 * 4;
        union { bf16x8 v; uint2 u[2]; } vf;
        vf.u[0] = *(const uint2*)vr;
        vf.u[1] = *(const uint2*)(vr + 16);
        o[dt] = mfma16(vf.v, pf.v, o[dt]);
      }
      __builtin_amdgcn_sched_barrier(0);
    }
#pragma unroll
    for (int dt = 0; dt < 8; dt++) {
      uint2 stv;
      stv.x = pack2(o[dt][0] * inv, o[dt][1] * inv);
      stv.y = pack2(o[dt][2] * inv, o[dt][3] * inv);
      if (!dry) *(uint2*)(p.qm + (size_t)(q0 + cl) * 512 + h * 128 + dt * 16 + g4 * 4) = stv;
    }
  }
}

DI unsigned mono_key(float f) {
  const int u = __float_as_int(f + 0.0f);
  return (unsigned)u ^ ((unsigned)(u >> 31) | 0x80000000u);
}
DI float relu_(float x) { return __builtin_amdgcn_fmed3f(x, 0.f, __builtin_inff()); }

DI void dsa_task(const Params& p, int l, int isP, int b, int tq, char* smem, const bool dry) {
  unsigned* hist = (unsigned*)smem;
  unsigned short* idxl = (unsigned short*)(smem + 16384);
  unsigned short* tiel = (unsigned short*)smem;
  bf16_t* kst = (bf16_t*)(smem + 24576);
  float* pl = (float*)(smem + 24576);
  float* op = (float*)(smem + 32768);
  float* ml = (float*)(smem + 40960);
  unsigned* cnt = (unsigned*)(smem + 61440);
  unsigned* res = (unsigned*)(smem + 61504);
  unsigned* ccnt = (unsigned*)(smem + 61632);
  unsigned* ovf = (unsigned*)(smem + 61696);
  unsigned* ckey = (unsigned*)(smem + 61952);
  unsigned* cidx = (unsigned*)(smem + 66048);
  const int tid = otid(), lane = tid & 63, wave = tid >> 6;
  const int g4 = lane >> 4, cl = lane & 15;
  const int tokq0 = (isP ? b * 8192 : TP + b * 64) + tq;
  const int S = isP ? ((tq >> 6) + 1) * 64 : 2112;
  const size_t seqbase = isP ? (size_t)b * 8192 : (size_t)16384 + (size_t)b * 2112;
  const bf16_t* KIs = p.KIB + seqbase * 64;
  const bf16_t* Ks = p.KB + seqbase * 128;
  const bf16_t* Vs = p.VB + seqbase * 128;
  const int nsel = S < 256 ? S : 256;
  __syncthreads();
  if (S <= 256) {
    for (int e = tid; e < 16 * 256; e += 256) idxl[e] = (unsigned short)(e & 255);
  } else {
    const int qloc = wave * 4 + g4;
    bf16x8 aq0, aq1;
    {
      const bf16_t* qp = p.qi + ((size_t)(tokq0 + wave * 4) * 4 + cl) * 64 + g4 * 8;
      aq0 = *(const bf16x8*)qp;
      aq1 = *(const bf16x8*)(qp + 32);
    }
    const float4 wq = *(const float4*)(p.wi + (size_t)(tokq0 + qloc) * 4);
    unsigned prefix = 0u, need = 256u;
    const int nchunks = (S + 255) >> 8;
    const int skey = tid >> 3, sc8 = (tid & 7) * 8;
    for (int pass = 0; pass < 6; pass++) {
      const int kind = (pass == 2) ? 1 : (pass == 5) ? 2 : 0;
      const int shift = pass == 0 ? 24 : pass == 1 ? 16 : pass == 3 ? 8 : 0;
      if (kind == 0) {
        for (int e = tid; e < 1024; e += 256) ((uint4*)hist)[e] = make_uint4(0, 0, 0, 0);
      } else {
        if (tid < 16) { cnt[tid] = 0u; ccnt[tid] = 0u; }
        if (tid == 16) *ovf = 0u;
      }
      unsigned tiecnt = 0u;
      const unsigned G = 256u - need;
      uint4 rg0, rg1, rg2, rg3, rg4, rg5, rg6, rg7;
#define KLOAD(KC)                                                                            \
  {                                                                                          \
    const bf16_t* src = KIs + (size_t)((KC) * 256 + skey) * 64 + sc8;                        \
    const int kb0 = (KC) * 256 + skey;                                                       \
    if (kb0 < S) rg0 = *(const uint4*)(src);                                                 \
    if (kb0 + 32 < S) rg1 = *(const uint4*)(src + 32 * 64);                                  \
    if (kb0 + 64 < S) rg2 = *(const uint4*)(src + 64 * 64);                                  \
    if (kb0 + 96 < S) rg3 = *(const uint4*)(src + 96 * 64);                                  \
    if (kb0 + 128 < S) rg4 = *(const uint4*)(src + 128 * 64);                                \
    if (kb0 + 160 < S) rg5 = *(const uint4*)(src + 160 * 64);                                \
    if (kb0 + 192 < S) rg6 = *(const uint4*)(src + 192 * 64);                                \
    if (kb0 + 224 < S) rg7 = *(const uint4*)(src + 224 * 64);                                \
  }
      rg0 = rg1 = rg2 = rg3 = rg4 = rg5 = rg6 = rg7 = make_uint4(0, 0, 0, 0);
      KLOAD(0)
      for (int kc = 0; kc < nchunks; kc++) {
        __syncthreads();
        {
          bf16_t* d = kst + skey * 72 + sc8;
          *(uint4*)(d) = rg0;
          *(uint4*)(d + 32 * 72) = rg1;
          *(uint4*)(d + 64 * 72) = rg2;
          *(uint4*)(d + 96 * 72) = rg3;
          *(uint4*)(d + 128 * 72) = rg4;
          *(uint4*)(d + 160 * 72) = rg5;
          *(uint4*)(d + 192 * 72) = rg6;
          *(uint4*)(d + 224 * 72) = rg7;
        }
        __syncthreads();
        if (kc + 1 < nchunks) KLOAD(kc + 1)
        const int ngrp = (S - kc * 256) >= 256 ? 4 : ((S - kc * 256) >> 6);
        for (int tg = 0; tg < ngrp; tg++) {
          unsigned keys[4];
#pragma unroll
          for (int tt = 0; tt < 4; tt++) {
            const bf16_t* br = kst + ((tg * 4 + tt) * 16 + cl) * 72 + g4 * 8;
            const bf16x8 b0 = *(const bf16x8*)br;
            const bf16x8 b1 = *(const bf16x8*)(br + 32);
            f32x4 a = (f32x4){0.f, 0.f, 0.f, 0.f};
            a = mfma16(aq0, b0, a);
            a = mfma16(aq1, b1, a);
            const float score = wq.x * relu_(a[0]) + wq.y * relu_(a[1]) + wq.z * relu_(a[2]) + wq.w * relu_(a[3]);
            keys[tt] = mono_key(score);
          }
#pragma unroll
          for (int tt = 0; tt < 4; tt++) {
            const unsigned key = keys[tt];
            const int kidx = kc * 256 + (tg * 4 + tt) * 16 + cl;
            if (kind == 0) {
              const bool match = (pass == 0) || ((key >> (shift + 8)) == prefix);
              if (match) atomicAdd(&hist[qloc * 256 + ((key >> shift) & 255u)], 1u);
            } else if (kind == 1) {
              const unsigned hk = key >> 16;
              const bool tz = (hk == prefix) && ((key & 0xFFFFu) == 0u);
              if (hk > prefix) {
                const unsigned slot = atomicAdd(&cnt[qloc], 1u);
                if (slot < 256u) idxl[qloc * 256 + slot] = (unsigned short)kidx;
              } else if (hk == prefix && !tz) {
                const unsigned c = atomicAdd(&ccnt[qloc], 1u);
                if (c < 64u) { ckey[qloc * 64 + c] = key; cidx[qloc * 64 + c] = (unsigned)kidx; }
              }
              const unsigned long long bm = __ballot(tz);
              if (bm != 0ull) {
                const unsigned mg = (unsigned)(bm >> (g4 * 16)) & 0xFFFFu;
                const unsigned rank = tiecnt + __popc(mg & ((1u << cl) - 1u));
                if (tz && rank < need) tiel[qloc * 256 + rank] = (unsigned short)kidx;
                tiecnt += __popc(mg);
              }
            } else {
              if (key > prefix) {
                const unsigned slot = atomicAdd(&cnt[qloc], 1u);
                if (slot < 256u) idxl[qloc * 256 + slot] = (unsigned short)kidx;
              }
              const bool eq = (key == prefix);
              const unsigned long long bm = __ballot(eq);
              if (bm != 0ull) {
                const unsigned mg = (unsigned)(bm >> (g4 * 16)) & 0xFFFFu;
                const unsigned rank = tiecnt + __popc(mg & ((1u << cl) - 1u));
                if (eq && rank < need) idxl[qloc * 256 + G + rank] = (unsigned short)kidx;
                tiecnt += __popc(mg);
              }
            }
          }
        }
      }
#undef KLOAD
      __syncthreads();
      if (kind == 0) {
        const unsigned* hq = hist + qloc * 256;
        const int top = 255 - 16 * cl;
        unsigned sum = 0u;
#pragma unroll
        for (int u = 0; u < 16; u++) sum += hq[top - u];
        unsigned incl = sum;
#pragma unroll
        for (int d = 1; d < 16; d <<= 1) {
          const unsigned t = __shfl_up(incl, d, 16);
          if (cl >= d) incl += t;
        }
        const unsigned excl = incl - sum;
        if (excl < need && incl >= need) {
          unsigned cum = excl;
          int bsel = top - 15;
          unsigned above = excl;
          bool found = false;
#pragma unroll
          for (int u = 0; u < 16; u++) {
            const unsigned c = hq[top - u];
            if (!found && cum + c >= need) { bsel = top - u; above = cum; found = true; }
            cum += c;
          }
          res[qloc * 2] = (unsigned)bsel;
          res[qloc * 2 + 1] = above;
        }
        __syncthreads();
        const unsigned bstar = res[qloc * 2], above = res[qloc * 2 + 1];
        need -= above;
        prefix = (prefix << 8) | bstar;
      } else if (kind == 1) {
        const unsigned c = ccnt[qloc];
        if (c > 64u) {
          if (cl == 0) *ovf = 1u;
        } else {
          for (unsigned i = cl; i < c; i += 16) {
            const unsigned ki = ckey[qloc * 64 + i], ii = cidx[qloc * 64 + i];
            unsigned rank = 0u;
            for (unsigned j = 0; j < c; j++) {
              const unsigned kj = ckey[qloc * 64 + j], ij = cidx[qloc * 64 + j];
              rank += (kj > ki || (kj == ki && ij < ii)) ? 1u : 0u;
            }
            if (rank < need) idxl[qloc * 256 + G + rank] = (unsigned short)ii;
          }
          const unsigned nso = c < need ? c : need;
          for (unsigned t = cl; t < need - nso; t += 16) idxl[qloc * 256 + G + nso + t] = tiel[qloc * 256 + t];
        }
        __syncthreads();
        if (*ovf == 0u) break;
      }
    }
  }
  __syncthreads();
  float* opq = (float*)smem;
  float* mlq = (float*)(smem + 61952);
  char* vst = smem + 24576 + wave * 9216;
  const bool active = wave * 64 < nsel;
  uint4 vq0, vq1, vq2, vq3, vq4, vq5, vq6, vq7, vq8, vq9, vq10, vq11, vq12, vq13, vq14, vq15;
  bf16x8 kf[2][4][2];
  if (active) {
    vq0 = *(const uint4*)(Vs + (size_t)idxl[wave * 64 + 0 + g4] * 128 + cl * 8);
    vq1 = *(const uint4*)(Vs + (size_t)idxl[wave * 64 + 4 + g4] * 128 + cl * 8);
    vq2 = *(const uint4*)(Vs + (size_t)idxl[wave * 64 + 8 + g4] * 128 + cl * 8);
    vq3 = *(const uint4*)(Vs + (size_t)idxl[wave * 64 + 12 + g4] * 128 + cl * 8);
    vq4 = *(const uint4*)(Vs + (size_t)idxl[wave * 64 + 16 + g4] * 128 + cl * 8);
    vq5 = *(const uint4*)(Vs + (size_t)idxl[wave * 64 + 20 + g4] * 128 + cl * 8);
    vq6 = *(const uint4*)(Vs + (size_t)idxl[wave * 64 + 24 + g4] * 128 + cl * 8);
    vq7 = *(const uint4*)(Vs + (size_t)idxl[wave * 64 + 28 + g4] * 128 + cl * 8);
    vq8 = *(const uint4*)(Vs + (size_t)idxl[wave * 64 + 32 + g4] * 128 + cl * 8);
    vq9 = *(const uint4*)(Vs + (size_t)idxl[wave * 64 + 36 + g4] * 128 + cl * 8);
    vq10 = *(const uint4*)(Vs + (size_t)idxl[wave * 64 + 40 + g4] * 128 + cl * 8);
    vq11 = *(const uint4*)(Vs + (size_t)idxl[wave * 64 + 44 + g4] * 128 + cl * 8);
    vq12 = *(const uint4*)(Vs + (size_t)idxl[wave * 64 + 48 + g4] * 128 + cl * 8);
    vq13 = *(const uint4*)(Vs + (size_t)idxl[wave * 64 + 52 + g4] * 128 + cl * 8);
    vq14 = *(const uint4*)(Vs + (size_t)idxl[wave * 64 + 56 + g4] * 128 + cl * 8);
    vq15 = *(const uint4*)(Vs + (size_t)idxl[wave * 64 + 60 + g4] * 128 + cl * 8);
#pragma unroll
    for (int tt = 0; tt < 4; tt++) {
      const int pos = idxl[wave * 64 + tt * 16 + cl];
#pragma unroll
      for (int j = 0; j < 2; j++) {
        const bf16_t* kr = Ks + (size_t)pos * 128 + j * 64 + g4 * 8;
        kf[j][tt][0] = *(const bf16x8*)kr;
        kf[j][tt][1] = *(const bf16x8*)(kr + 32);
      }
    }
  }
  for (int qq = 0; qq < 16; qq++) {
    const int tok = tokq0 + qq;
    const int qn = qq < 15 ? qq + 1 : 15;
    float* opb = opq + (qq & 1) * 2048;
    float* mlb = mlq + (qq & 1) * 64;
    if (active) {
      union PB { bf16x8 v; unsigned u[4]; };
      PB pb[2][2];
#pragma unroll
      for (int j = 0; j < 2; j++) {
        const bf16_t* qp = p.qa + (size_t)tok * 512 + (j * 4 + (cl & 3)) * 64 + g4 * 8;
        const bf16x8 bq0 = *(const bf16x8*)qp;
        const bf16x8 bq1 = *(const bf16x8*)(qp + 32);
        f32x4 lg[4];
#pragma unroll
        for (int tt = 0; tt < 4; tt++) {
          f32x4 a = (f32x4){0.f, 0.f, 0.f, 0.f};
          a = mfma16(kf[j][tt][0], bq0, a);
          a = mfma16(kf[j][tt][1], bq1, a);
          lg[tt] = a;
        }
        float m = -1e30f;
#pragma unroll
        for (int tt = 0; tt < 4; tt++)
#pragma unroll
          for (int r = 0; r < 4; r++) m = fmaxf(m, lg[tt][r]);
        m = red4_max(m);
        float sum = 0.f;
#pragma unroll
        for (int tt = 0; tt < 4; tt++)
#pragma unroll
          for (int r = 0; r < 4; r++) {
            const float e = __expf(lg[tt][r] - m);
            lg[tt][r] = e;
            sum += e;
          }
        sum = red4_sum(sum);
#pragma unroll
        for (int sI = 0; sI < 2; sI++) {
          pb[j][sI].u[0] = pack2(lg[2 * sI][0], lg[2 * sI][1]);
          pb[j][sI].u[1] = pack2(lg[2 * sI][2], lg[2 * sI][3]);
          pb[j][sI].u[2] = pack2(lg[2 * sI + 1][0], lg[2 * sI + 1][1]);
          pb[j][sI].u[3] = pack2(lg[2 * sI + 1][2], lg[2 * sI + 1][3]);
        }
        if (cl < 4 && g4 == 0) {
          mlb[(wave * 8 + j * 4 + cl) * 2] = m;
          mlb[(wave * 8 + j * 4 + cl) * 2 + 1] = sum;
        }
      }
#pragma unroll
      for (int tt = 0; tt < 4; tt++) {
        const int pos = idxl[qn * 256 + wave * 64 + tt * 16 + cl];
#pragma unroll
        for (int j = 0; j < 2; j++) {
          const bf16_t* kr = Ks + (size_t)pos * 128 + j * 64 + g4 * 8;
          kf[j][tt][0] = *(const bf16x8*)kr;
          kf[j][tt][1] = *(const bf16x8*)(kr + 32);
        }
      }
      f32x4 o[2][4];
#pragma unroll
      for (int j = 0; j < 2; j++)
#pragma unroll
        for (int dt = 0; dt < 4; dt++) o[j][dt] = (f32x4){0.f, 0.f, 0.f, 0.f};
      const lds_cptr vb = (lds_cptr)(vst + (g4 * 4 + (cl >> 2)) * 288 + (cl & 3) * 8);
      {
        *(uint4*)(vst + (0 + g4) * 288 + cl * 16) = vq0;
        *(uint4*)(vst + (4 + g4) * 288 + cl * 16) = vq1;
        *(uint4*)(vst + (8 + g4) * 288 + cl * 16) = vq2;
        *(uint4*)(vst + (12 + g4) * 288 + cl * 16) = vq3;
        *(uint4*)(vst + (16 + g4) * 288 + cl * 16) = vq4;
        *(uint4*)(vst + (20 + g4) * 288 + cl * 16) = vq5;
        *(uint4*)(vst + (24 + g4) * 288 + cl * 16) = vq6;
        *(uint4*)(vst + (28 + g4) * 288 + cl * 16) = vq7;
        __builtin_amdgcn_wave_barrier();
#pragma unroll
        for (int j = 0; j < 2; j++)
#pragma unroll
          for (int dt = 0; dt < 4; dt++) {
            const s16x4 alo = vtr(vb + (j * 64 + dt * 16) * 2);
            const s16x4 ahi = vtr(vb + (j * 64 + dt * 16) * 2 + 16 * 288);
            const bf16x8 af = __builtin_shufflevector(alo, ahi, 0, 1, 2, 3, 4, 5, 6, 7);
            o[j][dt] = mfma16(af, pb[j][0].v, o[j][dt]);
          }
        __builtin_amdgcn_wave_barrier();
      }
      {
        *(uint4*)(vst + (0 + g4) * 288 + cl * 16) = vq8;
        *(uint4*)(vst + (4 + g4) * 288 + cl * 16) = vq9;
        *(uint4*)(vst + (8 + g4) * 288 + cl * 16) = vq10;
        *(uint4*)(vst + (12 + g4) * 288 + cl * 16) = vq11;
        *(uint4*)(vst + (16 + g4) * 288 + cl * 16) = vq12;
        *(uint4*)(vst + (20 + g4) * 288 + cl * 16) = vq13;
        *(uint4*)(vst + (24 + g4) * 288 + cl * 16) = vq14;
        *(uint4*)(vst + (28 + g4) * 288 + cl * 16) = vq15;
        __builtin_amdgcn_wave_barrier();
#pragma unroll
        for (int j = 0; j < 2; j++)
#pragma unroll
          for (int dt = 0; dt < 4; dt++) {
            const s16x4 alo = vtr(vb + (j * 64 + dt * 16) * 2);
            const s16x4 ahi = vtr(vb + (j * 64 + dt * 16) * 2 + 16 * 288);
            const bf16x8 af = __builtin_shufflevector(alo, ahi, 0, 1, 2, 3, 4, 5, 6, 7);
            o[j][dt] = mfma16(af, pb[j][1].v, o[j][dt]);
          }
        __builtin_amdgcn_wave_barrier();
      }
      vq0 = *(const uint4*)(Vs + (size_t)idxl[qn * 256 + wave * 64 + 0 + g4] * 128 + cl * 8);
      vq1 = *(const uint4*)(Vs + (size_t)idxl[qn * 256 + wave * 64 + 4 + g4] * 128 + cl * 8);
      vq2 = *(const uint4*)(Vs + (size_t)idxl[qn * 256 + wave * 64 + 8 + g4] * 128 + cl * 8);
      vq3 = *(const uint4*)(Vs + (size_t)idxl[qn * 256 + wave * 64 + 12 + g4] * 128 + cl * 8);
      vq4 = *(const uint4*)(Vs + (size_t)idxl[qn * 256 + wave * 64 + 16 + g4] * 128 + cl * 8);
      vq5 = *(const uint4*)(Vs + (size_t)idxl[qn * 256 + wave * 64 + 20 + g4] * 128 + cl * 8);
      vq6 = *(const uint4*)(Vs + (size_t)idxl[qn * 256 + wave * 64 + 24 + g4] * 128 + cl * 8);
      vq7 = *(const uint4*)(Vs + (size_t)idxl[qn * 256 + wave * 64 + 28 + g4] * 128 + cl * 8);
      vq8 = *(const uint4*)(Vs + (size_t)idxl[qn * 256 + wave * 64 + 32 + g4] * 128 + cl * 8);
      vq9 = *(const uint4*)(Vs + (size_t)idxl[qn * 256 + wave * 64 + 36 + g4] * 128 + cl * 8);
      vq10 = *(const uint4*)(Vs + (size_t)idxl[qn * 256 + wave * 64 + 40 + g4] * 128 + cl * 8);
      vq11 = *(const uint4*)(Vs + (size_t)idxl[qn * 256 + wave * 64 + 44 + g4] * 128 + cl * 8);
      vq12 = *(const uint4*)(Vs + (size_t)idxl[qn * 256 + wave * 64 + 48 + g4] * 128 + cl * 8);
      vq13 = *(const uint4*)(Vs + (size_t)idxl[qn * 256 + wave * 64 + 52 + g4] * 128 + cl * 8);
      vq14 = *(const uint4*)(Vs + (size_t)idxl[qn * 256 + wave * 64 + 56 + g4] * 128 + cl * 8);
      vq15 = *(const uint4*)(Vs + (size_t)idxl[qn * 256 + wave * 64 + 60 + g4] * 128 + cl * 8);
      if (cl < 4) {
#pragma unroll
        for (int j = 0; j < 2; j++)
#pragma unroll
          for (int dt = 0; dt < 4; dt++) *(f32x4*)(opb + (wave * 8 + j * 4 + cl) * 64 + dt * 16 + g4 * 4) = o[j][dt];
      }
    } else {
      if (lane < 8) {
        mlb[(wave * 8 + lane) * 2] = -1e30f;
        mlb[(wave * 8 + lane) * 2 + 1] = 0.f;
      }
      *(f32x4*)(opb + wave * 512 + lane * 8) = (f32x4){0.f, 0.f, 0.f, 0.f};
      *(f32x4*)(opb + wave * 512 + lane * 8 + 4) = (f32x4){0.f, 0.f, 0.f, 0.f};
    }
    __syncthreads();
    {
      const int e = tid * 2, head = e >> 6, d = e & 63;
      float M = -1e30f;
#pragma unroll
      for (int w = 0; w < 4; w++) M = fmaxf(M, mlb[(w * 8 + head) * 2]);
      float den = 0.f, n0 = 0.f, n1 = 0.f;
#pragma unroll
      for (int w = 0; w < 4; w++) {
        const float f = __expf(mlb[(w * 8 + head) * 2] - M);
        den += mlb[(w * 8 + head) * 2 + 1] * f;
        const float2 o2 = *(const float2*)(opb + (w * 8 + head) * 64 + d);
        n0 += o2.x * f;
        n1 += o2.y * f;
      }
      const float inv = __builtin_amdgcn_rcpf(den);
      if (!dry) *(unsigned*)(p.qa + (size_t)tok * 512 + e) = pack2(n0 * inv, n1 * inv);
    }
  }
  __syncthreads();
}

DI void mixer_phase(const Params& p, int l, char* smem, const bool dry = false, const int ci = 0) {
  const int tid = otid();
  const int NTASK = 64 + 1024 + 1024 + 128 + 288;
  const int NEXTRA = (l == 0 && !dry) ? 456 : 0;
  bool first = true;
  for (;;) {
    int id;
    if (first && blockIdx.x < 64) {
      id = blockIdx.x;
    } else {
      __syncthreads();
      if (tid == 0) *(int*)(smem + SLOT) = 64 + (int)atomicAdd(&p.ctr[l + ci], 1u);
      __syncthreads();
      id = *(const int*)(smem + SLOT);
    }
    first = false;
    if (id >= NTASK + NEXTRA) break;
    if (id >= NTASK) {
      for (int q = 0; q < 8; q++) {
        const int d = (id - NTASK) * 8 + q;
        const int t = d < 1984 ? 2880 + d : d < 2624 ? 2880 + 2240 + (d - 1984) : 5760 + 1024 + (d - 2624);
        transpose_job(p, t, (float*)smem);
      }
      continue;
    }
    const int d = id - 64;
    if (id < 64 || d >= 1440) {
      int isP, b, h, rg;
      if (id < 64) { isP = 1; b = id >> 5; h = (id >> 2) & 7; rg = id & 3; }
      else { const int s = d - 1440; isP = 0; b = s >> 5; h = (s >> 2) & 7; rg = s & 3; }
      if (!(dry && (PROBE_SKIP & 2))) scan_task(p, l, isP, b, h, rg, smem, dry);
    } else if (d < 896 || d >= 1184) {
      int isP, b, tq;
      if (d < 768) { isP = 1; b = d & 1; tq = (511 - (d >> 1)) * 16; }
      else if (d < 896) { const int s = d - 768; isP = 0; b = s >> 2; tq = (s & 3) * 16; }
      else { const int s = d - 1184; isP = 1; b = s & 1; tq = (127 - (s >> 1)) * 16; }
      if (!(dry && (PROBE_SKIP & 1))) dsa_task(p, l, isP, b, tq, smem, dry);
    } else {
      if (!(dry && (PROBE_SKIP & 4))) mem_task(p, l, (d - 896) * 64, smem, dry);
    }
  }
}

DI void post_phase(const Params& p, int l) {
  const int tid = otid(), lane = tid & 63, wave = tid >> 6;
  float lw[8], lb[8];
#pragma unroll
  for (int h = 0; h < 8; h++) { lw[h] = p.ln_w[l * 512 + h * 64 + lane]; lb[h] = p.ln_b[l * 512 + h * 64 + lane]; }
  const int step = gridDim.x * 4;
  int tok = blockIdx.x * 4 + wave;
  float y[8], vv[8], bo[8];
  if (tok < TOK) {
    const bf16_t* vb = (const bf16_t*)(p.R + (size_t)tok * RS + 512) + 1024;
#pragma unroll
    for (int h = 0; h < 8; h++) {
      y[h] = p.yscan[(size_t)tok * 512 + h * 64 + lane];
      vv[h] = bf2f(vb[h * 64 + lane]);
      bo[h] = p.bonus[(size_t)tok * 8 + h];
    }
  }
  for (; tok < TOK; tok += step) {
    float yn[8], vn[8], bn[8];
    const int tn = tok + step < TOK ? tok + step : tok;
    {
      const bf16_t* vb = (const bf16_t*)(p.R + (size_t)tn * RS + 512) + 1024;
#pragma unroll
      for (int h = 0; h < 8; h++) {
        yn[h] = p.yscan[(size_t)tn * 512 + h * 64 + lane];
        vn[h] = bf2f(vb[h * 64 + lane]);
        bn[h] = p.bonus[(size_t)tn * 8 + h];
      }
    }
    float o[8];
#pragma unroll
    for (int h = 0; h < 8; h++) {
      const float mean = wave_sum(y[h]) * (1.f / 64.f);
      const float dv = y[h] - mean;
      const float var = wave_sum(dv * dv) * (1.f / 64.f);
      o[h] = dv * rsqrtf(var + 64e-5f) * lw[h] + lb[h] + bo[h] * vv[h];
    }
#pragma unroll
    for (int h = 0; h < 8; h++) p.o_r[(size_t)tok * 512 + h * 64 + lane] = f2bf(o[h]);
#pragma unroll
    for (int h = 0; h < 8; h++) { y[h] = yn[h]; vv[h] = vn[h]; bo[h] = bn[h]; }
  }
}

DI void gemm2_phase(const Params& p, int l, char* smem, const bool dry = false) {
  bf16_t* sm = (bf16_t*)smem;
  const int tid = otid(), lane = tid & 63, wave = tid >> 6;
  const int wm = wave >> 1, wn = wave & 1, g4 = lane >> 4, cl = lane & 15;
  const int slots = gridDim.x >> 3, slot = blockIdx.x >> 3;
  for (int e = slot;; e += slots) {
    int mt, nt;
    if (!xcd_tile(e, 36, mt, nt)) break;
    f32x4 acc[4][4];
    zero_acc(acc);
    gemm_kloop(p.hb + (size_t)mt * 128 * DM, DM, p.Wt2 + ((size_t)l * N2 + nt * 128) * DM, DM, DM, sm, acc);
    const int nb = nt * 128 + wn * 64;
    if (dry) {
      if (acc[0][0][0] == 1.2345e30f) p.wi[0] = acc[1][1][1] + acc[2][2][2] + acc[3][3][3];
    } else if (nb < 1536) {
      bf16_t* base = (nb < 512 ? p.qa : nb < 1024 ? p.o_r : p.qm) + (nb & 511) + cl;
      bf16_t old[4][4][4];
#pragma unroll
      for (int i = 0; i < 4; i++)
#pragma unroll
        for (int r = 0; r < 4; r++) {
          const int tok = mt * 128 + wm * 64 + i * 16 + g4 * 4 + r;
#pragma unroll
          for (int jn = 0; jn < 4; jn++) old[i][r][jn] = base[(size_t)tok * 512 + jn * 16];
        }
#pragma unroll
      for (int i = 0; i < 4; i++)
#pragma unroll
        for (int r = 0; r < 4; r++) {
          const int tok = mt * 128 + wm * 64 + i * 16 + g4 * 4 + r;
#pragma unroll
          for (int jn = 0; jn < 4; jn++) base[(size_t)tok * 512 + jn * 16] = f2bf(bf2f(old[i][r][jn]) * siluf_(acc[i][jn][r]));
        }
    } else {
#pragma unroll
      for (int i = 0; i < 4; i++)
#pragma unroll
        for (int r = 0; r < 4; r++) {
          const int tok = mt * 128 + wm * 64 + i * 16 + g4 * 4 + r;
#pragma unroll
          for (int jn = 0; jn < 4; jn++)
            p.G[(size_t)tok * 3072 + nb - 1536 + jn * 16 + cl] = f2bf(sigmoidf_(acc[i][jn][r]));
        }
    }
  }
}

DI void merge_phase(const Params& p, int l, char* smem) {
  bf16_t* sm = (bf16_t*)smem;
  const int tid = otid(), lane = tid & 63, wave = tid >> 6;
  const int g4 = lane >> 4, cl = lane & 15;
  const int slots = gridDim.x >> 3, slot = blockIdx.x >> 3;
  for (int e = slot;; e += slots) {
    int mt, nt;
    if (!xcd_tile(e, 16, mt, nt)) break;
    f32x4 tot[2][4];
#pragma unroll
    for (int i = 0; i < 2; i++)
#pragma unroll
      for (int j = 0; j < 4; j++) tot[i][j] = (f32x4){0.f, 0.f, 0.f, 0.f};
#pragma unroll 1
    for (int br = 0; br < 3; br++) {
      f32x4 acc[2][4];
#pragma unroll
      for (int i = 0; i < 2; i++)
#pragma unroll
        for (int j = 0; j < 4; j++) acc[i][j] = (f32x4){0.f, 0.f, 0.f, 0.f};
      const bf16_t* A = (br == 0 ? p.qa : br == 1 ? p.o_r : p.qm) + (size_t)mt * 128 * 512;
      gemm_kloop64(A, 512, p.Wbr + ((size_t)(l * 3 + br) * DM + nt * 64) * 512, 512, 512, sm, acc);
#pragma unroll
      for (int i = 0; i < 2; i++)
#pragma unroll
        for (int r = 0; r < 4; r++) {
          const int tok = mt * 128 + wave * 32 + i * 16 + g4 * 4 + r;
#pragma unroll
          for (int jn = 0; jn < 4; jn++) {
            const int n = nt * 64 + jn * 16 + cl;
            const float g = bf2f(p.G[(size_t)tok * 3072 + br * 1024 + n]);
            tot[i][jn][r] += g * acc[i][jn][r];
          }
        }
    }
#pragma unroll
    for (int i = 0; i < 2; i++)
#pragma unroll
      for (int r = 0; r < 4; r++) {
        const int tok = mt * 128 + wave * 32 + i * 16 + g4 * 4 + r;
#pragma unroll
        for (int jn = 0; jn < 4; jn++) {
          const int n = nt * 64 + jn * 16 + cl;
          p.merged[(size_t)tok * DM + n] = f2bf(tot[i][jn][r]);
        }
      }
  }
}

DI void out_phase(const Params& p, int l, char* smem, const bool dry = false) {
  bf16_t* sm = (bf16_t*)smem;
  const int tid = otid(), lane = tid & 63, wave = tid >> 6;
  const int wm = wave >> 1, wn = wave & 1, g4 = lane >> 4, cl = lane & 15;
  const int slots = gridDim.x >> 3, slot = blockIdx.x >> 3;
  for (int e = slot;; e += slots) {
    int mt, nt;
    if (!xcd_tile(e, 8, mt, nt)) break;
    f32x4 acc[4][4];
    zero_acc(acc);
    gemm_kloop(p.merged + (size_t)mt * 128 * DM, DM, p.Wout + ((size_t)l * DM + nt * 128) * DM, DM, DM, sm, acc);
    if (dry) {
      if (acc[0][0][0] == 1.2345e30f) p.wi[0] = acc[1][1][1] + acc[2][2][2] + acc[3][3][3];
      continue;
    }
    float xo[4][4][4];
#pragma unroll
    for (int i = 0; i < 4; i++)
#pragma unroll
      for (int r = 0; r < 4; r++) {
        const int tok = mt * 128 + wm * 64 + i * 16 + g4 * 4 + r;
        const float* xr = xrow_ptr(p, l, tok);
#pragma unroll
        for (int jn = 0; jn < 4; jn++) xo[i][r][jn] = xr[nt * 128 + wn * 64 + jn * 16 + cl];
      }
#pragma unroll
    for (int i = 0; i < 4; i++)
#pragma unroll
      for (int r = 0; r < 4; r++) {
        const int tok = mt * 128 + wm * 64 + i * 16 + g4 * 4 + r;
#pragma unroll
        for (int jn = 0; jn < 4; jn++) {
          const int n = nt * 128 + wn * 64 + jn * 16 + cl;
          p.out[(size_t)tok * DM + n] = xo[i][r][jn] + acc[i][jn][r];
        }
      }
  }
}

DI void norm_phase(const Params& p, int l) {
  const int wave = otid() >> 6;
  for (int tok = blockIdx.x * 4 + wave; tok < TOK; tok += gridDim.x * 4)
    norm_row_bf16(xrow_ptr(p, l, tok), p.norm_g + l * DM, p.hb + (size_t)tok * DM);
}
DI void final_phase(const Params& p) {
  const int lane = otid() & 63, wave = otid() >> 6;
  for (int tok = blockIdx.x * 4 + wave; tok < TOK; tok += gridDim.x * 4) {
    float* x = p.out + (size_t)tok * DM;
    float4 v[4];
    float ss = 0.f;
#pragma unroll
    for (int i = 0; i < 4; i++) {
      v[i] = *(const float4*)(x + i * 256 + lane * 4);
      ss += v[i].x * v[i].x + v[i].y * v[i].y + v[i].z * v[i].z + v[i].w * v[i].w;
    }
    ss = wave_sum(ss);
    const float rstd = rsqrtf(ss * (1.f / 1024.f) + 1e-6f);
#pragma unroll
    for (int i = 0; i < 4; i++) {
      const float4 g = *(const float4*)(p.final_g + i * 256 + lane * 4);
      *(float4*)(x + i * 256 + lane * 4) = make_float4(v[i].x * rstd * g.x, v[i].y * rstd * g.y, v[i].z * rstd * g.z, v[i].w * rstd * g.w);
    }
  }
}

__global__ void __launch_bounds__(256, 2) mega(Params pk) {
  const Params& p = *(const Params*)__builtin_amdgcn_kernarg_segment_ptr();
  cg::grid_group grid = cg::this_grid();
  __shared__ __attribute__((aligned(16))) char smem[SMEM];
  phase0(p, smem);
  grid.sync();
  GBar gb;
  gbar_init(gb, p.ctr);
#ifndef PROBE_DUP
#define PROBE_DUP 0
#endif
  const bool dryv = PROBE_DUP ? (*(volatile unsigned*)&p.ctr[7] == 0u) : false;
  if (PROBE_DUP & 1) { phase0(p, smem); gbar(gb); }
  for (int l = 0; l < 2; l++) {
    if (l == 1) { norm_phase(p, 1); convert_caches(p, 1); gbar(gb); }
    if (PROBE_DUP & 2) { gemm1_phase(p, l, smem); gbar(gb); }
    gemm1_phase(p, l, smem);
    gbar(gb);
    if (PROBE_DUP & 4) { prep_phase(p, l, smem, dryv); gbar(gb); }
    prep_phase(p, l, smem);
    gbar(gb);
    if (PROBE_DUP & 8) { mixer_phase(p, l, smem, dryv, 2); gbar(gb); }
    mixer_phase(p, l, smem);
    gbar(gb);
    if (PROBE_DUP & 16) { post_phase(p, l); gbar(gb); }
    post_phase(p, l);
    gbar(gb);
    if (PROBE_DUP & 32) { gemm2_phase(p, l, smem, dryv); gbar(gb); }
    gemm2_phase(p, l, smem);
    gbar(gb);
    if (PROBE_DUP & 64) { merge_phase(p, l, smem); gbar(gb); }
    merge_phase(p, l, smem);
    gbar(gb);
    if (PROBE_DUP & 128) { out_phase(p, l, smem, dryv); gbar(gb); }
    out_phase(p, l, smem);
    gbar(gb);
  }
  final_phase(p);
}

extern "C" void kernel_launch(void* const* d_in, const int* in_sizes, int n_in, void* d_out, int out_size, void* d_ws,
                              size_t ws_size, hipStream_t stream) {
  Params p;
  ::memset((void*)&p, 0, sizeof(p));
  const float** f = (const float**)&p;
  for (int i = 0; i < 29; i++) f[i] = (const float*)d_in[i];
  p.out = (float*)d_out;
  char* w = (char*)d_ws;
  size_t off = 0;
  auto take = [&](size_t bytes) { char* r = w + off; off += (bytes + 255) & ~(size_t)255; return r; };
  p.Wt1 = (bf16_t*)take((size_t)2 * N1 * DM * 2);
  p.Wt2 = (bf16_t*)take((size_t)2 * N2 * DM * 2);
  p.Wmem = (bf16_t*)take((size_t)2 * DM * DM * 2);
  p.Wbr = (bf16_t*)take((size_t)2 * 3 * DM * 512 * 2);
  p.Wout = (bf16_t*)take((size_t)2 * DM * DM * 2);
  p.cmvT = (bf16_t*)take((size_t)2 * 32 * 4 * 128 * 256 * 2);
  p.pmvT = (bf16_t*)take((size_t)2 * 2 * 4 * 128 * 256 * 2);
  p.memn = (bf16_t*)take((size_t)2 * 512 * DM * 2);
  p.rope = (float*)take((size_t)8192 * 32 * 2 * 4);
  p.hb = (bf16_t*)take((size_t)TOK * DM * 2);
  p.qa = (bf16_t*)take((size_t)TOK * 512 * 2);
  p.qi = (bf16_t*)take((size_t)TOK * 256 * 2);
  p.qm = (bf16_t*)take((size_t)TOK * 512 * 2);
  p.o_r = (bf16_t*)take((size_t)TOK * 512 * 2);
  p.wi = (float*)take((size_t)TOK * 4 * 4);
  p.R = (float*)take((size_t)TOK * RS * 4);
  p.G = (bf16_t*)p.R;
  p.yscan = (float*)take((size_t)TOK * 512 * 4);
  p.merged = (bf16_t*)p.yscan;
  p.bnd = (float*)take((size_t)(TOK / 16) * DSH * 4);
  p.bonus = (float*)take((size_t)TOK * 8 * 4);
  p.ctr = (unsigned*)take(16384);
  p.KB = (bf16_t*)take((size_t)NROWS * 128 * 2);
  p.VB = (bf16_t*)take((size_t)NROWS * 128 * 2);
  p.KIB = (bf16_t*)take((size_t)NROWS * 64 * 2);
  if (off > ws_size) {
    fprintf(stderr, "workspace too small: need %zu have %zu\n", off, ws_size);
    return;
  }
  static int grid_blocks = 0;
  if (!grid_blocks) {
    int dev = 0, cus = 0, per_cu = 0;
    (void)hipGetDevice(&dev);
    (void)hipDeviceGetAttribute(&cus, hipDeviceAttributeMultiprocessorCount, dev);
    (void)hipOccupancyMaxActiveBlocksPerMultiprocessor(&per_cu, mega, 256, 0);
    if (per_cu > 2) per_cu = 2;
    if (per_cu < 1) per_cu = 1;
    grid_blocks = (cus * per_cu) & ~7;
  }
  (void)hipMemsetAsync(p.ctr, 0, 16384, stream);
  void* args[] = {&p};
  hipError_t e = hipLaunchCooperativeKernel((void*)mega, dim3(grid_blocks), dim3(256), args, 0, stream);
  if (e != hipSuccess) fprintf(stderr, "cooperative launch failed: %s (grid %d)\n", hipGetErrorString(e), grid_blocks);
}
```
